# Optimizing an MI355X kernel written in HIP

```python
import math
import jax
import jax.numpy as jnp
from jax import lax
import numpy as np

D_MODEL = 1024
BATCH = 4
SEQ = 8192
DEPTH = 2

CHUNK = 64
Q_BLOCK = 128
MEM_LEN = 256
EPS = 1e-6

MLA_HEADS = 4
MLA_Q_RANK = 256
MLA_KV_RANK = 128
MLA_NOPE = 64
MLA_ROPE = 32
MLA_V = 128
ROPE_THETA = 10000.0
FOX_HEADS = 4
FOX_DIM = 64
CHK_HEADS = 4
CHK_DIM = 64
CHK_LEFT = 8
BAND = (CHK_LEFT + 1) * CHUNK
REL_MAX = 128
REL_SIZE = (CHUNK - 1) + REL_MAX + 1

A_WIDTH = MLA_HEADS * MLA_V
B_WIDTH = FOX_HEADS * FOX_DIM
C_WIDTH = CHK_HEADS * CHK_DIM
MIX_WIDTH = A_WIDTH + B_WIDTH + C_WIDTH

IN_SIZES = (MLA_Q_RANK, MLA_KV_RANK, MLA_ROPE,
            B_WIDTH, B_WIDTH, B_WIDTH, FOX_HEADS,
            C_WIDTH, C_WIDTH, C_WIDTH)
IN_WIDTH = sum(IN_SIZES)
IN_SPLIT_POINTS = tuple(int(v) for v in np.cumsum(IN_SIZES)[:-1])

CROSS_HEADS = 4
CROSS_DIM = 128
CROSS_WIDTH = CROSS_HEADS * CROSS_DIM

FFN_HIDDEN = ((-(-(8 * D_MODEL) // 3) + 255) // 256) * 256

kernel_name = 'hybrid_mla_fox_chunkrel_block'


def _rmsnorm(x, g):
    xf = x.astype(jnp.float32)
    y = xf * lax.rsqrt(jnp.mean(xf * xf, axis=-1, keepdims=True) + EPS)
    return (y * g.astype(jnp.float32)).astype(x.dtype)


def _rope_tables(seq):
    pos = jnp.arange(seq, dtype=jnp.float32)
    inv = ROPE_THETA ** (-jnp.arange(0, MLA_ROPE, 2, dtype=jnp.float32) / MLA_ROPE)
    ang = pos[:, None] * inv[None, :]
    return jnp.cos(ang), jnp.sin(ang)


def _rope(x, cos, sin):
    xf = x.astype(jnp.float32)
    x1, x2 = jnp.split(xf, 2, axis=-1)
    return jnp.concatenate([x1 * cos - x2 * sin, x1 * sin + x2 * cos], axis=-1).astype(x.dtype)


def _split_blocks(a, block):
    b, s = a.shape[:2]
    return jnp.moveaxis(a.reshape((b, s // block, block) + a.shape[2:]), 1, 0)


def _merge_blocks(a):
    nb, b, blk = a.shape[:3]
    return jnp.moveaxis(a, 0, 1).reshape(b, nb * blk, -1)


def _mla(c_q, c_kv, k_rope, q_norm, w_uq, kv_norm, w_ukv, cos, sin):
    b, s, _ = c_q.shape
    q = (_rmsnorm(c_q, q_norm) @ w_uq).reshape(b, s, MLA_HEADS, MLA_NOPE + MLA_ROPE)
    q_nope, q_pe = jnp.split(q, [MLA_NOPE], axis=-1)
    q = jnp.concatenate([q_nope, _rope(q_pe, cos[:, None], sin[:, None])], axis=-1)
    kv = (_rmsnorm(c_kv, kv_norm) @ w_ukv).reshape(b, s, MLA_HEADS, MLA_NOPE + MLA_V)
    k_nope, v = jnp.split(kv, [MLA_NOPE], axis=-1)
    k_pe = _rope(k_rope, cos, sin)
    k = jnp.concatenate(
        [k_nope, jnp.broadcast_to(k_pe[:, :, None, :], (b, s, MLA_HEADS, MLA_ROPE))], axis=-1)
    scale = (MLA_NOPE + MLA_ROPE) ** -0.5
    k_chunk = jnp.arange(s) // CHUNK

    def attend(args):
        qb, idx = args
        q_chunk = (idx * Q_BLOCK + jnp.arange(Q_BLOCK)) // CHUNK
        sc = jnp.einsum('bqhd,bkhd->bhqk', qb, k, preferred_element_type=jnp.float32) * scale
        sc = jnp.where(k_chunk[None, :] <= q_chunk[:, None], sc, -jnp.inf)
        p = jax.nn.softmax(sc, axis=-1).astype(v.dtype)
        return jnp.einsum('bhqk,bkhd->bqhd', p, v)

    out = lax.map(attend, (_split_blocks(q, Q_BLOCK), jnp.arange(s // Q_BLOCK)))
    return _merge_blocks(out)


def _fox(q, k, v, f_logit, f_bias):
    b, s, _ = q.shape
    q = q.reshape(b, s, FOX_HEADS, FOX_DIM)
    k = k.reshape(b, s, FOX_HEADS, FOX_DIM)
    v = v.reshape(b, s, FOX_HEADS, FOX_DIM)
    log_f = jax.nn.log_sigmoid(f_logit.astype(jnp.float32) + f_bias.astype(jnp.float32))
    cum = jnp.cumsum(log_f, axis=1)
    cum_k = jnp.transpose(cum, (0, 2, 1))
    scale = FOX_DIM ** -0.5
    k_pos = jnp.arange(s)

    def attend(args):
        qb, cq, idx = args
        q_pos = idx * Q_BLOCK + jnp.arange(Q_BLOCK)
        sc = jnp.einsum('bqhd,bkhd->bhqk', qb, k, preferred_element_type=jnp.float32) * scale
        sc = sc + jnp.transpose(cq, (0, 2, 1))[..., None] - cum_k[:, :, None, :]
        sc = jnp.where(k_pos[None, :] <= q_pos[:, None], sc, -jnp.inf)
        p = jax.nn.softmax(sc, axis=-1).astype(v.dtype)
        return jnp.einsum('bhqk,bkhd->bqhd', p, v)

    out = lax.map(attend, (_split_blocks(q, Q_BLOCK), _split_blocks(cum, Q_BLOCK),
                           jnp.arange(s // Q_BLOCK)))
    return _merge_blocks(out)


def _chunk_rel(q, k, v, rel_table):
    b, s, _ = q.shape
    q = q.reshape(b, s, CHK_HEADS, CHK_DIM)
    k = k.reshape(b, s, CHK_HEADS, CHK_DIM)
    v = v.reshape(b, s, CHK_HEADS, CHK_DIM)
    pad = CHK_LEFT * CHUNK
    kp = jnp.pad(k, ((0, 0), (pad, 0), (0, 0), (0, 0)))
    vp = jnp.pad(v, ((0, 0), (pad, 0), (0, 0), (0, 0)))
    qi = jnp.arange(CHUNK)
    ki = jnp.arange(BAND)
    rel = qi[:, None] + pad - ki[None, :]
    rel_idx = jnp.clip(rel, -(CHUNK - 1), REL_MAX) + (CHUNK - 1)
    bias = rel_table[:, rel_idx].astype(jnp.float32)
    scale = CHK_DIM ** -0.5

    def attend(args):
        qc, idx = args
        start = idx * CHUNK
        kb = lax.dynamic_slice_in_dim(kp, start, BAND, axis=1)
        vb = lax.dynamic_slice_in_dim(vp, start, BAND, axis=1)
        valid = (start - pad + ki) >= 0
        sc = jnp.einsum('bqhd,bkhd->bhqk', qc, kb, preferred_element_type=jnp.float32) * scale
        sc = jnp.where(valid, sc + bias[None], -jnp.inf)
        p = jax.nn.softmax(sc, axis=-1).astype(vb.dtype)
        return jnp.einsum('bhqk,bkhd->bqhd', p, vb)

    out = lax.map(attend, (_split_blocks(q, CHUNK), jnp.arange(s // CHUNK)))
    return _merge_blocks(out)


def _cross(h, m, w_cq, w_ckv, w_co):
    b, s, _ = h.shape
    n = m.shape[1]
    q = (h @ w_cq).reshape(b, s, CROSS_HEADS, CROSS_DIM)
    k, v = jnp.split(m @ w_ckv, 2, axis=-1)
    k = k.reshape(b, n, CROSS_HEADS, CROSS_DIM)
    v = v.reshape(b, n, CROSS_HEADS, CROSS_DIM)
    sc = jnp.einsum('bshd,bmhd->bhsm', q, k, preferred_element_type=jnp.float32) * (CROSS_DIM ** -0.5)
    p = jax.nn.softmax(sc, axis=-1).astype(v.dtype)
    o = jnp.einsum('bhsm,bmhd->bshd', p, v).reshape(b, s, CROSS_WIDTH)
    return o @ w_co


def setup_inputs(seed: int = 0) -> dict:
    key = jax.random.key(seed)
    ks = jax.random.split(key, 24)

    def nrm(k, shape, fan_in):
        return jax.random.normal(k, shape, jnp.float32) * (fan_in ** -0.5)

    def gain(k, shape):
        return 1.0 + 0.05 * jax.random.normal(k, shape, jnp.float32)

    L = DEPTH
    return {
        'x': jax.random.normal(ks[0], (BATCH, SEQ, D_MODEL), jnp.float32),
        'mem': jax.random.normal(ks[1], (BATCH, MEM_LEN, D_MODEL), jnp.float32),
        'norm_mix': gain(ks[2], (L, D_MODEL)),
        'w_in': nrm(ks[3], (L, D_MODEL, IN_WIDTH), D_MODEL),
        'q_norm': gain(ks[4], (L, MLA_Q_RANK)),
        'w_uq': nrm(ks[5], (L, MLA_Q_RANK, MLA_HEADS * (MLA_NOPE + MLA_ROPE)), MLA_Q_RANK),
        'kv_norm': gain(ks[6], (L, MLA_KV_RANK)),
        'w_ukv': nrm(ks[7], (L, MLA_KV_RANK, MLA_HEADS * (MLA_NOPE + MLA_V)), MLA_KV_RANK),
        'f_bias': jax.random.uniform(ks[8], (L, FOX_HEADS), jnp.float32, minval=1.0, maxval=4.0),
        'rel_bias': 0.3 * jax.random.normal(ks[9], (L, CHK_HEADS, REL_SIZE), jnp.float32),
        'out_norm': gain(ks[10], (L, MIX_WIDTH)),
        'w_o': nrm(ks[11], (L, MIX_WIDTH, D_MODEL), MIX_WIDTH),
        'norm_cross': gain(ks[12], (L, D_MODEL)),
        'norm_mem': gain(ks[13], (L, D_MODEL)),
        'w_cq': nrm(ks[14], (L, D_MODEL, CROSS_WIDTH), D_MODEL),
        'w_ckv': nrm(ks[15], (L, D_MODEL, 2 * CROSS_WIDTH), D_MODEL),
        'w_co': nrm(ks[16], (L, CROSS_WIDTH, D_MODEL), CROSS_WIDTH),
        'norm_ffn': gain(ks[17], (L, D_MODEL)),
        'w_gu': nrm(ks[18], (L, D_MODEL, 2 * FFN_HIDDEN), D_MODEL),
        'w_down': nrm(ks[19], (L, FFN_HIDDEN, D_MODEL), FFN_HIDDEN),
        'final_norm': gain(ks[20], (D_MODEL,)),
    }


def reference(x, mem, norm_mix, w_in, q_norm, w_uq, kv_norm, w_ukv, f_bias, rel_bias,
              out_norm, w_o, norm_cross, norm_mem, w_cq, w_ckv, w_co, norm_ffn, w_gu,
              w_down, final_norm):
    s = x.shape[1]
    cos, sin = _rope_tables(s)
    for l in range(DEPTH):
        h = _rmsnorm(x, norm_mix[l])
        proj = h @ w_in[l]
        (c_q, c_kv, k_rope, fq, fk, fv, f_logit, cq, ck, cv) = jnp.split(
            proj, IN_SPLIT_POINTS, axis=-1)
        ya = _mla(c_q, c_kv, k_rope, q_norm[l], w_uq[l], kv_norm[l], w_ukv[l], cos, sin)
        yb = _fox(fq, fk, fv, f_logit, f_bias[l])
        yc = _chunk_rel(cq, ck, cv, rel_bias[l])
        ga, gb, gc = jnp.split(out_norm[l], [A_WIDTH, A_WIDTH + B_WIDTH])
        y = jnp.concatenate([_rmsnorm(ya, ga), _rmsnorm(yb, gb), _rmsnorm(yc, gc)], axis=-1)
        x = x + y @ w_o[l]
        x = x + _cross(_rmsnorm(x, norm_cross[l]), _rmsnorm(mem, norm_mem[l]),
                       w_cq[l], w_ckv[l], w_co[l])
        h = _rmsnorm(x, norm_ffn[l])
        gate, up = jnp.split(h @ w_gu[l], 2, axis=-1)
        x = x + (jax.nn.silu(gate) * up) @ w_down[l]
    return _rmsnorm(x, final_norm)
```

```cpp
#include <hip/hip_runtime.h>
#include <hip/hip_cooperative_groups.h>
#include <cstdio>
#include <cstdint>
namespace cg = cooperative_groups;

#ifndef MK_MULTI
#define MK_MULTI 0
#endif

constexpr int NWAVES = 8, NTHREADS = 512;
constexpr int T_TOK = 32768, SEQ = 8192, NBATCH = 4, DMODEL = 1024, NLAYER = 2, MEMLEN = 256;
constexpr int IN_W = 1956, PROJ_W = 2048, FFN_H = 2816;
constexpr float EPS = 1e-6f, LOG2E = 1.4426950408889634f;
constexpr float SC_MLA = 0.10206207261596575f * 1.4426950408889634f;
constexpr float SC_64 = 0.125f * 1.4426950408889634f;
constexpr float SC_CROSS = 0.08838834764831845f * 1.4426950408889634f;

#define LAS __attribute__((address_space(3)))
typedef unsigned short bf16_t;
typedef float f32x4 __attribute__((ext_vector_type(4)));
typedef float f32x16 __attribute__((ext_vector_type(16)));
typedef short bf16x8 __attribute__((ext_vector_type(8)));
typedef short s16x4 __attribute__((ext_vector_type(4)));
typedef unsigned u32x4 __attribute__((ext_vector_type(4)));
typedef unsigned u32x2 __attribute__((ext_vector_type(2)));
typedef float f32x2_t __attribute__((ext_vector_type(2)));
typedef __bf16 bf16x2_t __attribute__((ext_vector_type(2)));

__device__ __forceinline__ unsigned pk2(float lo, float hi) { f32x2_t v = {lo, hi}; bf16x2_t b = __builtin_convertvector(v, bf16x2_t); return __builtin_bit_cast(unsigned, b); }
__device__ __forceinline__ float bflo(unsigned u) { return __uint_as_float(u << 16); }
__device__ __forceinline__ float bfhi(unsigned u) { return __uint_as_float(u & 0xffff0000u); }
__device__ __forceinline__ float bf2f(bf16_t h) { return __uint_as_float(((unsigned)h) << 16); }
__device__ __forceinline__ float lane_xor(float v, int lane, int m) { return __int_as_float(__builtin_amdgcn_ds_bpermute((lane ^ m) << 2, __float_as_int(v))); }
__device__ __forceinline__ float wave_sum(float v, int lane) {
#pragma unroll
    for (int o = 1; o < 64; o <<= 1) v += lane_xor(v, lane, o);
    return v;
}
__device__ __forceinline__ int lane_now() { int l; asm volatile("v_mbcnt_lo_u32_b32 %0, -1, 0\n\tv_mbcnt_hi_u32_b32 %0, -1, %0" : "=&v"(l)); return l; }
__device__ __forceinline__ int tid_from(int wv) { return wv * 64 + lane_now(); }

#define XB_TMO      128
#define XB_XCNT(j)  (256  + 64 * (j))
#define XB_XSUB(j)  (1280 + 64 * (j))
#define XB_XGEN(j)  (2304 + 64 * (j))
#define XB_TOP      3328
#define XB_TOPGEN   3392
#define XCD_BAR_WORDS 3456
#define XB_SPIN_CAP (1u << 18)


__device__ __forceinline__ unsigned xb_ld(unsigned* p)              { return __hip_atomic_load(p, __ATOMIC_RELAXED, __HIP_MEMORY_SCOPE_AGENT); }
__device__ __forceinline__ unsigned xb_add(unsigned* p, unsigned v) { return __hip_atomic_fetch_add(p, v, __ATOMIC_RELAXED, __HIP_MEMORY_SCOPE_AGENT); }
__device__ __forceinline__ unsigned xb_xcc_id() { return (unsigned)__builtin_amdgcn_s_getreg((3 << 11) | 20) & 0xFu; }
#define XB_SPIN(cond, bar) do { unsigned _sp = 0; while (cond) { __builtin_amdgcn_s_sleep(1); \
    if ((++_sp & 255u) == 0u) { if (xb_ld(&(bar)[XB_TMO])) break; if (_sp > XB_SPIN_CAP) { atomicAdd(&(bar)[XB_TMO], 1u); break; } } } } while (0)

struct XcdBarrier {
    unsigned* bar; unsigned x;
    volatile LAS unsigned* st; int wv;
};

__device__ __forceinline__ XcdBarrier xcd_barrier_post(unsigned* bar, volatile LAS unsigned* st, int wv) {
    XcdBarrier b; b.bar = bar; b.x = xb_xcc_id(); b.st = st; b.wv = wv;
    if (tid_from(wv) == 0) (void)xb_add(&bar[XB_XCNT(b.x)], 1u);
    return b;
}
__device__ __forceinline__ void xcd_barrier_complete(unsigned* bar, unsigned x, unsigned& nloc, unsigned& nx) {
    const unsigned G = gridDim.x * gridDim.y * gridDim.z;
    unsigned sum, cnt, mine, sp = 0u;
    for (;;) {
        sum = 0u; cnt = 0u; mine = 0u;
#pragma unroll
        for (unsigned j = 0; j < 16; ++j) { const unsigned c = xb_ld(&bar[XB_XCNT(j)]); sum += c; cnt += (c > 0u) ? 1u : 0u; mine = (j == x) ? c : mine; }
        if (sum == G) break;
        __builtin_amdgcn_s_sleep(1);
        if ((++sp & 255u) == 0u) { if (xb_ld(&bar[XB_TMO])) break; if (sp > XB_SPIN_CAP) { atomicAdd(&bar[XB_TMO], 1u); break; } }
    }
    nloc = mine > 0u ? mine : 1u; nx = cnt > 0u ? cnt : 1u;
}

__device__ __forceinline__ void xcd_barrier(const XcdBarrier& b) {
    asm volatile("s_waitcnt vmcnt(0)" ::: "memory");
    __syncthreads();
    if (tid_from(b.wv) == 0) {
        unsigned* bar = b.bar;
        __builtin_amdgcn_s_waitcnt(0);
        unsigned nloc = b.st[0], nx = b.st[1];
        if (nloc == 0u) { xcd_barrier_complete(bar, b.x, nloc, nx); b.st[0] = nloc; b.st[1] = nx; }
        const unsigned old = xb_add(&bar[XB_XSUB(b.x)], 1u);
        const unsigned gen = old / nloc;
        if (old + 1u == (gen + 1u) * nloc) {
            __builtin_amdgcn_fence(__ATOMIC_RELEASE, "agent");
            asm volatile("s_waitcnt vmcnt(0)" ::: "memory");
            const unsigned og = xb_add(&bar[XB_TOP], 1u);
            const unsigned tg = og / nx;
            if (og + 1u == (tg + 1u) * nx) xb_add(&bar[XB_TOPGEN], 1u);
            else XB_SPIN(xb_ld(&bar[XB_TOPGEN]) == tg, bar);
            __builtin_amdgcn_fence(__ATOMIC_ACQUIRE, "agent");
            xb_add(&bar[XB_XGEN(b.x)], 1u);
            asm volatile("s_waitcnt vmcnt(0)" ::: "memory");
        } else {
            XB_SPIN(xb_ld(&bar[XB_XGEN(b.x)]) == gen, bar);
            __builtin_amdgcn_fence(__ATOMIC_ACQUIRE, "agent");
            asm volatile("s_waitcnt vmcnt(0)" ::: "memory");
        }
    }
    __syncthreads();
}

namespace pg8 {
#define PG8_LAS __attribute__((address_space(3)))
typedef unsigned short bf16_t;
typedef short bf16x8 __attribute__((ext_vector_type(8)));
typedef float f32x4 __attribute__((ext_vector_type(4)));
typedef unsigned u32x4 __attribute__((ext_vector_type(4)));
constexpr int BM = 256, BK = 64, HALF = 128, HTB = HALF * BK * 2  , STAGE_BYTES = 8 * HTB, NXCD = 8, WGM = 8;

__host__ __device__ __forceinline__ int lds_byte(int r, int c) { const int st = (r >> 4) * 2 + (c >> 5), rr = r & 15, cc = c & 31, ob = rr * 64 + cc * 2; return st * 1024 + (ob ^ (((ob >> 9) & 1) << 5)); }
__host__ __device__ __forceinline__ void stage_rc(int b, int& R, int& C) { const int st = b / 1024, sb = b % 1024, swz = sb ^ (((sb >> 9) & 1) << 5); R = (st >> 1) * 16 + swz / 64; C = (st & 1) * 32 + (swz % 64) / 2; }
__host__ __device__ __forceinline__ int perm32(int rho) { const int n = rho >> 4, i = rho & 15; return 8 * (i >> 2) + 4 * n + (i & 3); }

struct Unit { int pm, pn; };
struct Gemm { const bf16_t* A; const bf16_t* Bt; int M, N, K; int lda; };

struct StaticOrder {
    int nM, nN, nwg, G, c;
    __host__ __device__ void init(int M, int N, int G_, int c_) { nM = M / BM; nN = N / BM; nwg = nM * nN; G = G_; c = c_; }
    __host__ __device__ bool next(int i, Unit& u) const {
        const long L = (long)i * G + c; if (L >= nwg) return false;
        int wgid = (int)L; { const int q = nwg / NXCD, r = nwg % NXCD, xcd = wgid % NXCD, off = wgid / NXCD; wgid = (xcd < r ? xcd * (q + 1) : r * (q + 1) + (xcd - r) * q) + off; }
        const int nig = WGM * nN, gid = wgid / nig, fm = gid * WGM, gsz = (nM - fm) < WGM ? (nM - fm) : WGM;
        u.pm = fm + ((wgid % nig) % gsz); u.pn = (wgid % nig) / gsz; return true;
    }
    __device__ __forceinline__ void a_ready(const Unit&) const {}
    __device__ __forceinline__ void done(const Unit&) const {}
};

__device__ __forceinline__ float row_rstd(const float* RS, int row) {
    const f32x4* p = (const f32x4*)(RS + (size_t)row * 16);
    const f32x4 a = p[0], b = p[1], c = p[2], d = p[3];
    const float s = ((a[0] + a[1]) + (a[2] + a[3])) + ((b[0] + b[1]) + (b[2] + b[3])) + ((c[0] + c[1]) + (c[2] + c[3])) + ((d[0] + d[1]) + (d[2] + d[3]));
    return __builtin_amdgcn_rsqf(s * (1.0f / 1024.0f) + 1e-6f);
}
__device__ __forceinline__ void st_bf8(bf16_t* p, f32x4 a, f32x4 c) { u32x4 w; w.x = ::pk2(a[0], a[1]); w.y = ::pk2(a[2], a[3]); w.z = ::pk2(c[0], c[1]); w.w = ::pk2(c[2], c[3]); *(u32x4*)p = w; }
__device__ __forceinline__ void st_bf4(bf16_t* p, f32x4 v) { u32x2 w; w.x = ::pk2(v[0], v[1]); w.y = ::pk2(v[2], v[3]); *(u32x2*)p = w; }

template <bool HAS_RS> struct EpiScaleBf16 {
    static constexpr bool PERM = true, AFTER_DRAIN = false, RESCALE = false;
    bf16_t* O; int ldc; const float* RS;
    __device__ __forceinline__ void operator()(const f32x4 (&acc)[2][2][4][2], const Unit& u, int wr, int wc, int fr, int fq) const {
        { int t2_ = (wr * 4 + wc) * 64 + ::lane_now(); asm volatile("" : "+v"(t2_)); fr = t2_ & 15; fq = (t2_ >> 4) & 3; }
        const int row0 = u.pm * BM + wr * 64 + fr, col0 = u.pn * BM + wc * 32 + 8 * fq;
#pragma unroll
        for (int ai = 0; ai < 2; ++ai)
#pragma unroll
            for (int m = 0; m < 4; ++m) {
                const int row = row0 + ai * HALF + m * 16;
                const float sc = HAS_RS ? row_rstd(RS, row) : 1.0f;
                bf16_t* rowp = O + (size_t)row * ldc;
#pragma unroll
                for (int bj = 0; bj < 2; ++bj) st_bf8(rowp + col0 + bj * HALF, acc[ai][bj][m][0] * sc, acc[ai][bj][m][1] * sc);
            }
    }
};
struct EpiQRope {
    static constexpr bool PERM = false, AFTER_DRAIN = false, RESCALE = false;
    bf16_t* O; int ldc; const float* rope;
    __device__ __forceinline__ void operator()(const f32x4 (&acc)[2][2][4][2], const Unit& u, int wr, int wc, int fr, int fq) const {
        { int t2_ = (wr * 4 + wc) * 64 + ::lane_now(); asm volatile("" : "+v"(t2_)); fr = t2_ & 15; fq = (t2_ >> 4) & 3; }
        const int row0 = u.pm * BM + wr * 64 + fr, col0 = u.pn * BM + wc * 32 + 4 * fq;
#pragma unroll
        for (int ai = 0; ai < 2; ++ai)
#pragma unroll
            for (int m = 0; m < 4; ++m) {
                const int row = row0 + ai * HALF + m * 16, pos = row & (::SEQ - 1);
                bf16_t* rowp = O + (size_t)row * ldc;
#pragma unroll
                for (int bj = 0; bj < 2; ++bj) {
                    const int c = col0 + bj * HALF;
                    if (c >= 384) continue;
                    f32x4 v0 = acc[ai][bj][m][0], v1 = acc[ai][bj][m][1];
                    if (((c >> 5) % 3) == 2) {
                        const f32x4* rp = (const f32x4*)(rope + ((size_t)pos * 16 + 4 * fq) * 2);
                        const f32x4 cs0 = rp[0], cs1 = rp[1];
                        const float co[4] = {cs0[0], cs0[2], cs1[0], cs1[2]}, si[4] = {cs0[1], cs0[3], cs1[1], cs1[3]};
                        f32x4 a, b;
#pragma unroll
                        for (int i = 0; i < 4; ++i) { a[i] = v0[i] * co[i] - v1[i] * si[i]; b[i] = v0[i] * si[i] + v1[i] * co[i]; }
                        v0 = a; v1 = b;
                    }
                    st_bf4(rowp + c, v0); st_bf4(rowp + c + 16, v1);
                }
            }
    }
};
struct EpiResidual {
    static constexpr bool PERM = true, AFTER_DRAIN = false, RESCALE = false;
    const bf16_t* XI; bf16_t* XB; float* RS; bool stats;
    __device__ __forceinline__ void operator()(const f32x4 (&acc)[2][2][4][2], const Unit& u, int wr, int wc, int fr, int fq) const {
        { int t2_ = (wr * 4 + wc) * 64 + ::lane_now(); asm volatile("" : "+v"(t2_)); fr = t2_ & 15; fq = (t2_ >> 4) & 3; }
        const int row0 = u.pm * BM + wr * 64 + fr, col0 = u.pn * BM + wc * 32 + 8 * fq;
#pragma unroll
        for (int ai = 0; ai < 2; ++ai)
#pragma unroll
            for (int m = 0; m < 4; ++m) {
                const int row = row0 + ai * HALF + m * 16;
                const size_t ro = (size_t)row * ::DMODEL;
                float ss = 0.f;
#pragma unroll
                for (int bj = 0; bj < 2; ++bj) {
                    const int c = col0 + bj * HALF;
                    const u32x4 xo = *(const u32x4*)(XI + ro + c);
                    const f32x4 x0 = (f32x4){::bflo(xo.x), ::bfhi(xo.x), ::bflo(xo.y), ::bfhi(xo.y)} + acc[ai][bj][m][0];
                    const f32x4 x1 = (f32x4){::bflo(xo.z), ::bfhi(xo.z), ::bflo(xo.w), ::bfhi(xo.w)} + acc[ai][bj][m][1];
                    st_bf8(XB + ro + c, x0, x1);
                    ss += ((x0[0] * x0[0] + x0[1] * x0[1]) + (x0[2] * x0[2] + x0[3] * x0[3])) + ((x1[0] * x1[0] + x1[1] * x1[1]) + (x1[2] * x1[2] + x1[3] * x1[3]));
                }
                { const int ln_ = fq * 16 + fr; ss += ::lane_xor(ss, ln_, 16); ss += ::lane_xor(ss, ln_, 32); }
                if (stats && fq == 0) RS[(size_t)row * 16 + u.pn * 4 + wc] = ss;
            }
    }
};
struct EpiSwiGLU {
    static constexpr bool PERM = true, AFTER_DRAIN = false, RESCALE = false;
    bf16_t* O; const float* RS;
    __device__ __forceinline__ void operator()(const f32x4 (&acc)[2][2][4][2], const Unit& u, int wr, int wc, int fr, int fq) const {
        { int t2_ = (wr * 4 + wc) * 64 + ::lane_now(); asm volatile("" : "+v"(t2_)); fr = t2_ & 15; fq = (t2_ >> 4) & 3; }
        const int row0 = u.pm * BM + wr * 64 + fr, col0 = u.pn * HALF + wc * 32 + 8 * fq;
#pragma unroll
        for (int ai = 0; ai < 2; ++ai)
#pragma unroll
            for (int m = 0; m < 4; ++m) {
                const int row = row0 + ai * HALF + m * 16;
                const float sc = row_rstd(RS, row);
                bf16_t* rowp = O + (size_t)row * ::FFN_H;
                f32x4 r2[2];
#pragma unroll
                for (int n = 0; n < 2; ++n) {
                    const f32x4 g = acc[ai][0][m][n] * sc, up = acc[ai][1][m][n] * sc;
#pragma unroll
                    for (int i = 0; i < 4; ++i) r2[n][i] = g[i] * __builtin_amdgcn_rcpf(1.0f + __builtin_amdgcn_exp2f(-g[i] * 1.4426950408889634f)) * up[i];
                }
                st_bf8(rowp + col0, r2[0], r2[1]);
            }
    }
};
struct EpiSplitQKV {
    static constexpr bool PERM = true, AFTER_DRAIN = false, RESCALE = false;
    bf16_t* QM; bf16_t* KV; const float* RSQ; const float* RSKV;
    __device__ __forceinline__ void operator()(const f32x4 (&acc)[2][2][4][2], const Unit& u, int wr, int wc, int fr, int fq) const {
        { int t2_ = (wr * 4 + wc) * 64 + ::lane_now(); asm volatile("" : "+v"(t2_)); fr = t2_ & 15; fq = (t2_ >> 4) & 3; }
        const bool isq = u.pn < 2;
        bf16_t* O = isq ? QM : KV; const int ldc = isq ? 512 : 768;
        const int row0 = u.pm * BM + wr * 64 + fr, col0 = (isq ? u.pn : u.pn - 2) * BM + wc * 32 + 8 * fq;
#pragma unroll
        for (int ai = 0; ai < 2; ++ai)
#pragma unroll
            for (int m = 0; m < 4; ++m) {
                const int row = row0 + ai * HALF + m * 16;
                const f32x4 ps = *(const f32x4*)((isq ? RSQ : RSKV) + (size_t)row * 4);
                const float sc = __builtin_amdgcn_rsqf(((ps[0] + ps[1]) + (ps[2] + ps[3])) * (isq ? 1.0f / 256.0f : 1.0f / 128.0f) + 1e-6f);
                bf16_t* rowp = O + (size_t)row * ldc;
#pragma unroll
                for (int bj = 0; bj < 2; ++bj) st_bf8(rowp + col0 + bj * HALF, acc[ai][bj][m][0] * sc, acc[ai][bj][m][1] * sc);
            }
    }
};
struct EpiResidualY {
    static constexpr bool PERM = true, AFTER_DRAIN = false, RESCALE = true;
    const bf16_t* XI; bf16_t* XB; float* RS; const float* SSQ;
    __device__ __forceinline__ static void group_rstd(const float* SSQ, int row, float& ra, float& rb, float& rc) {
        const f32x4* p = (const f32x4*)(SSQ + (size_t)row * 12);
        const f32x4 a = p[0], b = p[1], c = p[2];
        ra = __builtin_amdgcn_rsqf(((a[0] + a[1]) + (a[2] + a[3])) * (1.0f / 512.0f) + 1e-6f);
        rb = __builtin_amdgcn_rsqf(((b[0] + b[1]) + (b[2] + b[3])) * (1.0f / 256.0f) + 1e-6f);
        rc = __builtin_amdgcn_rsqf(((c[0] + c[1]) + (c[2] + c[3])) * (1.0f / 256.0f) + 1e-6f);
    }
    __device__ __forceinline__ void rescale(f32x4 (&acc)[2][2][4][2], const Unit& u, int t, int wr, int wc) const {
        int fr, fq; { int t2_ = (wr * 4 + wc) * 64 + ::lane_now(); asm volatile("" : "+v"(t2_)); fr = t2_ & 15; fq = (t2_ >> 4) & 3; } (void)fq;
        const int row0 = u.pm * BM + wr * 64 + fr;
#pragma unroll
        for (int ai = 0; ai < 2; ++ai)
#pragma unroll
            for (int m = 0; m < 4; ++m) {
                float ra, rb, rc; group_rstd(SSQ, row0 + ai * HALF + m * 16, ra, rb, rc);
                const float f = (t == 8) ? ra * __builtin_amdgcn_rcpf(rb) : rb * __builtin_amdgcn_rcpf(rc);
#pragma unroll
                for (int bj = 0; bj < 2; ++bj)
#pragma unroll
                    for (int n = 0; n < 2; ++n) acc[ai][bj][m][n] = acc[ai][bj][m][n] * f;
            }
    }
    __device__ __forceinline__ void operator()(const f32x4 (&acc)[2][2][4][2], const Unit& u, int wr, int wc, int fr, int fq) const {
        { int t2_ = (wr * 4 + wc) * 64 + ::lane_now(); asm volatile("" : "+v"(t2_)); fr = t2_ & 15; fq = (t2_ >> 4) & 3; }
        const int row0 = u.pm * BM + wr * 64 + fr, col0 = u.pn * BM + wc * 32 + 8 * fq;
#pragma unroll
        for (int ai = 0; ai < 2; ++ai)
#pragma unroll
            for (int m = 0; m < 4; ++m) {
                const int row = row0 + ai * HALF + m * 16;
                const size_t ro = (size_t)row * ::DMODEL;
                float ra, rb, rc; group_rstd(SSQ, row, ra, rb, rc); (void)ra; (void)rb;
                float ss = 0.f;
#pragma unroll
                for (int bj = 0; bj < 2; ++bj) {
                    const int c = col0 + bj * HALF;
                    const u32x4 xo = *(const u32x4*)(XI + ro + c);
                    const f32x4 x0 = (f32x4){::bflo(xo.x), ::bfhi(xo.x), ::bflo(xo.y), ::bfhi(xo.y)} + acc[ai][bj][m][0] * rc;
                    const f32x4 x1 = (f32x4){::bflo(xo.z), ::bfhi(xo.z), ::bflo(xo.w), ::bfhi(xo.w)} + acc[ai][bj][m][1] * rc;
                    st_bf8(XB + ro + c, x0, x1);
                    ss += ((x0[0] * x0[0] + x0[1] * x0[1]) + (x0[2] * x0[2] + x0[3] * x0[3])) + ((x1[0] * x1[0] + x1[1] * x1[1]) + (x1[2] * x1[2] + x1[3] * x1[3]));
                }
                { const int ln_ = fq * 16 + fr; ss += ::lane_xor(ss, ln_, 16); ss += ::lane_xor(ss, ln_, 32); }
                if (fq == 0) RS[(size_t)row * 16 + u.pn * 4 + wc] = ss;
            }
    }
};
struct EpiWin {
    static constexpr bool PERM = true, AFTER_DRAIN = false, RESCALE = false;
    bf16_t* O; const float* RS; float* RSQ; float* RSKV; bf16_t* KPE; float* LF; const float* rope; const float* fb;
    __device__ __forceinline__ void operator()(const f32x4 (&acc)[2][2][4][2], const Unit& u, int wr, int wc, int fr, int fq) const {
        { int t2_ = (wr * 4 + wc) * 64 + ::lane_now(); asm volatile("" : "+v"(t2_)); fr = t2_ & 15; fq = (t2_ >> 4) & 3; }
        const int row0 = u.pm * BM + wr * 64 + fr, col0 = u.pn * BM + wc * 32 + 8 * fq, ln_ = fq * 16 + fr;
#pragma unroll
        for (int ai = 0; ai < 2; ++ai)
#pragma unroll
            for (int m = 0; m < 4; ++m) {
                const int row = row0 + ai * HALF + m * 16;
                const float sc = row_rstd(RS, row);
                bf16_t* rowp = O + (size_t)row * ::PROJ_W;
                f32x4 v[2][2];
#pragma unroll
                for (int bj = 0; bj < 2; ++bj)
#pragma unroll
                    for (int n = 0; n < 2; ++n) v[bj][n] = acc[ai][bj][m][n] * sc;
#pragma unroll
                for (int bj = 0; bj < 2; ++bj) st_bf8(rowp + col0 + bj * HALF, v[bj][0], v[bj][1]);
                if (u.pn < 2) {
                    float s0 = 0.f, s1 = 0.f;
#pragma unroll
                    for (int n = 0; n < 2; ++n)
#pragma unroll
                        for (int i = 0; i < 4; ++i) { s0 += v[0][n][i] * v[0][n][i]; s1 += v[1][n][i] * v[1][n][i]; }
                    float ss = (u.pn == 0) ? s0 + s1 : s0;
                    ss += ::lane_xor(ss, ln_, 16); ss += ::lane_xor(ss, ln_, 32);
                    if (fq == 0) { if (u.pn == 0) RSQ[(size_t)row * 4 + wc] = ss; else RSKV[(size_t)row * 4 + wc] = ss; }
                    if (u.pn == 1 && wc == 0) {
                        const int pos = row & (::SEQ - 1), jb = 8 * (fq & 1);
                        const f32x4* rp = (const f32x4*)(rope + ((size_t)pos * 16 + jb) * 2);
                        f32x4 o2[2];
#pragma unroll
                        for (int n = 0; n < 2; ++n) { const f32x4 csA = rp[2 * n], csB = rp[2 * n + 1];
                            const float co[4] = {csA[0], csA[2], csB[0], csB[2]}, si[4] = {csA[1], csA[3], csB[1], csB[3]};
#pragma unroll
                            for (int i = 0; i < 4; ++i) { const float mine = v[1][n][i], oth = ::lane_xor(mine, ln_, 32);
                                o2[n][i] = (fq < 2) ? mine * co[i] - oth * si[i] : oth * si[i] + mine * co[i]; } }
                        st_bf8(KPE + (size_t)row * 32 + 8 * fq, o2[0], o2[1]);
                    }
                    if (u.pn == 1 && wc == 1 && fq == 0) {
                        f32x4 lf;
#pragma unroll
                        for (int i = 0; i < 4; ++i) { const float z = v[1][0][i] + fb[i]; lf[i] = 1.4426950408889634f * (fminf(z, 0.f) - log1pf(expf(-fabsf(z)))); }
                        *(f32x4*)(LF + (size_t)row * 4) = lf;
                    }
                }
            }
    }
};
template <class Epi, class Sched, bool ALIGN_EPI = false, bool SP2 = false>
__device__ __forceinline__ void gemm_phase(PG8_LAS unsigned char* lds, const Gemm g, const Sched& S, const Epi& E, int wv) {
    int tid_l = ::tid_from(wv); asm volatile("" : "+v"(tid_l));
    const int tid = tid_l, wid = wv, lane = tid & 63, wr = wid >> 2, wc = wid & 3, fr = lane & 15, fq = lane >> 4;
    const int K = g.K, nt = K / BK, lda = g.lda ? g.lda : K;
    unsigned voffA[2], voffB[2];
#pragma unroll
    for (int i = 0; i < 2; ++i) { int R, C; stage_rc(tid * 16 + i * 8192, R, C); const int Rb = Epi::PERM ? ((R & ~31) + perm32(R & 31)) : R;
        voffA[i] = (unsigned)(R * lda + C) * 2u; voffB[i] = (unsigned)(Rb * K + C) * 2u; }
    const size_t kstep = (size_t)(BK * 2);
    const size_t hstep = (size_t)HALF * K * 2;
    const size_t tstep = 2 * hstep;
    const size_t hstepA = (size_t)HALF * lda * 2, tstepA = 2 * hstepA;
    const unsigned ldsw = (unsigned)wid * 1024u;
    const int aoff = lds_byte(wr * 64 + fr, fq * 8), boff = lds_byte(wc * 32 + fr, fq * 8);
#define PG8_SA(b, h) (((b) * 2 + (h)) * HTB)
#define PG8_SB(b, h) ((4 + (b) * 2 + (h)) * HTB)
#define PG8_STAGE(bufoff, gbase, voff) do { _Pragma("unroll") for (int _i = 0; _i < 2; ++_i) \
        __builtin_amdgcn_global_load_lds((const unsigned*)((const char*)(gbase) + (voff)[_i]), (PG8_LAS unsigned*)(lds + (bufoff) + ldsw + _i * 8192), 16, 0, 0); } while (0)
#define PG8_LDA(dst, b, h) do { _Pragma("unroll") for (int m = 0; m < 4; ++m) _Pragma("unroll") for (int k = 0; k < 2; ++k) dst[m][k] = *(const PG8_LAS bf16x8*)(lds + PG8_SA(b, h) + aoff + m * 2048 + k * 1024); } while (0)
#define PG8_LDB(dst, b, h) do { _Pragma("unroll") for (int n = 0; n < 2; ++n) _Pragma("unroll") for (int k = 0; k < 2; ++k) dst[n][k] = *(const PG8_LAS bf16x8*)(lds + PG8_SB(b, h) + boff + n * 2048 + k * 1024); } while (0)
#define PG8_MMA(ai, bj, At, Bt) do { __builtin_amdgcn_s_setprio(1); _Pragma("unroll") for (int m = 0; m < 4; ++m) _Pragma("unroll") for (int n = 0; n < 2; ++n) _Pragma("unroll") for (int k = 0; k < 2; ++k) \
        acc[ai][bj][m][n] = __builtin_amdgcn_mfma_f32_16x16x32_bf16(Bt[n][k], At[m][k], acc[ai][bj][m][n], 0, 0, 0); __builtin_amdgcn_s_setprio(0); } while (0)
#define PG8_WAIT_V(n) asm volatile("s_waitcnt vmcnt(" #n ")" ::: "memory")
#define PG8_WAIT_L(n) asm volatile("s_waitcnt lgkmcnt(" #n ")" ::: "memory")
#define PG8_BAR __builtin_amdgcn_s_barrier()
#define PG8_SCHED __builtin_amdgcn_sched_barrier(0)
    Unit cur, nxt; int ui = 0;
    if (!S.next(0, cur)) return;
    f32x4 acc[2][2][4][2];
#pragma unroll
    for (int a = 0; a < 2; ++a)
#pragma unroll
        for (int b = 0; b < 2; ++b)
#pragma unroll
            for (int m = 0; m < 4; ++m)
#pragma unroll
                for (int n = 0; n < 2; ++n) acc[a][b][m][n] = (f32x4){0.f, 0.f, 0.f, 0.f};
    bf16x8 At[4][2], B0[2][2], B1[2][2];
    const char* cA = (const char*)g.A + (size_t)cur.pm * tstepA; const char* cB = (const char*)g.Bt + (size_t)cur.pn * tstep;
    S.a_ready(cur);
    if constexpr (SP2) {
        PG8_STAGE(PG8_SB(0, 0), cB, voffB); PG8_STAGE(PG8_SB(0, 1), cB + hstep, voffB); PG8_STAGE(PG8_SA(0, 0), cA, voffA); PG8_STAGE(PG8_SA(0, 1), cA + hstepA, voffA);
        if (wr == 1) PG8_BAR;
        PG8_WAIT_V(2); PG8_BAR;
        PG8_STAGE(PG8_SB(1, 0), cB + kstep, voffB); PG8_STAGE(PG8_SA(1, 0), cA + kstep, voffA); PG8_STAGE(PG8_SB(1, 1), cB + hstep + kstep, voffB);
        PG8_WAIT_V(6); PG8_BAR;
    } else {
        PG8_STAGE(PG8_SB(0, 0), cB, voffB); PG8_STAGE(PG8_SA(0, 0), cA, voffA); PG8_STAGE(PG8_SB(0, 1), cB + hstep, voffB); PG8_STAGE(PG8_SA(0, 1), cA + hstepA, voffA);
        if (wr == 1) PG8_BAR;
        PG8_WAIT_V(4); PG8_BAR;
        PG8_STAGE(PG8_SB(1, 0), cB + kstep, voffB); PG8_STAGE(PG8_SA(1, 0), cA + kstep, voffA); PG8_STAGE(PG8_SB(1, 1), cB + hstep + kstep, voffB);
        PG8_WAIT_V(6); PG8_BAR;
    }
    for (;;) {
        const bool has_next = S.next(ui + 1, nxt);
        const char* nA = has_next ? (const char*)g.A + (size_t)nxt.pm * tstepA : cA; const char* nB = has_next ? (const char*)g.Bt + (size_t)nxt.pn * tstep : cB;
        for (int t = 0; t < nt; t += 2) {
            if constexpr (Epi::RESCALE) { if (t == 8 || t == 12) E.rescale(acc, cur, t, wr, wc); }
            const bool last = (t == nt - 2);
            const char* a1 = cA + (size_t)(t + 1) * kstep;
            const char* a2 = last ? nA : cA + (size_t)(t + 2) * kstep; const char* b2 = last ? nB : cB + (size_t)(t + 2) * kstep;
            const char* a3 = a2 + kstep; const char* b3 = b2 + kstep;
            if (last && has_next) S.a_ready(nxt);
            if constexpr (SP2) {
            PG8_LDB(B0, 0, 0); PG8_LDB(B1, 0, 1); PG8_SCHED; PG8_LDA(At, 0, 0); PG8_STAGE(PG8_SA(1, 1), a1 + hstepA, voffA);
            PG8_WAIT_V(8); PG8_WAIT_L(0); PG8_BAR; PG8_MMA(0, 0, At, B0); PG8_MMA(0, 1, At, B1); PG8_BAR; PG8_SCHED;
            PG8_LDA(At, 0, 1); PG8_STAGE(PG8_SB(0, 0), b2, voffB); PG8_STAGE(PG8_SB(0, 1), b2 + hstep, voffB); PG8_STAGE(PG8_SA(0, 0), a2, voffA);
            PG8_WAIT_V(8); PG8_WAIT_L(0); PG8_BAR; PG8_MMA(1, 0, At, B0); PG8_MMA(1, 1, At, B1); PG8_BAR; PG8_SCHED;
            PG8_LDB(B0, 1, 0); PG8_LDB(B1, 1, 1); PG8_SCHED; PG8_LDA(At, 1, 0); PG8_STAGE(PG8_SA(0, 1), a2 + hstepA, voffA);
            PG8_WAIT_V(8); PG8_WAIT_L(0); PG8_BAR; PG8_MMA(0, 0, At, B0); PG8_MMA(0, 1, At, B1); PG8_BAR; PG8_SCHED;
            PG8_LDA(At, 1, 1); PG8_STAGE(PG8_SB(1, 0), b3, voffB); PG8_STAGE(PG8_SB(1, 1), b3 + hstep, voffB); PG8_STAGE(PG8_SA(1, 0), a3, voffA);
            PG8_WAIT_V(8); PG8_WAIT_L(0); PG8_BAR; PG8_MMA(1, 0, At, B0); PG8_MMA(1, 1, At, B1); PG8_BAR; PG8_SCHED;
            } else {
            PG8_LDB(B0, 0, 0); PG8_SCHED; PG8_LDA(At, 0, 0); PG8_STAGE(PG8_SA(1, 1), a1 + hstepA, voffA);
            PG8_WAIT_L(8); PG8_BAR; PG8_WAIT_L(0); PG8_MMA(0, 0, At, B0); PG8_BAR; PG8_SCHED;
            PG8_LDB(B1, 0, 1); PG8_STAGE(PG8_SB(0, 0), b2, voffB);
            PG8_BAR; PG8_WAIT_L(0); PG8_MMA(0, 1, At, B1); PG8_BAR;
            PG8_LDA(At, 0, 1); PG8_STAGE(PG8_SA(0, 0), a2, voffA);
            PG8_BAR; PG8_WAIT_L(0); PG8_MMA(1, 0, At, B0); PG8_BAR; PG8_SCHED;
            PG8_STAGE(PG8_SB(0, 1), b2 + hstep, voffB);
            PG8_WAIT_V(6); PG8_BAR; PG8_MMA(1, 1, At, B1); PG8_BAR;
            PG8_LDB(B0, 1, 0); PG8_SCHED; PG8_LDA(At, 1, 0); PG8_STAGE(PG8_SA(0, 1), a2 + hstepA, voffA);
            PG8_WAIT_L(8); PG8_BAR; PG8_WAIT_L(0); PG8_MMA(0, 0, At, B0); PG8_BAR; PG8_SCHED;
            PG8_LDB(B1, 1, 1); PG8_STAGE(PG8_SB(1, 0), b3, voffB);
            PG8_BAR; PG8_WAIT_L(0); PG8_MMA(0, 1, At, B1); PG8_BAR;
            PG8_LDA(At, 1, 1); PG8_STAGE(PG8_SA(1, 0), a3, voffA);
            PG8_BAR; PG8_WAIT_L(0); PG8_MMA(1, 0, At, B0); PG8_BAR; PG8_SCHED;
            PG8_STAGE(PG8_SB(1, 1), b3 + hstep, voffB);
            PG8_WAIT_V(6); PG8_BAR; PG8_MMA(1, 1, At, B1); PG8_BAR;
            }
        }
        if constexpr (ALIGN_EPI) { if (wr == 0) PG8_BAR; }
        if constexpr (!Epi::AFTER_DRAIN) { E(acc, cur, wr, wc, fr, fq); S.done(cur); }
        if (!has_next) break;
#pragma unroll
        for (int a = 0; a < 2; ++a)
#pragma unroll
            for (int b = 0; b < 2; ++b)
#pragma unroll
                for (int m = 0; m < 4; ++m)
#pragma unroll
                    for (int n = 0; n < 2; ++n) acc[a][b][m][n] = (f32x4){0.f, 0.f, 0.f, 0.f};
        cur = nxt; cA = nA; cB = nB; ++ui;
        if constexpr (ALIGN_EPI) { if (wr == 1) PG8_BAR; }
    }
    PG8_WAIT_V(0);
    if constexpr (!ALIGN_EPI) { if (wr == 0) PG8_BAR; }
    PG8_BAR;
    if constexpr (Epi::AFTER_DRAIN) { E.fused(acc, cur, wr, wc, fr, fq, lds, wid, lane); S.done(cur); }
#undef PG8_SA
#undef PG8_SB
#undef PG8_STAGE
#undef PG8_LDA
#undef PG8_LDB
#undef PG8_MMA
#undef PG8_WAIT_V
#undef PG8_WAIT_L
#undef PG8_BAR
#undef PG8_SCHED
}
}
constexpr size_t MiB = 1u << 20;
constexpr size_t WS_W = 0, W_LAYER = 28 * MiB;
constexpr size_t WO_IN = 0, WO_UQ = 4 * MiB, WO_UKV = 4 * MiB + 512 * 1024, WO_O = 5 * MiB, WO_CQ = 7 * MiB, WO_CKV = 8 * MiB, WO_CO = 10 * MiB, WO_GU = 11 * MiB, WO_DOWN = 22 * MiB;
constexpr size_t WS_XB = 56 * MiB;
constexpr size_t WS_RS = 120 * MiB;
constexpr size_t WS_KPE = 122 * MiB;
constexpr size_t WS_LC = 124 * MiB;
constexpr size_t WS_CUM = 124 * MiB + 512 * 1024;
constexpr size_t WS_TOT = 125 * MiB;
constexpr size_t WS_ROPE = 125 * MiB + 512 * 1024;
constexpr size_t WS_MEMN = 127 * MiB;
constexpr size_t WS_KVMEM = 129 * MiB;
constexpr size_t WS_PROJ = 134 * MiB;
constexpr size_t WS_CQN = 262 * MiB;
constexpr size_t WS_CKVN = 278 * MiB;
constexpr size_t WS_QM = 294 * MiB;
constexpr size_t WS_HID = 134 * MiB;
constexpr size_t WS_KV = 326 * MiB;
constexpr size_t WS_Y = 374 * MiB;
constexpr size_t WS_SSQ = 438 * MiB;
constexpr size_t WS_RSQ = 440 * MiB;
constexpr size_t WS_RSKV = 440 * MiB + 512 * 1024;
constexpr size_t WS_BAR = 441 * MiB;
constexpr size_t WS_XB2 = 442 * MiB;
constexpr size_t WS_END = 506 * MiB;

constexpr int LDS_BYTES = 131072 + 4096;

struct Args { const float* in[21]; float* out; unsigned char* ws; int ph_lo, ph_hi; };
typedef const __attribute__((address_space(4))) Args* KArgs;

__device__ __forceinline__ int conv_map(int type, int n, float& sc) {
    sc = 1.0f;
    switch (type) {
    case 0:
        if (n < 416) return n;
        if (n < 420) return 1184 + (n - 416);
        if (n < 512) return -1;
        if (n < 1280) { if (n < 768) sc = SC_64; return 416 + (n - 512); }
        if (n < 1536) sc = SC_64;
        return 1188 + (n - 1280);
    case 1: sc = SC_MLA; return n < 384 ? n : -1;
    case 2: if (n < 256) return (n >> 6) * 192 + (n & 63); else { const int mm = n - 256; return (mm >> 7) * 192 + 64 + (mm & 127); }
    case 4: sc = SC_CROSS; return n;
    case 7: { const int t = n >> 8, c = n & 255; return c < 128 ? 128 * t + c : FFN_H + 128 * t + (c - 128); }
    default: return n;
    }
}
__device__ __forceinline__ void conv_tile(const float* src, const float* gain, bf16_t* dst, int K, int Nsrc, int Nd, int Kd, int type, int tile, LAS float* scr, int wv, int koff = 0) {
    int tid_l = tid_from(wv); asm volatile("" : "+v"(tid_l));
    const int tid = tid_l, ntn = Nd >> 8, kb = tile / ntn, nb = tile - kb * ntn, k0 = kb * 64, n0 = nb * 256;
    { const int nn = tid & 255, kh = tid >> 8; float sc; const int sn = conv_map(type, n0 + nn, sc);
      const float* sp = src + (size_t)(k0 + kh - koff) * Nsrc + (sn >= 0 ? sn : 0);
#pragma unroll 8
      for (int i = 0; i < 32; ++i) { const int kk = kh + 2 * i, k = k0 + kk; float v = 0.f;
          if (sn >= 0 && k >= koff && k - koff < K) { v = __builtin_nontemporal_load(sp + (size_t)(2 * i) * Nsrc) * sc; if (gain) v *= gain[k - koff]; }
          scr[nn * 65 + kk] = v; } }
    __syncthreads();
#pragma unroll
    for (int j = 0; j < 4; ++j) { const int idx = tid + 512 * j, nn = idx >> 3, kq = (idx & 7) * 8; const LAS float* s = scr + nn * 65 + kq;
      u32x4 o; o.x = pk2(s[0], s[1]); o.y = pk2(s[2], s[3]); o.z = pk2(s[4], s[5]); o.w = pk2(s[6], s[7]);
      *(u32x4*)(dst + (size_t)(n0 + nn) * Kd + k0 + kq) = o; }
    __syncthreads();
}
__device__ __forceinline__ void phase_prologue(KArgs a, LAS unsigned char* lds, int wv, int part) {
    LAS float* scr = (LAS float*)lds;
    unsigned char* ws = a->ws;
    int tid_l = tid_from(wv); asm volatile("" : "+v"(tid_l));
    const int tid = tid_l, lane = tid & 63, wave = tid >> 6;
    constexpr int NT_L = 128 + 12 + 18 + 64 + 32 + 64 + 32 + 352 + 176;
    const int g_lo = part == 0 ? 0 : 128, g_hi = part == 0 ? 128 : NLAYER * NT_L;
    for (int g = g_lo + blockIdx.x; g < g_hi; g += gridDim.x) {
        const int l = g / NT_L; int r = g - l * NT_L;
        bf16_t* wb = (bf16_t*)(ws + WS_W + (size_t)l * W_LAYER);
        if (r < 128) { conv_tile(a->in[3] + (size_t)l * 1024 * IN_W, a->in[2] + l * 1024, (bf16_t*)((unsigned char*)wb + WO_IN), 1024, IN_W, 2048, 1024, 0, r, scr, wv); continue; } r -= 128;
        if (r < 12) { conv_tile(a->in[5] + (size_t)l * 256 * 384, a->in[4] + l * 256, (bf16_t*)((unsigned char*)wb + WO_UQ), 256, 384, 512, 384, 1, r, scr, wv); continue; } r -= 12;
        if (r < 18) { conv_tile(a->in[7] + (size_t)l * 128 * 768, a->in[6] + l * 128, (bf16_t*)((unsigned char*)wb + WO_UQ) + (size_t)512 * 384, 128, 768, 768, 384, 2, r, scr, wv, 256); continue; } r -= 18;
        if (r < 64) { conv_tile(a->in[11] + (size_t)l * 1024 * 1024, a->in[10] + l * 1024, (bf16_t*)((unsigned char*)wb + WO_O), 1024, 1024, 1024, 1024, 3, r, scr, wv); continue; } r -= 64;
        if (r < 32) { conv_tile(a->in[14] + (size_t)l * 1024 * 512, a->in[12] + l * 1024, (bf16_t*)((unsigned char*)wb + WO_CQ), 1024, 512, 512, 1024, 4, r, scr, wv); continue; } r -= 32;
        if (r < 64) { conv_tile(a->in[15] + (size_t)l * 1024 * 1024, a->in[13] + l * 1024, (bf16_t*)((unsigned char*)wb + WO_CKV), 1024, 1024, 1024, 1024, 5, r, scr, wv); continue; } r -= 64;
        if (r < 32) { conv_tile(a->in[16] + (size_t)l * 512 * 1024, nullptr, (bf16_t*)((unsigned char*)wb + WO_CO), 512, 1024, 1024, 512, 6, r, scr, wv); continue; } r -= 32;
        if (r < 352) { conv_tile(a->in[18] + (size_t)l * 1024 * 2 * FFN_H, a->in[17] + l * 1024, (bf16_t*)((unsigned char*)wb + WO_GU), 1024, 2 * FFN_H, 2 * FFN_H, 1024, 7, r, scr, wv); continue; } r -= 352;
        conv_tile(a->in[19] + (size_t)l * FFN_H * 1024, nullptr, (bf16_t*)((unsigned char*)wb + WO_DOWN), FFN_H, 1024, 1024, FFN_H, 8, r, scr, wv);
    }
    if (part != 0) return;
    const int gw = blockIdx.x * NWAVES + wave, ngw = gridDim.x * NWAVES;
    bf16_t* XB = (bf16_t*)(ws + WS_XB); float* RS = (float*)(ws + WS_RS); bf16_t* MEMN = (bf16_t*)(ws + WS_MEMN);
    for (int row = gw; row < T_TOK + NBATCH * MEMLEN; row += ngw) {
        const bool ismem = row >= T_TOK; const int rr = ismem ? row - T_TOK : row;
        const f32x4* xr = (const f32x4*)((ismem ? a->in[1] : a->in[0]) + (size_t)rr * DMODEL) + lane;
        f32x4 v[4]; float s = 0.f;
#pragma unroll
        for (int j = 0; j < 4; ++j) { v[j] = __builtin_nontemporal_load(xr + 64 * j); s += (v[j][0] * v[j][0] + v[j][1] * v[j][1]) + (v[j][2] * v[j][2] + v[j][3] * v[j][3]); }
        s = wave_sum(s, lane);
        float sc = 1.0f;
        if (ismem) sc = __builtin_amdgcn_rsqf(s * (1.0f / 1024.0f) + EPS);
        else if (lane < 16) RS[(size_t)rr * 16 + lane] = lane == 0 ? s : 0.f;
        u32x2* o8 = (u32x2*)((ismem ? MEMN : XB) + (size_t)rr * DMODEL) + lane;
#pragma unroll
        for (int j = 0; j < 4; ++j) { u32x2 w; w.x = pk2(v[j][0] * sc, v[j][1] * sc); w.y = pk2(v[j][2] * sc, v[j][3] * sc); o8[64 * j] = w; }
    }
    float* rope = (float*)(ws + WS_ROPE);
    for (int i = blockIdx.x * NTHREADS + tid; i < SEQ * 16; i += gridDim.x * NTHREADS) {
        const int pos = i >> 4, j = i & 15;
        const float inv = powf(10000.0f, -(float)(2 * j) / 32.0f), ang = (float)pos * inv;
        rope[2 * i] = cosf(ang); rope[2 * i + 1] = sinf(ang);
    }
}

__device__ __forceinline__ void phase_cum(KArgs a, LAS unsigned char* lds, int wv) {
    unsigned char* ws = a->ws;
    const float* LF = (const float*)(ws + WS_LC); float* CUM = (float*)(ws + WS_CUM);
    LAS float* sc = (LAS float*)lds;
    LAS float* lc = (LAS float*)(lds + 2048);
    int tid_l = tid_from(wv); asm volatile("" : "+v"(tid_l));
    const int tid = tid_l;
    for (int c = blockIdx.x; c < T_TOK / 64; c += gridDim.x) {
        const int b = c >> 7, ci = c & 127, n0 = ci * 64;
        { const int h = tid & 3, j = tid >> 2; float p = 0.f;
          for (int t = j; t < n0; t += 128) p += LF[((size_t)b * SEQ + t) * 4 + h];
          sc[tid] = p;
          if (tid < 256) lc[tid] = LF[((size_t)c * 64) * 4 + tid]; }
        __syncthreads();
        if (tid < 256) {
            const int h = tid & 3, i = tid >> 2; float p = 0.f;
            for (int cc = 0; cc < 128; ++cc) p += sc[cc * 4 + h];
            for (int j = 0; j <= i; ++j) p += lc[j * 4 + h];
            CUM[(size_t)(c * 64 + i) * 4 + h] = p;
        }
        __syncthreads();
    }
}

__device__ __forceinline__ f32x16 mfma32(bf16x8 a, bf16x8 b, f32x16 c) { return __builtin_amdgcn_mfma_f32_32x32x16_bf16(a, b, c, 0, 0, 0); }
typedef short v4i16_t __attribute__((ext_vector_type(4)));
__device__ __forceinline__ float max3f(float a, float b, float c) { float r; asm("v_max3_f32 %0, %1, %2, %3" : "=v"(r) : "v"(a), "v"(b), "v"(c)); return r; }
__device__ __forceinline__ s16x4 vtr(const LAS unsigned char* p) { return __builtin_bit_cast(s16x4, __builtin_amdgcn_ds_read_tr16_b64_v4i16((LAS v4i16_t*)p)); }

struct AttnT {
    const bf16_t* Q; int qpitch, qcol;
    const bf16_t* K; int kpitch, kcol;
    const bf16_t* K2;
    const bf16_t* V; int vpitch, vcol;
    bf16_t* O; int opitch, ocol;
    const float* cum;
    const float* relb;
    const float* rope;
    float* ssq; int slot0;
};
template <int DQK, int DV, int MODE>
__device__ __forceinline__ void attn_unit(LAS unsigned char* lds, const AttnT& A, int b, int h, int qb, int wv) {
    constexpr int KB = DQK * 128, VB = DV * 128, KVB = KB + VB;
    constexpr int KPT = (8 * DQK + 511) / 512, VPT = (8 * DV + 511) / 512, ND = DQK / 16, NV = DV / 32;
    int tid_l = tid_from(wv); asm volatile("" : "+v"(tid_l));
    const int tid = tid_l, lane = tid & 63, r32 = lane & 31, hi = lane >> 5;
    const int wid = wv;
    LAS float* xtra = (LAS float*)(lds + 2 * KVB);
    const int q0 = qb * 256;
    const size_t qrow = (size_t)b * SEQ + q0 + wid * 32 + r32;
    const size_t krow0 = (MODE == 3) ? (size_t)b * MEMLEN : (size_t)b * SEQ;
    int kt_lo = 0, kt_hi = 4 * qb + 4;
    if (MODE == 2) kt_lo = (4 * qb - 8) > 0 ? (4 * qb - 8) : 0;
    if (MODE == 3) kt_hi = 4;
    const int wchunk = 4 * qb + (wid >> 1);
    int w_lo = 0, w_hi = wchunk;
    if (MODE == 2) w_lo = (wchunk - 8) > 0 ? (wchunk - 8) : 0;
    if (MODE == 3) w_hi = 3;
    bf16x8 qr[ND];
    { const bf16_t* qp = A.Q + qrow * A.qpitch + A.qcol + h * DQK + hi * 8;
#pragma unroll
      for (int d0 = 0; d0 < ND; ++d0) qr[d0] = *(const bf16x8*)(qp + d0 * 16); }
    if (MODE == 0) {
        const f32x4* rp = (const f32x4*)(A.rope + ((size_t)(q0 + wid * 32 + r32) * 16 + 8 * hi) * 2);
        bf16x8 a1 = qr[ND - 2], a2 = qr[ND - 1];
#pragma unroll
        for (int jj = 0; jj < 4; ++jj) { const f32x4 cs = rp[jj];
            const float x1a = bf2f((bf16_t)a1[2 * jj]), x2a = bf2f((bf16_t)a2[2 * jj]), x1b = bf2f((bf16_t)a1[2 * jj + 1]), x2b = bf2f((bf16_t)a2[2 * jj + 1]);
            const unsigned w1 = pk2(x1a * cs[0] - x2a * cs[1], x1b * cs[2] - x2b * cs[3]), w2 = pk2(x1a * cs[1] + x2a * cs[0], x1b * cs[3] + x2b * cs[2]);
            a1[2 * jj] = (short)(w1 & 0xffffu); a1[2 * jj + 1] = (short)(w1 >> 16); a2[2 * jj] = (short)(w2 & 0xffffu); a2[2 * jj + 1] = (short)(w2 >> 16); }
        qr[ND - 2] = a1; qr[ND - 1] = a2;
    }
    if (MODE == 2) { if (tid < 192) xtra[tid] = A.relb[h * 192 + tid] * LOG2E; }
    f32x16 o[NV];
#pragma unroll
    for (int d = 0; d < NV; ++d)
#pragma unroll
        for (int r = 0; r < 16; ++r) o[d][r] = 0.f;
    float mrun = 0.f, lrun = 0.f; bool first = true;
    u32x4 kreg[KPT], vreg[VPT]; float ckreg = 0.f;
    constexpr bool DEEP = (MODE != 3);
    u32x4 kreg2[KPT], vreg2[VPT]; float ckreg2 = 0.f;
    unsigned koff[KPT], voff[VPT];
#pragma unroll
    for (int i_ = 0; i_ < KPT; ++i_) { const int e_ = tid + 512 * i_; const int key_ = e_ & 63, c8_ = e_ >> 6;
        if (MODE == 0 && i_ == 1) koff[i_] = (unsigned)(key_ * 32 + (c8_ - 8) * 8) * 2u;
        else koff[i_] = ((unsigned)key_ * (unsigned)A.kpitch + (unsigned)(A.kcol + h * (MODE == 0 ? 64 : DQK) + c8_ * 8)) * 2u; }
#pragma unroll
    for (int i_ = 0; i_ < VPT; ++i_) { const int e_ = tid + 512 * i_; const int part_ = e_ & 3, key_ = (e_ >> 2) & 63, d0_ = e_ >> 8;
        voff[i_] = ((unsigned)key_ * (unsigned)A.vpitch + (unsigned)(A.vcol + h * DV + d0_ * 32 + part_ * 8)) * 2u; }
#define GLOAD(kt, KR, VR, CR) do { const size_t rb_ = krow0 + (size_t)(kt) * 64; \
    const char* kb_ = (const char*)A.K + rb_ * (size_t)A.kpitch * 2; const char* k2b_ = (MODE == 0) ? (const char*)A.K2 + rb_ * 64 : kb_; const char* vb_ = (const char*)A.V + rb_ * (size_t)A.vpitch * 2; \
    _Pragma("unroll") for (int i_ = 0; i_ < KPT; ++i_) { const int e_ = tid + 512 * i_; if (e_ < 8 * DQK) KR[i_] = *(const u32x4*)(((MODE == 0 && i_ == 1) ? k2b_ : kb_) + koff[i_]); } \
    _Pragma("unroll") for (int i_ = 0; i_ < VPT; ++i_) VR[i_] = *(const u32x4*)(vb_ + voff[i_]); \
    if (MODE == 1) { if (tid < 64) CR = A.cum[(rb_ + tid) * 4 + h]; } } while (0)
#define LWRITE(buf) do { LAS unsigned char* kb_ = lds + (buf) * KVB; \
    _Pragma("unroll") for (int i_ = 0; i_ < KPT; ++i_) { const int e_ = tid + 512 * i_; if (e_ < 8 * DQK) *(LAS u32x4*)(kb_ + e_ * 16) = kreg[i_]; } \
    _Pragma("unroll") for (int i_ = 0; i_ < VPT; ++i_) { const int e_ = tid + 512 * i_; *(LAS u32x4*)(kb_ + KB + e_ * 16) = vreg[i_]; } \
    if (MODE == 1) { if (tid < 64) xtra[(buf) * 64 + tid] = ckreg; } } while (0)
    const int nsteps = kt_hi - kt_lo;
#define KT(i_) ((MODE == 1) ? (kt_hi - 1 - (i_)) : (kt_lo + (i_)))
    GLOAD(KT(0), kreg, vreg, ckreg); LWRITE(0);
    if (DEEP) { if (1 < nsteps) GLOAD(KT(1), kreg, vreg, ckreg); }
    __syncthreads();
    bool hot = (MODE != 1);
#pragma unroll 1
    for (int it = 0; it < nsteps; ++it) {
        const int kt = KT(it);
        const int cur = it & 1;
        const bool more = it + 1 < nsteps;
        if (DEEP) { if (it + 2 < nsteps) GLOAD(KT(it + 2), kreg2, vreg2, ckreg2); } else { if (more) GLOAD(KT(it + 1), kreg, vreg, ckreg); }
        if (kt >= w_lo && kt <= w_hi) {
            const LAS unsigned char* Kb = lds + cur * KVB; const LAS unsigned char* Vb = Kb + KB;
            constexpr int NDA = ND > 6 ? ND / 2 : ND;
            bf16x8 kf0[NDA], kf1[NDA];
#pragma unroll
            for (int d0 = 0; d0 < NDA; ++d0) {
                kf0[d0] = *(const LAS bf16x8*)(Kb + (2 * d0 + hi) * 1024 + r32 * 16);
                kf1[d0] = *(const LAS bf16x8*)(Kb + (2 * d0 + hi) * 1024 + 512 + r32 * 16);
            }
            f32x4 ck0[4], ck1[4];
            if (MODE == 1) { const LAS float* ck = xtra + cur * 64;
#pragma unroll
                for (int g = 0; g < 4; ++g) { ck0[g] = *(const LAS f32x4*)(ck + 8 * g + 4 * hi); ck1[g] = *(const LAS f32x4*)(ck + 32 + 8 * g + 4 * hi); } }
            __builtin_amdgcn_sched_barrier(0);
            f32x16 p0, p1;
            { const float nm = -mrun;
#pragma unroll
            for (int r = 0; r < 16; ++r) { p0[r] = nm; p1[r] = nm; } }
#pragma unroll
            for (int d0 = 0; d0 < NDA; ++d0) { p0 = mfma32(kf0[d0], qr[d0], p0); p1 = mfma32(kf1[d0], qr[d0], p1); }
            __builtin_amdgcn_sched_barrier(0);
            if (NDA < ND) {
#pragma unroll
                for (int d0 = 0; d0 < ND - NDA; ++d0) {
                    kf0[d0] = *(const LAS bf16x8*)(Kb + (2 * (d0 + NDA) + hi) * 1024 + r32 * 16);
                    kf1[d0] = *(const LAS bf16x8*)(Kb + (2 * (d0 + NDA) + hi) * 1024 + 512 + r32 * 16);
                }
                __builtin_amdgcn_sched_barrier(0);
#pragma unroll
                for (int d0 = 0; d0 < ND - NDA; ++d0) { p0 = mfma32(kf0[d0], qr[d0 + NDA], p0); p1 = mfma32(kf1[d0], qr[d0 + NDA], p1); }
                __builtin_amdgcn_sched_barrier(0);
            }
            asm volatile("s_nop 15\n\ts_nop 7" : "+v"(p0), "+v"(p1));
            const LAS unsigned char* vbase = Vb + (4 * hi + ((lane & 15) >> 2)) * 64 + ((lane >> 4) & 1) * 32 + (lane & 3) * 8;
            constexpr int KSA = NV > 2 ? 1 : 4;
            s16x4 vlo[4][NV], vh4[4][NV];
            if (hot) {
#pragma unroll
                for (int ks = 0; ks < KSA; ++ks)
#pragma unroll
                    for (int d = 0; d < NV; ++d) { vlo[ks][d] = vtr(vbase + d * 4096 + ks * 1024); vh4[ks][d] = vtr(vbase + d * 4096 + ks * 1024 + 512); }
            }
            __builtin_amdgcn_sched_barrier(0);
            if (MODE == 1) {
#pragma unroll
                for (int g = 0; g < 4; ++g)
#pragma unroll
                    for (int i = 0; i < 4; ++i) { p0[4 * g + i] -= ck0[g][i]; p1[4 * g + i] -= ck1[g][i]; }
                if (kt * 64 + 63 > q0 + wid * 32) {
                    const int qrel = q0 + wid * 32 + r32 - kt * 64;
#pragma unroll
                    for (int r = 0; r < 16; ++r) { const int kk = (r & 3) + 8 * (r >> 2) + 4 * hi; if (kk > qrel) p0[r] = -INFINITY; if (kk + 32 > qrel) p1[r] = -INFINITY; }
                }
            }
            if (MODE == 2) {
                if (wchunk - kt >= 3) { const float cb = xtra[191];
#pragma unroll
                    for (int r = 0; r < 16; ++r) { p0[r] += cb; p1[r] += cb; } }
                else { const int qrel = q0 + wid * 32 + r32 - kt * 64 + 63;
#pragma unroll
                    for (int r = 0; r < 16; ++r) { const int kk = (r & 3) + 8 * (r >> 2) + 4 * hi;
                        int i0 = qrel - kk, i1 = qrel - kk - 32; i0 = i0 < 0 ? 0 : (i0 > 191 ? 191 : i0); i1 = i1 < 0 ? 0 : (i1 > 191 ? 191 : i1);
                        p0[r] += xtra[i0]; p1[r] += xtra[i1]; } }
            }
            float mx = max3f(p0[0], p0[1], p1[0]), mx2 = max3f(p0[2], p0[3], p1[1]);
            mx = max3f(mx, p1[2], p1[3]);
#pragma unroll
            for (int r = 4; r < 16; r += 4) { mx = max3f(mx, p0[r], p0[r + 1]); mx2 = max3f(mx2, p0[r + 2], p0[r + 3]); mx = max3f(mx, p1[r], p1[r + 1]); mx2 = max3f(mx2, p1[r + 2], p1[r + 3]); }
            mx = max3f(mx, mx2, mx2);
            mx = max3f(mx, mx, lane_xor(mx, lane, 32));
            const bool dead = (MODE == 1) && !first && __all(mx < -160.0f);
            if (!dead) {
            if (MODE == 1 && !hot) {
#pragma unroll
                for (int ks = 0; ks < KSA; ++ks)
#pragma unroll
                    for (int d = 0; d < NV; ++d) { vlo[ks][d] = vtr(vbase + d * 4096 + ks * 1024); vh4[ks][d] = vtr(vbase + d * 4096 + ks * 1024 + 512); }
                hot = true;
            }
            if (first || __any(mx > 8.0f)) {
                const float dl = first ? mx : fmaxf(mx, 0.f);
                mrun += dl;
#pragma unroll
                for (int r = 0; r < 16; ++r) { p0[r] -= dl; p1[r] -= dl; }
                if (!first) { const float f = __builtin_amdgcn_exp2f(-dl); lrun *= f;
#pragma unroll
                    for (int d = 0; d < NV; ++d)
#pragma unroll
                        for (int r = 0; r < 16; ++r) o[d][r] *= f; }
                first = false;
            }
            float ls = 0.f;
#pragma unroll
            for (int r = 0; r < 16; ++r) { p0[r] = __builtin_amdgcn_exp2f(p0[r]); p1[r] = __builtin_amdgcn_exp2f(p1[r]); ls += p0[r] + p1[r]; }
            lrun += ls;
            u32x4 pw[4];
            pw[0] = (u32x4){pk2(p0[0], p0[1]), pk2(p0[2], p0[3]), pk2(p0[4], p0[5]), pk2(p0[6], p0[7])};
            pw[1] = (u32x4){pk2(p0[8], p0[9]), pk2(p0[10], p0[11]), pk2(p0[12], p0[13]), pk2(p0[14], p0[15])};
            pw[2] = (u32x4){pk2(p1[0], p1[1]), pk2(p1[2], p1[3]), pk2(p1[4], p1[5]), pk2(p1[6], p1[7])};
            pw[3] = (u32x4){pk2(p1[8], p1[9]), pk2(p1[10], p1[11]), pk2(p1[12], p1[13]), pk2(p1[14], p1[15])};
            __builtin_amdgcn_sched_barrier(0);
#pragma unroll
            for (int ks = 0; ks < 4; ++ks) {
                if (KSA < 4 && ks + 1 < 4) {
#pragma unroll
                    for (int d = 0; d < NV; ++d) { vlo[ks + 1][d] = vtr(vbase + d * 4096 + (ks + 1) * 1024); vh4[ks + 1][d] = vtr(vbase + d * 4096 + (ks + 1) * 1024 + 512); }
                    __builtin_amdgcn_sched_barrier(0);
                }
                const bf16x8 pf = __builtin_bit_cast(bf16x8, pw[ks]);
#pragma unroll
                for (int d = 0; d < NV; ++d) {
                    const s16x4 lo = vlo[ks][d], h4 = vh4[ks][d];
                    const bf16x8 vf = (bf16x8){lo[0], lo[1], lo[2], lo[3], h4[0], h4[1], h4[2], h4[3]};
                    o[d] = mfma32(vf, pf, o[d]);
                }
                if (KSA < 4) __builtin_amdgcn_sched_barrier(0);
            }
            } else { hot = false; }
        }
        if (more) LWRITE(cur ^ 1);
        __syncthreads();
        if (DEEP) {
#pragma unroll
            for (int i_ = 0; i_ < KPT; ++i_) kreg[i_] = kreg2[i_];
#pragma unroll
            for (int i_ = 0; i_ < VPT; ++i_) vreg[i_] = vreg2[i_];
            ckreg = ckreg2;
        }
    }
#undef GLOAD
#undef LWRITE
#undef KT
    lrun += lane_xor(lrun, lane, 32);
    const float rl = 1.0f / lrun;
    {
        constexpr int NCH16 = DV / 8, RB = DV * 2;
        LAS unsigned char* stg = lds + 65536 + wid * (32 * RB);
#pragma unroll
        for (int d = 0; d < NV; ++d)
#pragma unroll
            for (int g = 0; g < 4; ++g) { u32x2 w; w.x = pk2(o[d][4 * g] * rl, o[d][4 * g + 1] * rl); w.y = pk2(o[d][4 * g + 2] * rl, o[d][4 * g + 3] * rl);
                const int pi = 8 * d + 2 * g + hi, ch = pi >> 1, sub = pi & 1;
                *(LAS u32x2*)(stg + r32 * RB + ((ch ^ (r32 & (NCH16 - 1))) * 16) + sub * 8) = w; }
        bf16_t* ob = A.O + ((size_t)b * SEQ + q0 + wid * 32) * A.opitch + A.ocol + h * DV;
#pragma unroll
        for (int i = 0; i < (32 * NCH16) / 64; ++i) { const int row = i * (64 / NCH16) + lane / NCH16, ch = lane % NCH16;
            const u32x4 v = *(const LAS u32x4*)(stg + row * RB + ((ch ^ (row & (NCH16 - 1))) * 16));
            *(u32x4*)(ob + (size_t)row * A.opitch + ch * 8) = v; }
    }
    if (MODE != 3) {
        float sq = 0.f;
#pragma unroll
        for (int d = 0; d < NV; ++d)
#pragma unroll
            for (int r = 0; r < 16; ++r) { const float v = o[d][r] * rl; sq += v * v; }
        sq += lane_xor(sq, lane, 32);
        if (hi == 0) A.ssq[qrow * 12 + A.slot0 + h] = sq;
    }
}

__device__ __forceinline__ void phase_final(KArgs a, int wv) {
    const float* g = a->in[20];
    const bf16_t* XB = (const bf16_t*)(a->ws + (((3 * NLAYER) & 1) ? WS_XB2 : WS_XB));
    int tid_l = tid_from(wv); asm volatile("" : "+v"(tid_l));
    const int tid = tid_l, lane = tid & 63, wave = tid >> 6;
    for (int row = blockIdx.x * NWAVES + wave; row < T_TOK; row += gridDim.x * NWAVES) {
        const u32x2* xr = (const u32x2*)(XB + (size_t)row * DMODEL) + lane;
        f32x4 v[4]; float s = 0.f;
#pragma unroll
        for (int j = 0; j < 4; ++j) { const u32x2 w = xr[64 * j]; v[j] = (f32x4){bflo(w.x), bfhi(w.x), bflo(w.y), bfhi(w.y)}; s += (v[j][0] * v[j][0] + v[j][1] * v[j][1]) + (v[j][2] * v[j][2] + v[j][3] * v[j][3]); }
        const float rs = __builtin_amdgcn_rsqf(wave_sum(s, lane) * (1.0f / 1024.0f) + EPS);
        f32x4* orow = (f32x4*)(a->out + (size_t)row * DMODEL) + lane;
#pragma unroll
        for (int j = 0; j < 4; ++j) { const f32x4 gg = ((const f32x4*)g)[64 * j + lane]; orow[64 * j] = v[j] * rs * gg; }
    }
}

constexpr int PH_PER_LAYER = 9, N_PHASES = 1 + NLAYER * PH_PER_LAYER + 1;
__global__ void __launch_bounds__(NTHREADS, 2) fwd_kernel(Args args) {
    extern __shared__ __attribute__((aligned(16))) unsigned char lds_raw[];
    LAS unsigned char* lds = (LAS unsigned char*)lds_raw;
    const int lo = args.ph_lo, hi = args.ph_hi;
#define WSP(off) (wsl + (off))
#define LAUNDER_WS() KArgs ap = (KArgs)__builtin_amdgcn_kernarg_segment_ptr(); asm volatile("" : "+s"(ap)); unsigned char* wsl = ap->ws; \
    bf16_t* XB = (bf16_t*)WSP(WS_XB); bf16_t* XB2 = (bf16_t*)WSP(WS_XB2); (void)XB2; float* RS = (float*)WSP(WS_RS); bf16_t* PROJ = (bf16_t*)WSP(WS_PROJ); bf16_t* CQN = (bf16_t*)WSP(WS_CQN); bf16_t* CKVN = (bf16_t*)WSP(WS_CKVN); \
    bf16_t* QM = (bf16_t*)WSP(WS_QM); bf16_t* KV = (bf16_t*)WSP(WS_KV); bf16_t* Y = (bf16_t*)WSP(WS_Y); bf16_t* HID = (bf16_t*)WSP(WS_HID); \
    bf16_t* KPE = (bf16_t*)WSP(WS_KPE); bf16_t* MEMN = (bf16_t*)WSP(WS_MEMN); bf16_t* QC = QM; bf16_t* OC = KV; \
    const float* CUM = (const float*)WSP(WS_CUM); const float* rope = (const float*)WSP(WS_ROPE); float* SSQ = (float*)WSP(WS_SSQ); (void)SSQ; float* RSQ = (float*)WSP(WS_RSQ); float* RSKV = (float*)WSP(WS_RSKV); float* LF = (float*)WSP(WS_LC); (void)RSQ; (void)RSKV; (void)LF; \
    unsigned char* wl = wsl + WS_W + (size_t)l * W_LAYER; bf16_t* KVMEM = (bf16_t*)WSP(WS_KVMEM) + (size_t)l * 1024 * 1024; \
    (void)XB; (void)RS; (void)PROJ; (void)CQN; (void)CKVN; (void)QM; (void)KV; (void)Y; (void)HID; (void)KPE; (void)MEMN; (void)QC; (void)OC; (void)CUM; (void)rope; (void)wl; (void)KVMEM
    const int G = gridDim.x, bx = blockIdx.x;
    const int vcu = (G % 8 == 0) ? (bx % 8) * (G / 8) + bx / 8 : bx;
    volatile LAS unsigned* bst = (volatile LAS unsigned*)(lds + 131072 + 1024);
    const int wv = __builtin_amdgcn_readfirstlane((int)threadIdx.x >> 6);
    if (threadIdx.x < 4) bst[threadIdx.x] = 0u;
    __syncthreads();
    XcdBarrier gbar; gbar.bar = (unsigned*)(args.ws + WS_BAR); gbar.x = 0; gbar.st = bst; gbar.wv = wv;
    if (hi - lo > 1) gbar = xcd_barrier_post((unsigned*)(args.ws + WS_BAR), bst, wv);
    if (lo > 100000) cg::this_grid().sync();
    for (int p = lo; p < hi; ++p) {
        if (p == 0) { KArgs ap = (KArgs)__builtin_amdgcn_kernarg_segment_ptr(); asm volatile("" : "+s"(ap)); phase_prologue(ap, lds, wv, 0); }
        else if (p == N_PHASES - 1) { KArgs ap = (KArgs)__builtin_amdgcn_kernarg_segment_ptr(); asm volatile("" : "+s"(ap)); phase_final(ap, wv); }
        else {
        const int l = (p - 1) / PH_PER_LAYER, kph = (p - 1) - l * PH_PER_LAYER;
        LAUNDER_WS();
        switch (kph) {
        case 0: {
            pg8::Gemm g{((3 * l) & 1) ? XB2 : XB, (const bf16_t*)(wl + WO_IN), T_TOK, PROJ_W, 1024}; pg8::StaticOrder S; S.init(T_TOK, PROJ_W, G, bx);
            pg8::EpiWin E{PROJ, RS, RSQ, RSKV, KPE, LF, rope, ap->in[8] + l * 4};
            pg8::gemm_phase<pg8::EpiWin, pg8::StaticOrder, true, true>(lds, g, S, E, wv);
            if (l == 0) phase_prologue(ap, lds, wv, 1);
        }
        break;
        case 1: {
            { pg8::Gemm g{PROJ, (const bf16_t*)(wl + WO_UQ), T_TOK, 1280, 384, PROJ_W}; pg8::StaticOrder S; S.init(T_TOK, 1280, G, bx);
              pg8::EpiSplitQKV E{QM, KV, RSQ, RSKV};
              pg8::gemm_phase<pg8::EpiSplitQKV, pg8::StaticOrder, true, true>(lds, g, S, E, wv); }
            { pg8::Gemm g{MEMN, (const bf16_t*)(wl + WO_CKV), 1024, 1024, 1024}; pg8::StaticOrder S; S.init(1024, 1024, G, (bx + G - (128 % G)) % G);
              pg8::EpiScaleBf16<false> E{KVMEM, 1024, nullptr};
              pg8::gemm_phase<pg8::EpiScaleBf16<false>, pg8::StaticOrder, true, true>(lds, g, S, E, wv); }
            phase_cum(ap, lds, wv);
        }
        break;
        case 2: {
            { AttnT A{QM, 512, 0, KV, 768, 0, KPE, KV, 768, 256, Y, 1024, 0, nullptr, nullptr, rope, SSQ, 0};
              for (int u = vcu; u < 256; u += G) { const int bh = u >> 4, s = u & 15;
                  for (int hf = 0; hf < 2; ++hf) attn_unit<96, 128, 0>(lds, A, bh >> 2, bh & 3, hf ? s : 31 - s, wv); } }
            { AttnT A{PROJ, PROJ_W, 512, PROJ, PROJ_W, 768, nullptr, PROJ, PROJ_W, 1024, Y, 1024, 512, CUM, nullptr, nullptr, SSQ, 4};
              for (int u = vcu; u < 256; u += G) { const int bh = u >> 4, s = u & 15;
                  for (int hf = 0; hf < 2; ++hf) attn_unit<64, 64, 1>(lds, A, bh >> 2, bh & 3, hf ? s : 31 - s, wv); } }
            { AttnT A{PROJ, PROJ_W, 1280, PROJ, PROJ_W, 1536, nullptr, PROJ, PROJ_W, 1792, Y, 1024, 768, nullptr, ap->in[9] + l * 4 * 192, nullptr, SSQ, 8};
              for (int u = vcu; u < 512; u += G) { const int bh = (u >> 4) & 15, qb = (u & 15) + 16 * (u >> 8); attn_unit<64, 64, 2>(lds, A, bh >> 2, bh & 3, qb, wv); } }
        }
        break;
        case 3: {
            pg8::Gemm g{Y, (const bf16_t*)(wl + WO_O), T_TOK, 1024, 1024}; pg8::StaticOrder S; S.init(T_TOK, 1024, G, bx);
            pg8::EpiResidualY E{((3 * l) & 1) ? XB2 : XB, ((3 * l + 1) & 1) ? XB2 : XB, RS, SSQ};
            pg8::gemm_phase<pg8::EpiResidualY, pg8::StaticOrder, true, true>(lds, g, S, E, wv);
        }
        break;
        case 4: {
            pg8::Gemm g{((3 * l + 1) & 1) ? XB2 : XB, (const bf16_t*)(wl + WO_CQ), T_TOK, 512, 1024}; pg8::StaticOrder S; S.init(T_TOK, 512, G, bx);
            pg8::EpiScaleBf16<true> E{QC, 512, RS};
            pg8::gemm_phase<pg8::EpiScaleBf16<true>, pg8::StaticOrder, true, true>(lds, g, S, E, wv);
        }
        break;
        case 5: {
            AttnT A{QC, 512, 0, KVMEM, 1024, 0, nullptr, KVMEM, 1024, 512, OC, 512, 0, nullptr, nullptr, nullptr, nullptr, 0};
            for (int u = vcu; u < 512; u += G) { const int bh = (u >> 4) & 15, qb = (u & 15) + 16 * (u >> 8); attn_unit<128, 128, 3>(lds, A, bh >> 2, bh & 3, qb, wv); }
        }
        break;
        case 6: {
            pg8::Gemm g{OC, (const bf16_t*)(wl + WO_CO), T_TOK, 1024, 512}; pg8::StaticOrder S; S.init(T_TOK, 1024, G, bx);
            pg8::EpiResidual E{((3 * l + 1) & 1) ? XB2 : XB, ((3 * l + 2) & 1) ? XB2 : XB, RS, true};
            pg8::gemm_phase<pg8::EpiResidual, pg8::StaticOrder, true, true>(lds, g, S, E, wv);
        }
        break;
        case 7: {
            pg8::Gemm g{((3 * l + 2) & 1) ? XB2 : XB, (const bf16_t*)(wl + WO_GU), T_TOK, 2 * FFN_H, 1024}; pg8::StaticOrder S; S.init(T_TOK, 2 * FFN_H, G, bx);
            pg8::EpiSwiGLU E{HID, RS};
            pg8::gemm_phase<pg8::EpiSwiGLU, pg8::StaticOrder, true, true>(lds, g, S, E, wv);
        }
        break;
        case 8: {
            pg8::Gemm g{HID, (const bf16_t*)(wl + WO_DOWN), T_TOK, 1024, FFN_H}; pg8::StaticOrder S; S.init(T_TOK, 1024, G, bx);
            pg8::EpiResidual E{((3 * l + 2) & 1) ? XB2 : XB, ((3 * l + 3) & 1) ? XB2 : XB, RS, l + 1 < NLAYER};
            pg8::gemm_phase<pg8::EpiResidual, pg8::StaticOrder, true, true>(lds, g, S, E, wv);
        }
        break;

        default: break;
        }
        }
        if (p + 1 < hi) xcd_barrier(gbar);
    }
}

extern "C" void kernel_launch(void* const* d_in, const int* in_sizes, int n_in, void* d_out, int out_size, void* d_ws, size_t ws_size, hipStream_t stream) {
    static int grid = 0;
    if (grid == 0) {
        if (n_in != 21 || out_size != T_TOK * DMODEL || ws_size < WS_END) { fprintf(stderr, "kernel_launch: unexpected shapes (n_in %d, out %d, ws %zu)\n", n_in, out_size, ws_size); grid = -1; return; }
        int dev = 0, cus = 0, per_cu = 0;
        (void)hipGetDevice(&dev); (void)hipDeviceGetAttribute(&cus, hipDeviceAttributeMultiprocessorCount, dev);
        if (hipFuncSetAttribute((const void*)fwd_kernel, hipFuncAttributeMaxDynamicSharedMemorySize, LDS_BYTES) != hipSuccess) { fprintf(stderr, "kernel_launch: hipFuncSetAttribute failed\n"); grid = -1; return; }
        if (hipOccupancyMaxActiveBlocksPerMultiprocessor(&per_cu, (const void*)fwd_kernel, NTHREADS, LDS_BYTES) != hipSuccess || per_cu < 1) { fprintf(stderr, "kernel_launch: occupancy query gave %d\n", per_cu); per_cu = 1; }
        (void)hipGetLastError();
        grid = cus * 1;
        if (grid <= 0) grid = 256;
    }
    if (grid < 0) return;
    if (hipMemsetAsync((char*)d_ws + WS_BAR, 0, XCD_BAR_WORDS * 4, stream) != hipSuccess) { fprintf(stderr, "kernel_launch: memset failed\n"); return; }
    Args a{};
    for (int i = 0; i < 21; ++i) a.in[i] = (const float*)d_in[i];
    a.out = (float*)d_out; a.ws = (unsigned char*)d_ws;
#if MK_MULTI
    for (int p = 0; p < N_PHASES; ++p) { a.ph_lo = p; a.ph_hi = p + 1; hipLaunchKernelGGL(fwd_kernel, dim3(grid), dim3(NTHREADS), LDS_BYTES, stream, a); }
#else
    a.ph_lo = 0; a.ph_hi = N_PHASES;
    void* kargs[] = {&a};
    hipError_t e = hipLaunchCooperativeKernel((const void*)fwd_kernel, dim3(grid), dim3(NTHREADS), kargs, LDS_BYTES, stream);
    if (e != hipSuccess) fprintf(stderr, "kernel_launch: cooperative launch failed: %s (grid %d)\n", hipGetErrorString(e), grid);
#endif
}
```

```cpp
#include <hip/hip_runtime.h>
#include <hip/hip_cooperative_groups.h>
#include <cstdio>
#include <cstdint>
namespace cg = cooperative_groups;

#ifndef MK_MULTI
#define MK_MULTI 0
#endif

constexpr int NWAVES = 8, NTHREADS = 512;
constexpr int T_TOK = 32768, SEQ = 8192, NBATCH = 4, DMODEL = 1024, NLAYER = 2, MEMLEN = 256;
constexpr int IN_W = 1956, PROJ_W = 2048, FFN_H = 2816;
constexpr float EPS = 1e-6f, LOG2E = 1.4426950408889634f;
constexpr float SC_MLA = 0.10206207261596575f * 1.4426950408889634f;
constexpr float SC_64 = 0.125f * 1.4426950408889634f;
constexpr float SC_CROSS = 0.08838834764831845f * 1.4426950408889634f;

#define LAS __attribute__((address_space(3)))
typedef unsigned short bf16_t;
typedef float f32x4 __attribute__((ext_vector_type(4)));
typedef float f32x16 __attribute__((ext_vector_type(16)));
typedef short bf16x8 __attribute__((ext_vector_type(8)));
typedef short s16x4 __attribute__((ext_vector_type(4)));
typedef unsigned u32x4 __attribute__((ext_vector_type(4)));
typedef unsigned u32x2 __attribute__((ext_vector_type(2)));
typedef float f32x2_t __attribute__((ext_vector_type(2)));
typedef __bf16 bf16x2_t __attribute__((ext_vector_type(2)));

__device__ __forceinline__ unsigned pk2(float lo, float hi) { f32x2_t v = {lo, hi}; bf16x2_t b = __builtin_convertvector(v, bf16x2_t); return __builtin_bit_cast(unsigned, b); }
__device__ __forceinline__ float bflo(unsigned u) { return __uint_as_float(u << 16); }
__device__ __forceinline__ float bfhi(unsigned u) { return __uint_as_float(u & 0xffff0000u); }
__device__ __forceinline__ float bf2f(bf16_t h) { return __uint_as_float(((unsigned)h) << 16); }
__device__ __forceinline__ float lane_xor(float v, int lane, int m) { return __int_as_float(__builtin_amdgcn_ds_bpermute((lane ^ m) << 2, __float_as_int(v))); }
__device__ __forceinline__ float wave_sum(float v, int lane) {
#pragma unroll
    for (int o = 1; o < 64; o <<= 1) v += lane_xor(v, lane, o);
    return v;
}
__device__ __forceinline__ int lane_now() { int l; asm volatile("v_mbcnt_lo_u32_b32 %0, -1, 0\n\tv_mbcnt_hi_u32_b32 %0, -1, %0" : "=&v"(l)); return l; }
__device__ __forceinline__ int tid_from(int wv) { return wv * 64 + lane_now(); }

#define XB_TMO      128
#define XB_XCNT(j)  (256  + 64 * (j))
#define XB_XSUB(j)  (1280 + 64 * (j))
#define XB_XGEN(j)  (2304 + 64 * (j))
#define XB_TOP      3328
#define XB_TOPGEN   3392
#define XCD_BAR_WORDS 3456
#define XB_SPIN_CAP (1u << 18)


__device__ __forceinline__ unsigned xb_ld(unsigned* p)              { return __hip_atomic_load(p, __ATOMIC_RELAXED, __HIP_MEMORY_SCOPE_AGENT); }
__device__ __forceinline__ unsigned xb_add(unsigned* p, unsigned v) { return __hip_atomic_fetch_add(p, v, __ATOMIC_RELAXED, __HIP_MEMORY_SCOPE_AGENT); }
__device__ __forceinline__ unsigned xb_xcc_id() { return (unsigned)__builtin_amdgcn_s_getreg((3 << 11) | 20) & 0xFu; }
#define XB_SPIN(cond, bar) do { unsigned _sp = 0; while (cond) { __builtin_amdgcn_s_sleep(1); \
    if ((++_sp & 255u) == 0u) { if (xb_ld(&(bar)[XB_TMO])) break; if (_sp > XB_SPIN_CAP) { atomicAdd(&(bar)[XB_TMO], 1u); break; } } } } while (0)

struct XcdBarrier {
    unsigned* bar; unsigned x;
    volatile LAS unsigned* st; int wv;
};

__device__ __forceinline__ XcdBarrier xcd_barrier_post(unsigned* bar, volatile LAS unsigned* st, int wv) {
    XcdBarrier b; b.bar = bar; b.x = xb_xcc_id(); b.st = st; b.wv = wv;
    if (tid_from(wv) == 0) (void)xb_add(&bar[XB_XCNT(b.x)], 1u);
    return b;
}
__device__ __forceinline__ void xcd_barrier_complete(unsigned* bar, unsigned x, unsigned& nloc, unsigned& nx) {
    const unsigned G = gridDim.x * gridDim.y * gridDim.z;
    unsigned sum, cnt, mine, sp = 0u;
    for (;;) {
        sum = 0u; cnt = 0u; mine = 0u;
#pragma unroll
        for (unsigned j = 0; j < 16; ++j) { const unsigned c = xb_ld(&bar[XB_XCNT(j)]); sum += c; cnt += (c > 0u) ? 1u : 0u; mine = (j == x) ? c : mine; }
        if (sum == G) break;
        __builtin_amdgcn_s_sleep(1);
        if ((++sp & 255u) == 0u) { if (xb_ld(&bar[XB_TMO])) break; if (sp > XB_SPIN_CAP) { atomicAdd(&bar[XB_TMO], 1u); break; } }
    }
    nloc = mine > 0u ? mine : 1u; nx = cnt > 0u ? cnt : 1u;
}

__device__ __forceinline__ void xcd_barrier(const XcdBarrier& b) {
    asm volatile("s_waitcnt vmcnt(0)" ::: "memory");
    __syncthreads();
    if (tid_from(b.wv) == 0) {
        unsigned* bar = b.bar;
        __builtin_amdgcn_s_waitcnt(0);
        unsigned nloc = b.st[0], nx = b.st[1];
        if (nloc == 0u) { xcd_barrier_complete(bar, b.x, nloc, nx); b.st[0] = nloc; b.st[1] = nx; }
        const unsigned old = xb_add(&bar[XB_XSUB(b.x)], 1u);
        const unsigned gen = old / nloc;
        if (old + 1u == (gen + 1u) * nloc) {
            __builtin_amdgcn_fence(__ATOMIC_RELEASE, "agent");
            asm volatile("s_waitcnt vmcnt(0)" ::: "memory");
            const unsigned og = xb_add(&bar[XB_TOP], 1u);
            const unsigned tg = og / nx;
            if (og + 1u == (tg + 1u) * nx) xb_add(&bar[XB_TOPGEN], 1u);
            else XB_SPIN(xb_ld(&bar[XB_TOPGEN]) == tg, bar);
            __builtin_amdgcn_fence(__ATOMIC_ACQUIRE, "agent");
            xb_add(&bar[XB_XGEN(b.x)], 1u);
            asm volatile("s_waitcnt vmcnt(0)" ::: "memory");
        } else {
            XB_SPIN(xb_ld(&bar[XB_XGEN(b.x)]) == gen, bar);
            __builtin_amdgcn_fence(__ATOMIC_ACQUIRE, "agent");
            asm volatile("s_waitcnt vmcnt(0)" ::: "memory");
        }
    }
    __syncthreads();
}

namespace pg8 {
#define PG8_LAS __attribute__((address_space(3)))
typedef unsigned short bf16_t;
typedef short bf16x8 __attribute__((ext_vector_type(8)));
typedef float f32x4 __attribute__((ext_vector_type(4)));
typedef unsigned u32x4 __attribute__((ext_vector_type(4)));
constexpr int BM = 256, BK = 64, HALF = 128, HTB = HALF * BK * 2  , STAGE_BYTES = 8 * HTB, NXCD = 8, WGM = 8;

__host__ __device__ __forceinline__ int lds_byte(int r, int c) { const int st = (r >> 4) * 2 + (c >> 5), rr = r & 15, cc = c & 31, ob = rr * 64 + cc * 2; return st * 1024 + (ob ^ (((ob >> 9) & 1) << 5)); }
__host__ __device__ __forceinline__ void stage_rc(int b, int& R, int& C) { const int st = b / 1024, sb = b % 1024, swz = sb ^ (((sb >> 9) & 1) << 5); R = (st >> 1) * 16 + swz / 64; C = (st & 1) * 32 + (swz % 64) / 2; }
__host__ __device__ __forceinline__ int perm32(int rho) { const int n = rho >> 4, i = rho & 15; return 8 * (i >> 2) + 4 * n + (i & 3); }

struct Unit { int pm, pn; };
struct Gemm { const bf16_t* A; const bf16_t* Bt; int M, N, K; int lda; };

struct StaticOrder {
    int nM, nN, nwg, G, c;
    __host__ __device__ void init(int M, int N, int G_, int c_) { nM = M / BM; nN = N / BM; nwg = nM * nN; G = G_; c = c_; }
    __host__ __device__ bool next(int i, Unit& u) const {
        const long L = (long)i * G + c; if (L >= nwg) return false;
        int wgid = (int)L; { const int q = nwg / NXCD, r = nwg % NXCD, xcd = wgid % NXCD, off = wgid / NXCD; wgid = (xcd < r ? xcd * (q + 1) : r * (q + 1) + (xcd - r) * q) + off; }
        const int nig = WGM * nN, gid = wgid / nig, fm = gid * WGM, gsz = (nM - fm) < WGM ? (nM - fm) : WGM;
        u.pm = fm + ((wgid % nig) % gsz); u.pn = (wgid % nig) / gsz; return true;
    }
    __device__ __forceinline__ void a_ready(const Unit&) const {}
    __device__ __forceinline__ void done(const Unit&) const {}
};

__device__ __forceinline__ float row_rstd(const float* RS, int row) {
    const f32x4* p = (const f32x4*)(RS + (size_t)row * 16);
    const f32x4 a = p[0], b = p[1], c = p[2], d = p[3];
    const float s = ((a[0] + a[1]) + (a[2] + a[3])) + ((b[0] + b[1]) + (b[2] + b[3])) + ((c[0] + c[1]) + (c[2] + c[3])) + ((d[0] + d[1]) + (d[2] + d[3]));
    return __builtin_amdgcn_rsqf(s * (1.0f / 1024.0f) + 1e-6f);
}
__device__ __forceinline__ void st_bf8(bf16_t* p, f32x4 a, f32x4 c) { u32x4 w; w.x = ::pk2(a[0], a[1]); w.y = ::pk2(a[2], a[3]); w.z = ::pk2(c[0], c[1]); w.w = ::pk2(c[2], c[3]); *(u32x4*)p = w; }
__device__ __forceinline__ void st_bf4(bf16_t* p, f32x4 v) { u32x2 w; w.x = ::pk2(v[0], v[1]); w.y = ::pk2(v[2], v[3]); *(u32x2*)p = w; }

template <bool HAS_RS> struct EpiScaleBf16 {
    static constexpr bool PERM = true, AFTER_DRAIN = false, RESCALE = false;
    bf16_t* O; int ldc; const float* RS;
    __device__ __forceinline__ void operator()(const f32x4 (&acc)[2][2][4][2], const Unit& u, int wr, int wc, int fr, int fq) const {
        { int t2_ = (wr * 4 + wc) * 64 + ::lane_now(); asm volatile("" : "+v"(t2_)); fr = t2_ & 15; fq = (t2_ >> 4) & 3; }
        const int row0 = u.pm * BM + wr * 64 + fr, col0 = u.pn * BM + wc * 32 + 8 * fq;
#pragma unroll
        for (int ai = 0; ai < 2; ++ai)
#pragma unroll
            for (int m = 0; m < 4; ++m) {
                const int row = row0 + ai * HALF + m * 16;
                const float sc = HAS_RS ? row_rstd(RS, row) : 1.0f;
                bf16_t* rowp = O + (size_t)row * ldc;
#pragma unroll
                for (int bj = 0; bj < 2; ++bj) st_bf8(rowp + col0 + bj * HALF, acc[ai][bj][m][0] * sc, acc[ai][bj][m][1] * sc);
            }
    }
};
struct EpiQRope {
    static constexpr bool PERM = false, AFTER_DRAIN = false, RESCALE = false;
    bf16_t* O; int ldc; const float* rope;
    __device__ __forceinline__ void operator()(const f32x4 (&acc)[2][2][4][2], const Unit& u, int wr, int wc, int fr, int fq) const {
        { int t2_ = (wr * 4 + wc) * 64 + ::lane_now(); asm volatile("" : "+v"(t2_)); fr = t2_ & 15; fq = (t2_ >> 4) & 3; }
        const int row0 = u.pm * BM + wr * 64 + fr, col0 = u.pn * BM + wc * 32 + 4 * fq;
#pragma unroll
        for (int ai = 0; ai < 2; ++ai)
#pragma unroll
            for (int m = 0; m < 4; ++m) {
                const int row = row0 + ai * HALF + m * 16, pos = row & (::SEQ - 1);
                bf16_t* rowp = O + (size_t)row * ldc;
#pragma unroll
                for (int bj = 0; bj < 2; ++bj) {
                    const int c = col0 + bj * HALF;
                    if (c >= 384) continue;
                    f32x4 v0 = acc[ai][bj][m][0], v1 = acc[ai][bj][m][1];
                    if (((c >> 5) % 3) == 2) {
                        const f32x4* rp = (const f32x4*)(rope + ((size_t)pos * 16 + 4 * fq) * 2);
                        const f32x4 cs0 = rp[0], cs1 = rp[1];
                        const float co[4] = {cs0[0], cs0[2], cs1[0], cs1[2]}, si[4] = {cs0[1], cs0[3], cs1[1], cs1[3]};
                        f32x4 a, b;
#pragma unroll
                        for (int i = 0; i < 4; ++i) { a[i] = v0[i] * co[i] - v1[i] * si[i]; b[i] = v0[i] * si[i] + v1[i] * co[i]; }
                        v0 = a; v1 = b;
                    }
                    st_bf4(rowp + c, v0); st_bf4(rowp + c + 16, v1);
                }
            }
    }
};
struct EpiResidual {
    static constexpr bool PERM = true, AFTER_DRAIN = false, RESCALE = false;
    const bf16_t* XI; bf16_t* XB; float* RS; bool stats;
    __device__ __forceinline__ void operator()(const f32x4 (&acc)[2][2][4][2], const Unit& u, int wr, int wc, int fr, int fq) const {
        { int t2_ = (wr * 4 + wc) * 64 + ::lane_now(); asm volatile("" : "+v"(t2_)); fr = t2_ & 15; fq = (t2_ >> 4) & 3; }
        const int row0 = u.pm * BM + wr * 64 + fr, col0 = u.pn * BM + wc * 32 + 8 * fq;
#pragma unroll
        for (int ai = 0; ai < 2; ++ai)
#pragma unroll
            for (int m = 0; m < 4; ++m) {
                const int row = row0 + ai * HALF + m * 16;
                const size_t ro = (size_t)row * ::DMODEL;
                float ss = 0.f;
#pragma unroll
                for (int bj = 0; bj < 2; ++bj) {
                    const int c = col0 + bj * HALF;
                    const u32x4 xo = *(const u32x4*)(XI + ro + c);
                    const f32x4 x0 = (f32x4){::bflo(xo.x), ::bfhi(xo.x), ::bflo(xo.y), ::bfhi(xo.y)} + acc[ai][bj][m][0];
                    const f32x4 x1 = (f32x4){::bflo(xo.z), ::bfhi(xo.z), ::bflo(xo.w), ::bfhi(xo.w)} + acc[ai][bj][m][1];
                    st_bf8(XB + ro + c, x0, x1);
                    ss += ((x0[0] * x0[0] + x0[1] * x0[1]) + (x0[2] * x0[2] + x0[3] * x0[3])) + ((x1[0] * x1[0] + x1[1] * x1[1]) + (x1[2] * x1[2] + x1[3] * x1[3]));
                }
                { const int ln_ = fq * 16 + fr; ss += ::lane_xor(ss, ln_, 16); ss += ::lane_xor(ss, ln_, 32); }
                if (stats && fq == 0) RS[(size_t)row * 16 + u.pn * 4 + wc] = ss;
            }
    }
};
struct EpiSwiGLU {
    static constexpr bool PERM = true, AFTER_DRAIN = false, RESCALE = false;
    bf16_t* O; const float* RS;
    __device__ __forceinline__ void operator()(const f32x4 (&acc)[2][2][4][2], const Unit& u, int wr, int wc, int fr, int fq) const {
        { int t2_ = (wr * 4 + wc) * 64 + ::lane_now(); asm volatile("" : "+v"(t2_)); fr = t2_ & 15; fq = (t2_ >> 4) & 3; }
        const int row0 = u.pm * BM + wr * 64 + fr, col0 = u.pn * HALF + wc * 32 + 8 * fq;
#pragma unroll
        for (int ai = 0; ai < 2; ++ai)
#pragma unroll
            for (int m = 0; m < 4; ++m) {
                const int row = row0 + ai * HALF + m * 16;
                const float sc = row_rstd(RS, row);
                bf16_t* rowp = O + (size_t)row * ::FFN_H;
                f32x4 r2[2];
#pragma unroll
                for (int n = 0; n < 2; ++n) {
                    const f32x4 g = acc[ai][0][m][n] * sc, up = acc[ai][1][m][n] * sc;
#pragma unroll
                    for (int i = 0; i < 4; ++i) r2[n][i] = g[i] * __builtin_amdgcn_rcpf(1.0f + __builtin_amdgcn_exp2f(-g[i] * 1.4426950408889634f)) * up[i];
                }
                st_bf8(rowp + col0, r2[0], r2[1]);
            }
    }
};
struct EpiSplitQKV {
    static constexpr bool PERM = true, AFTER_DRAIN = false, RESCALE = false;
    bf16_t* QM; bf16_t* KV; const float* RSQ; const float* RSKV;
    __device__ __forceinline__ void operator()(const f32x4 (&acc)[2][2][4][2], const Unit& u, int wr, int wc, int fr, int fq) const {
        { int t2_ = (wr * 4 + wc) * 64 + ::lane_now(); asm volatile("" : "+v"(t2_)); fr = t2_ & 15; fq = (t2_ >> 4) & 3; }
        const bool isq = u.pn < 2;
        bf16_t* O = isq ? QM : KV; const int ldc = isq ? 512 : 768;
        const int row0 = u.pm * BM + wr * 64 + fr, col0 = (isq ? u.pn : u.pn - 2) * BM + wc * 32 + 8 * fq;
#pragma unroll
        for (int ai = 0; ai < 2; ++ai)
#pragma unroll
            for (int m = 0; m < 4; ++m) {
                const int row = row0 + ai * HALF + m * 16;
                const f32x4 ps = *(const f32x4*)((isq ? RSQ : RSKV) + (size_t)row * 4);
                const float sc = __builtin_amdgcn_rsqf(((ps[0] + ps[1]) + (ps[2] + ps[3])) * (isq ? 1.0f / 256.0f : 1.0f / 128.0f) + 1e-6f);
                bf16_t* rowp = O + (size_t)row * ldc;
#pragma unroll
                for (int bj = 0; bj < 2; ++bj) st_bf8(rowp + col0 + bj * HALF, acc[ai][bj][m][0] * sc, acc[ai][bj][m][1] * sc);
            }
    }
};
struct EpiResidualY {
    static constexpr bool PERM = true, AFTER_DRAIN = false, RESCALE = true;
    const bf16_t* XI; bf16_t* XB; float* RS; const float* SSQ;
    __device__ __forceinline__ static void group_rstd(const float* SSQ, int row, float& ra, float& rb, float& rc) {
        const f32x4* p = (const f32x4*)(SSQ + (size_t)row * 12);
        const f32x4 a = p[0], b = p[1], c = p[2];
        ra = __builtin_amdgcn_rsqf(((a[0] + a[1]) + (a[2] + a[3])) * (1.0f / 512.0f) + 1e-6f);
        rb = __builtin_amdgcn_rsqf(((b[0] + b[1]) + (b[2] + b[3])) * (1.0f / 256.0f) + 1e-6f);
        rc = __builtin_amdgcn_rsqf(((c[0] + c[1]) + (c[2] + c[3])) * (1.0f / 256.0f) + 1e-6f);
    }
    __device__ __forceinline__ void rescale(f32x4 (&acc)[2][2][4][2], const Unit& u, int t, int wr, int wc) const {
        int fr, fq; { int t2_ = (wr * 4 + wc) * 64 + ::lane_now(); asm volatile("" : "+v"(t2_)); fr = t2_ & 15; fq = (t2_ >> 4) & 3; } (void)fq;
        const int row0 = u.pm * BM + wr * 64 + fr;
#pragma unroll
        for (int ai = 0; ai < 2; ++ai)
#pragma unroll
            for (int m = 0; m < 4; ++m) {
                float ra, rb, rc; group_rstd(SSQ, row0 + ai * HALF + m * 16, ra, rb, rc);
                const float f = (t == 8) ? ra * __builtin_amdgcn_rcpf(rb) : rb * __builtin_amdgcn_rcpf(rc);
#pragma unroll
                for (int bj = 0; bj < 2; ++bj)
#pragma unroll
                    for (int n = 0; n < 2; ++n) acc[ai][bj][m][n] = acc[ai][bj][m][n] * f;
            }
    }
    __device__ __forceinline__ void operator()(const f32x4 (&acc)[2][2][4][2], const Unit& u, int wr, int wc, int fr, int fq) const {
        { int t2_ = (wr * 4 + wc) * 64 + ::lane_now(); asm volatile("" : "+v"(t2_)); fr = t2_ & 15; fq = (t2_ >> 4) & 3; }
        const int row0 = u.pm * BM + wr * 64 + fr, col0 = u.pn * BM + wc * 32 + 8 * fq;
#pragma unroll
        for (int ai = 0; ai < 2; ++ai)
#pragma unroll
            for (int m = 0; m < 4; ++m) {
                const int row = row0 + ai * HALF + m * 16;
                const size_t ro = (size_t)row * ::DMODEL;
                float ra, rb, rc; group_rstd(SSQ, row, ra, rb, rc); (void)ra; (void)rb;
                float ss = 0.f;
#pragma unroll
                for (int bj = 0; bj < 2; ++bj) {
                    const int c = col0 + bj * HALF;
                    const u32x4 xo = *(const u32x4*)(XI + ro + c);
                    const f32x4 x0 = (f32x4){::bflo(xo.x), ::bfhi(xo.x), ::bflo(xo.y), ::bfhi(xo.y)} + acc[ai][bj][m][0] * rc;
                    const f32x4 x1 = (f32x4){::bflo(xo.z), ::bfhi(xo.z), ::bflo(xo.w), ::bfhi(xo.w)} + acc[ai][bj][m][1] * rc;
                    st_bf8(XB + ro + c, x0, x1);
                    ss += ((x0[0] * x0[0] + x0[1] * x0[1]) + (x0[2] * x0[2] + x0[3] * x0[3])) + ((x1[0] * x1[0] + x1[1] * x1[1]) + (x1[2] * x1[2] + x1[3] * x1[3]));
                }
                { const int ln_ = fq * 16 + fr; ss += ::lane_xor(ss, ln_, 16); ss += ::lane_xor(ss, ln_, 32); }
                if (fq == 0) RS[(size_t)row * 16 + u.pn * 4 + wc] = ss;
            }
    }
};
struct EpiWin {
    static constexpr bool PERM = true, AFTER_DRAIN = false, RESCALE = false;
    bf16_t* O; const float* RS; float* RSQ; float* RSKV; bf16_t* KPE; float* LF; const float* rope; const float* fb;
    __device__ __forceinline__ void operator()(const f32x4 (&acc)[2][2][4][2], const Unit& u, int wr, int wc, int fr, int fq) const {
        { int t2_ = (wr * 4 + wc) * 64 + ::lane_now(); asm volatile("" : "+v"(t2_)); fr = t2_ & 15; fq = (t2_ >> 4) & 3; }
        const int row0 = u.pm * BM + wr * 64 + fr, col0 = u.pn * BM + wc * 32 + 8 * fq, ln_ = fq * 16 + fr;
#pragma unroll
        for (int ai = 0; ai < 2; ++ai)
#pragma unroll
            for (int m = 0; m < 4; ++m) {
                const int row = row0 + ai * HALF + m * 16;
                const float sc = row_rstd(RS, row);
                bf16_t* rowp = O + (size_t)row * ::PROJ_W;
                f32x4 v[2][2];
#pragma unroll
                for (int bj = 0; bj < 2; ++bj)
#pragma unroll
                    for (int n = 0; n < 2; ++n) v[bj][n] = acc[ai][bj][m][n] * sc;
#pragma unroll
                for (int bj = 0; bj < 2; ++bj) st_bf8(rowp + col0 + bj * HALF, v[bj][0], v[bj][1]);
                if (u.pn < 2) {
                    float s0 = 0.f, s1 = 0.f;
#pragma unroll
                    for (int n = 0; n < 2; ++n)
#pragma unroll
                        for (int i = 0; i < 4; ++i) { s0 += v[0][n][i] * v[0][n][i]; s1 += v[1][n][i] * v[1][n][i]; }
                    float ss = (u.pn == 0) ? s0 + s1 : s0;
                    ss += ::lane_xor(ss, ln_, 16); ss += ::lane_xor(ss, ln_, 32);
                    if (fq == 0) { if (u.pn == 0) RSQ[(size_t)row * 4 + wc] = ss; else RSKV[(size_t)row * 4 + wc] = ss; }
                    if (u.pn == 1 && wc == 0) {
                        const int pos = row & (::SEQ - 1), jb = 8 * (fq & 1);
                        const f32x4* rp = (const f32x4*)(rope + ((size_t)pos * 16 + jb) * 2);
                        f32x4 o2[2];
#pragma unroll
                        for (int n = 0; n < 2; ++n) { const f32x4 csA = rp[2 * n], csB = rp[2 * n + 1];
                            const float co[4] = {csA[0], csA[2], csB[0], csB[2]}, si[4] = {csA[1], csA[3], csB[1], csB[3]};
#pragma unroll
                            for (int i = 0; i < 4; ++i) { const float mine = v[1][n][i], oth = ::lane_xor(mine, ln_, 32);
                                o2[n][i] = (fq < 2) ? mine * co[i] - oth * si[i] : oth * si[i] + mine * co[i]; } }
                        st_bf8(KPE + (size_t)row * 32 + 8 * fq, o2[0], o2[1]);
                    }
                    if (u.pn == 1 && wc == 1 && fq == 0) {
                        f32x4 lf;
#pragma unroll
                        for (int i = 0; i < 4; ++i) { const float z = v[1][0][i] + fb[i]; lf[i] = 1.4426950408889634f * (fminf(z, 0.f) - log1pf(expf(-fabsf(z)))); }
                        *(f32x4*)(LF + (size_t)row * 4) = lf;
                    }
                }
            }
    }
};
template <class Epi, class Sched, bool ALIGN_EPI = false, bool SP2 = false>
__device__ __forceinline__ void gemm_phase(PG8_LAS unsigned char* lds, const Gemm g, const Sched& S, const Epi& E, int wv) {
    int tid_l = ::tid_from(wv); asm volatile("" : "+v"(tid_l));
    const int tid = tid_l, wid = wv, lane = tid & 63, wr = wid >> 2, wc = wid & 3, fr = lane & 15, fq = lane >> 4;
    const int K = g.K, nt = K / BK, lda = g.lda ? g.lda : K;
    unsigned voffA[2], voffB[2];
#pragma unroll
    for (int i = 0; i < 2; ++i) { int R, C; stage_rc(tid * 16 + i * 8192, R, C); const int Rb = Epi::PERM ? ((R & ~31) + perm32(R & 31)) : R;
        voffA[i] = (unsigned)(R * lda + C) * 2u; voffB[i] = (unsigned)(Rb * K + C) * 2u; }
    const size_t kstep = (size_t)(BK * 2);
    const size_t hstep = (size_t)HALF * K * 2;
    const size_t tstep = 2 * hstep;
    const size_t hstepA = (size_t)HALF * lda * 2, tstepA = 2 * hstepA;
    const unsigned ldsw = (unsigned)wid * 1024u;
    const int aoff = lds_byte(wr * 64 + fr, fq * 8), boff = lds_byte(wc * 32 + fr, fq * 8);
#define PG8_SA(b, h) (((b) * 2 + (h)) * HTB)
#define PG8_SB(b, h) ((4 + (b) * 2 + (h)) * HTB)
#define PG8_STAGE(bufoff, gbase, voff) do { _Pragma("unroll") for (int _i = 0; _i < 2; ++_i) \
        __builtin_amdgcn_global_load_lds((const unsigned*)((const char*)(gbase) + (voff)[_i]), (PG8_LAS unsigned*)(lds + (bufoff) + ldsw + _i * 8192), 16, 0, 0); } while (0)
#define PG8_LDA(dst, b, h) do { _Pragma("unroll") for (int m = 0; m < 4; ++m) _Pragma("unroll") for (int k = 0; k < 2; ++k) dst[m][k] = *(const PG8_LAS bf16x8*)(lds + PG8_SA(b, h) + aoff + m * 2048 + k * 1024); } while (0)
#define PG8_LDB(dst, b, h) do { _Pragma("unroll") for (int n = 0; n < 2; ++n) _Pragma("unroll") for (int k = 0; k < 2; ++k) dst[n][k] = *(const PG8_LAS bf16x8*)(lds + PG8_SB(b, h) + boff + n * 2048 + k * 1024); } while (0)
#define PG8_MMA(ai, bj, At, Bt) do { __builtin_amdgcn_s_setprio(1); _Pragma("unroll") for (int m = 0; m < 4; ++m) _Pragma("unroll") for (int n = 0; n < 2; ++n) _Pragma("unroll") for (int k = 0; k < 2; ++k) \
        acc[ai][bj][m][n] = __builtin_amdgcn_mfma_f32_16x16x32_bf16(Bt[n][k], At[m][k], acc[ai][bj][m][n], 0, 0, 0); __builtin_amdgcn_s_setprio(0); } while (0)
#define PG8_WAIT_V(n) asm volatile("s_waitcnt vmcnt(" #n ")" ::: "memory")
#define PG8_WAIT_L(n) asm volatile("s_waitcnt lgkmcnt(" #n ")" ::: "memory")
#define PG8_BAR __builtin_amdgcn_s_barrier()
#define PG8_SCHED __builtin_amdgcn_sched_barrier(0)
    Unit cur, nxt; int ui = 0;
    if (!S.next(0, cur)) return;
    f32x4 acc[2][2][4][2];
#pragma unroll
    for (int a = 0; a < 2; ++a)
#pragma unroll
        for (int b = 0; b < 2; ++b)
#pragma unroll
            for (int m = 0; m < 4; ++m)
#pragma unroll
                for (int n = 0; n < 2; ++n) acc[a][b][m][n] = (f32x4){0.f, 0.f, 0.f, 0.f};
    bf16x8 At[4][2], B0[2][2], B1[2][2];
    const char* cA = (const char*)g.A + (size_t)cur.pm * tstepA; const char* cB = (const char*)g.Bt + (size_t)cur.pn * tstep;
    S.a_ready(cur);
    if constexpr (SP2) {
        PG8_STAGE(PG8_SB(0, 0), cB, voffB); PG8_STAGE(PG8_SB(0, 1), cB + hstep, voffB); PG8_STAGE(PG8_SA(0, 0), cA, voffA); PG8_STAGE(PG8_SA(0, 1), cA + hstepA, voffA);
        if (wr == 1) PG8_BAR;
        PG8_WAIT_V(2); PG8_BAR;
        PG8_STAGE(PG8_SB(1, 0), cB + kstep, voffB); PG8_STAGE(PG8_SA(1, 0), cA + kstep, voffA); PG8_STAGE(PG8_SB(1, 1), cB + hstep + kstep, voffB);
        PG8_WAIT_V(6); PG8_BAR;
    } else {
        PG8_STAGE(PG8_SB(0, 0), cB, voffB); PG8_STAGE(PG8_SA(0, 0), cA, voffA); PG8_STAGE(PG8_SB(0, 1), cB + hstep, voffB); PG8_STAGE(PG8_SA(0, 1), cA + hstepA, voffA);
        if (wr == 1) PG8_BAR;
        PG8_WAIT_V(4); PG8_BAR;
        PG8_STAGE(PG8_SB(1, 0), cB + kstep, voffB); PG8_STAGE(PG8_SA(1, 0), cA + kstep, voffA); PG8_STAGE(PG8_SB(1, 1), cB + hstep + kstep, voffB);
        PG8_WAIT_V(6); PG8_BAR;
    }
    for (;;) {
        const bool has_next = S.next(ui + 1, nxt);
        const char* nA = has_next ? (const char*)g.A + (size_t)nxt.pm * tstepA : cA; const char* nB = has_next ? (const char*)g.Bt + (size_t)nxt.pn * tstep : cB;
        for (int t = 0; t < nt; t += 2) {
            if constexpr (Epi::RESCALE) { if (t == 8 || t == 12) E.rescale(acc, cur, t, wr, wc); }
            const bool last = (t == nt - 2);
            const char* a1 = cA + (size_t)(t + 1) * kstep;
            const char* a2 = last ? nA : cA + (size_t)(t + 2) * kstep; const char* b2 = last ? nB : cB + (size_t)(t + 2) * kstep;
            const char* a3 = a2 + kstep; const char* b3 = b2 + kstep;
            if (last && has_next) S.a_ready(nxt);
            if constexpr (SP2) {
            PG8_LDB(B0, 0, 0); PG8_LDB(B1, 0, 1); PG8_SCHED; PG8_LDA(At, 0, 0); PG8_STAGE(PG8_SA(1, 1), a1 + hstepA, voffA);
            PG8_WAIT_V(8); PG8_WAIT_L(0); PG8_BAR; PG8_MMA(0, 0, At, B0); PG8_MMA(0, 1, At, B1); PG8_BAR; PG8_SCHED;
            PG8_LDA(At, 0, 1); PG8_STAGE(PG8_SB(0, 0), b2, voffB); PG8_STAGE(PG8_SB(0, 1), b2 + hstep, voffB); PG8_STAGE(PG8_SA(0, 0), a2, voffA);
            PG8_WAIT_V(8); PG8_WAIT_L(0); PG8_BAR; PG8_MMA(1, 0, At, B0); PG8_MMA(1, 1, At, B1); PG8_BAR; PG8_SCHED;
            PG8_LDB(B0, 1, 0); PG8_LDB(B1, 1, 1); PG8_SCHED; PG8_LDA(At, 1, 0); PG8_STAGE(PG8_SA(0, 1), a2 + hstepA, voffA);
            PG8_WAIT_V(8); PG8_WAIT_L(0); PG8_BAR; PG8_MMA(0, 0, At, B0); PG8_MMA(0, 1, At, B1); PG8_BAR; PG8_SCHED;
            PG8_LDA(At, 1, 1); PG8_STAGE(PG8_SB(1, 0), b3, voffB); PG8_STAGE(PG8_SB(1, 1), b3 + hstep, voffB); PG8_STAGE(PG8_SA(1, 0), a3, voffA);
            PG8_WAIT_V(8); PG8_WAIT_L(0); PG8_BAR; PG8_MMA(1, 0, At, B0); PG8_MMA(1, 1, At, B1); PG8_BAR; PG8_SCHED;
            } else {
            PG8_LDB(B0, 0, 0); PG8_SCHED; PG8_LDA(At, 0, 0); PG8_STAGE(PG8_SA(1, 1), a1 + hstepA, voffA);
            PG8_WAIT_L(8); PG8_BAR; PG8_WAIT_L(0); PG8_MMA(0, 0, At, B0); PG8_BAR; PG8_SCHED;
            PG8_LDB(B1, 0, 1); PG8_STAGE(PG8_SB(0, 0), b2, voffB);
            PG8_BAR; PG8_WAIT_L(0); PG8_MMA(0, 1, At, B1); PG8_BAR;
            PG8_LDA(At, 0, 1); PG8_STAGE(PG8_SA(0, 0), a2, voffA);
            PG8_BAR; PG8_WAIT_L(0); PG8_MMA(1, 0, At, B0); PG8_BAR; PG8_SCHED;
            PG8_STAGE(PG8_SB(0, 1), b2 + hstep, voffB);
            PG8_WAIT_V(6); PG8_BAR; PG8_MMA(1, 1, At, B1); PG8_BAR;
            PG8_LDB(B0, 1, 0); PG8_SCHED; PG8_LDA(At, 1, 0); PG8_STAGE(PG8_SA(0, 1), a2 + hstepA, voffA);
            PG8_WAIT_L(8); PG8_BAR; PG8_WAIT_L(0); PG8_MMA(0, 0, At, B0); PG8_BAR; PG8_SCHED;
            PG8_LDB(B1, 1, 1); PG8_STAGE(PG8_SB(1, 0), b3, voffB);
            PG8_BAR; PG8_WAIT_L(0); PG8_MMA(0, 1, At, B1); PG8_BAR;
            PG8_LDA(At, 1, 1); PG8_STAGE(PG8_SA(1, 0), a3, voffA);
            PG8_BAR; PG8_WAIT_L(0); PG8_MMA(1, 0, At, B0); PG8_BAR; PG8_SCHED;
            PG8_STAGE(PG8_SB(1, 1), b3 + hstep, voffB);
            PG8_WAIT_V(6); PG8_BAR; PG8_MMA(1, 1, At, B1); PG8_BAR;
            }
        }
        if constexpr (ALIGN_EPI) { if (wr == 0) PG8_BAR; }
        if constexpr (!Epi::AFTER_DRAIN) { E(acc, cur, wr, wc, fr, fq); S.done(cur); }
        if (!has_next) break;
#pragma unroll
        for (int a = 0; a < 2; ++a)
#pragma unroll
            for (int b = 0; b < 2; ++b)
#pragma unroll
                for (int m = 0; m < 4; ++m)
#pragma unroll
                    for (int n = 0; n < 2; ++n) acc[a][b][m][n] = (f32x4){0.f, 0.f, 0.f, 0.f};
        cur = nxt; cA = nA; cB = nB; ++ui;
        if constexpr (ALIGN_EPI) { if (wr == 1) PG8_BAR; }
    }
    PG8_WAIT_V(0);
    if constexpr (!ALIGN_EPI) { if (wr == 0) PG8_BAR; }
    PG8_BAR;
    if constexpr (Epi::AFTER_DRAIN) { E.fused(acc, cur, wr, wc, fr, fq, lds, wid, lane); S.done(cur); }
#undef PG8_SA
#undef PG8_SB
#undef PG8_STAGE
#undef PG8_LDA
#undef PG8_LDB
#undef PG8_MMA
#undef PG8_WAIT_V
#undef PG8_WAIT_L
#undef PG8_BAR
#undef PG8_SCHED
}
}
constexpr size_t MiB = 1u << 20;
constexpr size_t WS_W = 0, W_LAYER = 28 * MiB;
constexpr size_t WO_IN = 0, WO_UQ = 4 * MiB, WO_UKV = 4 * MiB + 512 * 1024, WO_O = 5 * MiB, WO_CQ = 7 * MiB, WO_CKV = 8 * MiB, WO_CO = 10 * MiB, WO_GU = 11 * MiB, WO_DOWN = 22 * MiB;
constexpr size_t WS_XB = 56 * MiB;
constexpr size_t WS_RS = 120 * MiB;
constexpr size_t WS_KPE = 122 * MiB;
constexpr size_t WS_LC = 124 * MiB;
constexpr size_t WS_CUM = 124 * MiB + 512 * 1024;
constexpr size_t WS_TOT = 125 * MiB;
constexpr size_t WS_ROPE = 125 * MiB + 512 * 1024;
constexpr size_t WS_MEMN = 127 * MiB;
constexpr size_t WS_KVMEM = 129 * MiB;
constexpr size_t WS_PROJ = 134 * MiB;
constexpr size_t WS_CQN = 262 * MiB;
constexpr size_t WS_CKVN = 278 * MiB;
constexpr size_t WS_QM = 294 * MiB;
constexpr size_t WS_HID = 134 * MiB;
constexpr size_t WS_KV = 326 * MiB;
constexpr size_t WS_Y = 374 * MiB;
constexpr size_t WS_SSQ = 438 * MiB;
constexpr size_t WS_RSQ = 440 * MiB;
constexpr size_t WS_RSKV = 440 * MiB + 512 * 1024;
constexpr size_t WS_BAR = 441 * MiB;
constexpr size_t WS_XB2 = 442 * MiB;
constexpr size_t WS_END = 506 * MiB;

constexpr int LDS_BYTES = 131072 + 4096;

struct Args { const float* in[21]; float* out; unsigned char* ws; int ph_lo, ph_hi; };
typedef const __attribute__((address_space(4))) Args* KArgs;

__device__ __forceinline__ int conv_map(int type, int n, float& sc) {
    sc = 1.0f;
    switch (type) {
    case 0:
        if (n < 416) return n;
        if (n < 420) return 1184 + (n - 416);
        if (n < 512) return -1;
        if (n < 1280) { if (n < 768) sc = SC_64; return 416 + (n - 512); }
        if (n < 1536) sc = SC_64;
        return 1188 + (n - 1280);
    case 1: sc = SC_MLA; return n < 384 ? n : -1;
    case 2: if (n < 256) return (n >> 6) * 192 + (n & 63); else { const int mm = n - 256; return (mm >> 7) * 192 + 64 + (mm & 127); }
    case 4: sc = SC_CROSS; return n;
    case 7: { const int t = n >> 8, c = n & 255; return c < 128 ? 128 * t + c : FFN_H + 128 * t + (c - 128); }
    default: return n;
    }
}
__device__ __forceinline__ void conv_tile(const float* src, const float* gain, bf16_t* dst, int K, int Nsrc, int Nd, int Kd, int type, int tile, LAS float* scr, int wv, int koff = 0) {
    int tid_l = tid_from(wv); asm volatile("" : "+v"(tid_l));
    const int tid = tid_l, ntn = Nd >> 8, kb = tile / ntn, nb = tile - kb * ntn, k0 = kb * 64, n0 = nb * 256;
    { const int nn = tid & 255, kh = tid >> 8; float sc; const int sn = conv_map(type, n0 + nn, sc);
      const float* sp = src + (size_t)(k0 + kh - koff) * Nsrc + (sn >= 0 ? sn : 0);
#pragma unroll 8
      for (int i = 0; i < 32; ++i) { const int kk = kh + 2 * i, k = k0 + kk; float v = 0.f;
          if (sn >= 0 && k >= koff && k - koff < K) { v = __builtin_nontemporal_load(sp + (size_t)(2 * i) * Nsrc) * sc; if (gain) v *= gain[k - koff]; }
          scr[nn * 65 + kk] = v; } }
    __syncthreads();
#pragma unroll
    for (int j = 0; j < 4; ++j) { const int idx = tid + 512 * j, nn = idx >> 3, kq = (idx & 7) * 8; const LAS float* s = scr + nn * 65 + kq;
      u32x4 o; o.x = pk2(s[0], s[1]); o.y = pk2(s[2], s[3]); o.z = pk2(s[4], s[5]); o.w = pk2(s[6], s[7]);
      *(u32x4*)(dst + (size_t)(n0 + nn) * Kd + k0 + kq) = o; }
    __syncthreads();
}
__device__ __forceinline__ void phase_prologue(KArgs a, LAS unsigned char* lds, int wv, int part) {
    LAS float* scr = (LAS float*)lds;
    unsigned char* ws = a->ws;
    int tid_l = tid_from(wv); asm volatile("" : "+v"(tid_l));
    const int tid = tid_l, lane = tid & 63, wave = tid >> 6;
    constexpr int NT_L = 128 + 12 + 18 + 64 + 32 + 64 + 32 + 352 + 176;
    const int g_lo = part == 0 ? 0 : 128, g_hi = part == 0 ? 128 : NLAYER * NT_L;
    for (int g = g_lo + blockIdx.x; g < g_hi; g += gridDim.x) {
        const int l = g / NT_L; int r = g - l * NT_L;
        bf16_t* wb = (bf16_t*)(ws + WS_W + (size_t)l * W_LAYER);
        if (r < 128) { conv_tile(a->in[3] + (size_t)l * 1024 * IN_W, a->in[2] + l * 1024, (bf16_t*)((unsigned char*)wb + WO_IN), 1024, IN_W, 2048, 1024, 0, r, scr, wv); continue; } r -= 128;
        if (r < 12) { conv_tile(a->in[5] + (size_t)l * 256 * 384, a->in[4] + l * 256, (bf16_t*)((unsigned char*)wb + WO_UQ), 256, 384, 512, 384, 1, r, scr, wv); continue; } r -= 12;
        if (r < 18) { conv_tile(a->in[7] + (size_t)l * 128 * 768, a->in[6] + l * 128, (bf16_t*)((unsigned char*)wb + WO_UQ) + (size_t)512 * 384, 128, 768, 768, 384, 2, r, scr, wv, 256); continue; } r -= 18;
        if (r < 64) { conv_tile(a->in[11] + (size_t)l * 1024 * 1024, a->in[10] + l * 1024, (bf16_t*)((unsigned char*)wb + WO_O), 1024, 1024, 1024, 1024, 3, r, scr, wv); continue; } r -= 64;
        if (r < 32) { conv_tile(a->in[14] + (size_t)l * 1024 * 512, a->in[12] + l * 1024, (bf16_t*)((unsigned char*)wb + WO_CQ), 1024, 512, 512, 1024, 4, r, scr, wv); continue; } r -= 32;
        if (r < 64) { conv_tile(a->in[15] + (size_t)l * 1024 * 1024, a->in[13] + l * 1024, (bf16_t*)((unsigned char*)wb + WO_CKV), 1024, 1024, 1024, 1024, 5, r, scr, wv); continue; } r -= 64;
        if (r < 32) { conv_tile(a->in[16] + (size_t)l * 512 * 1024, nullptr, (bf16_t*)((unsigned char*)wb + WO_CO), 512, 1024, 1024, 512, 6, r, scr, wv); continue; } r -= 32;
        if (r < 352) { conv_tile(a->in[18] + (size_t)l * 1024 * 2 * FFN_H, a->in[17] + l * 1024, (bf16_t*)((unsigned char*)wb + WO_GU), 1024, 2 * FFN_H, 2 * FFN_H, 1024, 7, r, scr, wv); continue; } r -= 352;
        conv_tile(a->in[19] + (size_t)l * FFN_H * 1024, nullptr, (bf16_t*)((unsigned char*)wb + WO_DOWN), FFN_H, 1024, 1024, FFN_H, 8, r, scr, wv);
    }
    if (part != 0) return;
    const int gw = blockIdx.x * NWAVES + wave, ngw = gridDim.x * NWAVES;
    bf16_t* XB = (bf16_t*)(ws + WS_XB); float* RS = (float*)(ws + WS_RS); bf16_t* MEMN = (bf16_t*)(ws + WS_MEMN);
    for (int row = gw; row < T_TOK + NBATCH * MEMLEN; row += ngw) {
        const bool ismem = row >= T_TOK; const int rr = ismem ? row - T_TOK : row;
        const f32x4* xr = (const f32x4*)((ismem ? a->in[1] : a->in[0]) + (size_t)rr * DMODEL) + lane;
        f32x4 v[4]; float s = 0.f;
#pragma unroll
        for (int j = 0; j < 4; ++j) { v[j] = __builtin_nontemporal_load(xr + 64 * j); s += (v[j][0] * v[j][0] + v[j][1] * v[j][1]) + (v[j][2] * v[j][2] + v[j][3] * v[j][3]); }
        s = wave_sum(s, lane);
        float sc = 1.0f;
        if (ismem) sc = __builtin_amdgcn_rsqf(s * (1.0f / 1024.0f) + EPS);
        else if (lane < 16) RS[(size_t)rr * 16 + lane] = lane == 0 ? s : 0.f;
        u32x2* o8 = (u32x2*)((ismem ? MEMN : XB) + (size_t)rr * DMODEL) + lane;
#pragma unroll
        for (int j = 0; j < 4; ++j) { u32x2 w; w.x = pk2(v[j][0] * sc, v[j][1] * sc); w.y = pk2(v[j][2] * sc, v[j][3] * sc); o8[64 * j] = w; }
    }
    float* rope = (float*)(ws + WS_ROPE);
    for (int i = blockIdx.x * NTHREADS + tid; i < SEQ * 16; i += gridDim.x * NTHREADS) {
        const int pos = i >> 4, j = i & 15;
        const float inv = powf(10000.0f, -(float)(2 * j) / 32.0f), ang = (float)pos * inv;
        rope[2 * i] = cosf(ang); rope[2 * i + 1] = sinf(ang);
    }
}

__device__ __forceinline__ void phase_cum(KArgs a, LAS unsigned char* lds, int wv) {
    unsigned char* ws = a->ws;
    const float* LF = (const float*)(ws + WS_LC); float* CUM = (float*)(ws + WS_CUM);
    LAS float* sc = (LAS float*)lds;
    LAS float* lc = (LAS float*)(lds + 2048);
    int tid_l = tid_from(wv); asm volatile("" : "+v"(tid_l));
    const int tid = tid_l, lane = tid & 63, wave = tid >> 6;
    for (int c = blockIdx.x; c < T_TOK / 64; c += gridDim.x) {
        const int b = c >> 7, ci = c & 127, n0 = ci * 64;
        { const f32x4* base = (const f32x4*)(LF + (size_t)b * SEQ * 4);
          f32x4 acc = (f32x4){0.f, 0.f, 0.f, 0.f};
          for (int t = tid; t < n0; t += NTHREADS) acc += base[t];
#pragma unroll
          for (int k = 0; k < 4; ++k) acc[k] = wave_sum(acc[k], lane);
          if (lane == 0) *(LAS f32x4*)(sc + wave * 4) = acc;
          if (tid < 256) lc[tid] = LF[((size_t)c * 64) * 4 + tid]; }
        __syncthreads();
        if (tid < 256) {
            const int h = tid & 3, i = tid >> 2; float p = 0.f;
#pragma unroll
            for (int w = 0; w < NWAVES; ++w) p += sc[w * 4 + h];
            for (int j = 0; j <= i; ++j) p += lc[j * 4 + h];
            CUM[(size_t)(c * 64 + i) * 4 + h] = p;
        }
        __syncthreads();
    }
}

__device__ __forceinline__ f32x16 mfma32(bf16x8 a, bf16x8 b, f32x16 c) { return __builtin_amdgcn_mfma_f32_32x32x16_bf16(a, b, c, 0, 0, 0); }
typedef short v4i16_t __attribute__((ext_vector_type(4)));
__device__ __forceinline__ float max3f(float a, float b, float c) { float r; asm("v_max3_f32 %0, %1, %2, %3" : "=v"(r) : "v"(a), "v"(b), "v"(c)); return r; }
__device__ __forceinline__ s16x4 vtr(const LAS unsigned char* p) { return __builtin_bit_cast(s16x4, __builtin_amdgcn_ds_read_tr16_b64_v4i16((LAS v4i16_t*)p)); }

struct AttnT {
    const bf16_t* Q; int qpitch, qcol;
    const bf16_t* K; int kpitch, kcol;
    const bf16_t* K2;
    const bf16_t* V; int vpitch, vcol;
    bf16_t* O; int opitch, ocol;
    const float* cum;
    const float* relb;
    const float* rope;
    float* ssq; int slot0;
};
template <int DQK, int DV, int MODE>
__device__ __forceinline__ void attn_unit(LAS unsigned char* lds, const AttnT& A, int b, int h, int qb, int wv) {
    constexpr int KB = DQK * 128, VB = DV * 128, KVB = KB + VB;
    constexpr int KPT = (8 * DQK + 511) / 512, VPT = (8 * DV + 511) / 512, ND = DQK / 16, NV = DV / 32;
    int tid_l = tid_from(wv); asm volatile("" : "+v"(tid_l));
    const int tid = tid_l, lane = tid & 63, r32 = lane & 31, hi = lane >> 5;
    const int wid = wv;
    LAS float* xtra = (LAS float*)(lds + 2 * KVB);
    const int q0 = qb * 256;
    const size_t qrow = (size_t)b * SEQ + q0 + wid * 32 + r32;
    const size_t krow0 = (MODE == 3) ? (size_t)b * MEMLEN : (size_t)b * SEQ;
    int kt_lo = 0, kt_hi = 4 * qb + 4;
    if (MODE == 2) kt_lo = (4 * qb - 8) > 0 ? (4 * qb - 8) : 0;
    if (MODE == 3) kt_hi = 4;
    const int wchunk = 4 * qb + (wid >> 1);
    int w_lo = 0, w_hi = wchunk;
    if (MODE == 2) w_lo = (wchunk - 8) > 0 ? (wchunk - 8) : 0;
    if (MODE == 3) w_hi = 3;
    bf16x8 qr[ND];
    { const bf16_t* qp = A.Q + qrow * A.qpitch + A.qcol + h * DQK + hi * 8;
#pragma unroll
      for (int d0 = 0; d0 < ND; ++d0) qr[d0] = *(const bf16x8*)(qp + d0 * 16); }
    if (MODE == 0) {
        const f32x4* rp = (const f32x4*)(A.rope + ((size_t)(q0 + wid * 32 + r32) * 16 + 8 * hi) * 2);
        bf16x8 a1 = qr[ND - 2], a2 = qr[ND - 1];
#pragma unroll
        for (int jj = 0; jj < 4; ++jj) { const f32x4 cs = rp[jj];
            const float x1a = bf2f((bf16_t)a1[2 * jj]), x2a = bf2f((bf16_t)a2[2 * jj]), x1b = bf2f((bf16_t)a1[2 * jj + 1]), x2b = bf2f((bf16_t)a2[2 * jj + 1]);
            const unsigned w1 = pk2(x1a * cs[0] - x2a * cs[1], x1b * cs[2] - x2b * cs[3]), w2 = pk2(x1a * cs[1] + x2a * cs[0], x1b * cs[3] + x2b * cs[2]);
            a1[2 * jj] = (short)(w1 & 0xffffu); a1[2 * jj + 1] = (short)(w1 >> 16); a2[2 * jj] = (short)(w2 & 0xffffu); a2[2 * jj + 1] = (short)(w2 >> 16); }
        qr[ND - 2] = a1; qr[ND - 1] = a2;
    }
    if (MODE == 2) { if (tid < 192) xtra[tid] = A.relb[h * 192 + tid] * LOG2E; }
    f32x16 o[NV];
#pragma unroll
    for (int d = 0; d < NV; ++d)
#pragma unroll
        for (int r = 0; r < 16; ++r) o[d][r] = 0.f;
    float mrun = 0.f, lrun = 0.f; bool first = true;
    u32x4 kreg[KPT], vreg[VPT]; float ckreg = 0.f;
    constexpr bool DEEP = (MODE != 3);
    u32x4 kreg2[KPT], vreg2[VPT]; float ckreg2 = 0.f;
#define GLOAD(kt, KR, VR, CR) do { const size_t rb_ = krow0 + (size_t)(kt) * 64; \
    _Pragma("unroll") for (int i_ = 0; i_ < KPT; ++i_) { const int e_ = tid + 512 * i_; if (e_ < 8 * DQK) { const int key_ = e_ & 63, c8_ = e_ >> 6; \
        const bf16_t* p_; if (MODE == 0 && c8_ >= 8) p_ = A.K2 + (rb_ + key_) * 32 + (c8_ - 8) * 8; else p_ = A.K + (rb_ + key_) * A.kpitch + A.kcol + h * (MODE == 0 ? 64 : DQK) + c8_ * 8; \
        KR[i_] = *(const u32x4*)p_; } } \
    _Pragma("unroll") for (int i_ = 0; i_ < VPT; ++i_) { const int e_ = tid + 512 * i_; const int part_ = e_ & 3, key_ = (e_ >> 2) & 63, d0_ = e_ >> 8; \
        VR[i_] = *(const u32x4*)(A.V + (rb_ + key_) * A.vpitch + A.vcol + h * DV + d0_ * 32 + part_ * 8); } \
    if (MODE == 1) { if (tid < 64) CR = A.cum[(rb_ + tid) * 4 + h]; } } while (0)
#define LWRITE(buf) do { LAS unsigned char* kb_ = lds + (buf) * KVB; \
    _Pragma("unroll") for (int i_ = 0; i_ < KPT; ++i_) { const int e_ = tid + 512 * i_; if (e_ < 8 * DQK) *(LAS u32x4*)(kb_ + e_ * 16) = kreg[i_]; } \
    _Pragma("unroll") for (int i_ = 0; i_ < VPT; ++i_) { const int e_ = tid + 512 * i_; *(LAS u32x4*)(kb_ + KB + e_ * 16) = vreg[i_]; } \
    if (MODE == 1) { if (tid < 64) xtra[(buf) * 64 + tid] = ckreg; } } while (0)
    const int nsteps = kt_hi - kt_lo;
#define KT(i_) ((MODE == 1) ? (kt_hi - 1 - (i_)) : (kt_lo + (i_)))
    GLOAD(KT(0), kreg, vreg, ckreg); LWRITE(0);
    if (DEEP) { if (1 < nsteps) GLOAD(KT(1), kreg, vreg, ckreg); }
    __syncthreads();
    bool hot = (MODE != 1);
#pragma unroll 1
    for (int it = 0; it < nsteps; ++it) {
        const int kt = KT(it);
        const int cur = it & 1;
        const bool more = it + 1 < nsteps;
        if (DEEP) { if (it + 2 < nsteps) GLOAD(KT(it + 2), kreg2, vreg2, ckreg2); } else { if (more) GLOAD(KT(it + 1), kreg, vreg, ckreg); }
        if (kt >= w_lo && kt <= w_hi) {
            const LAS unsigned char* Kb = lds + cur * KVB; const LAS unsigned char* Vb = Kb + KB;
            constexpr int NDA = ND > 6 ? ND / 2 : ND;
            bf16x8 kf0[NDA], kf1[NDA];
#pragma unroll
            for (int d0 = 0; d0 < NDA; ++d0) {
                kf0[d0] = *(const LAS bf16x8*)(Kb + (2 * d0 + hi) * 1024 + r32 * 16);
                kf1[d0] = *(const LAS bf16x8*)(Kb + (2 * d0 + hi) * 1024 + 512 + r32 * 16);
            }
            f32x4 ck0[4], ck1[4];
            if (MODE == 1) { const LAS float* ck = xtra + cur * 64;
#pragma unroll
                for (int g = 0; g < 4; ++g) { ck0[g] = *(const LAS f32x4*)(ck + 8 * g + 4 * hi); ck1[g] = *(const LAS f32x4*)(ck + 32 + 8 * g + 4 * hi); } }
            __builtin_amdgcn_sched_barrier(0);
            f32x16 p0, p1;
            { const float nm = -mrun;
#pragma unroll
            for (int r = 0; r < 16; ++r) { p0[r] = nm; p1[r] = nm; } }
#pragma unroll
            for (int d0 = 0; d0 < NDA; ++d0) { p0 = mfma32(kf0[d0], qr[d0], p0); p1 = mfma32(kf1[d0], qr[d0], p1); }
            __builtin_amdgcn_sched_barrier(0);
            if (NDA < ND) {
#pragma unroll
                for (int d0 = 0; d0 < ND - NDA; ++d0) {
                    kf0[d0] = *(const LAS bf16x8*)(Kb + (2 * (d0 + NDA) + hi) * 1024 + r32 * 16);
                    kf1[d0] = *(const LAS bf16x8*)(Kb + (2 * (d0 + NDA) + hi) * 1024 + 512 + r32 * 16);
                }
                __builtin_amdgcn_sched_barrier(0);
#pragma unroll
                for (int d0 = 0; d0 < ND - NDA; ++d0) { p0 = mfma32(kf0[d0], qr[d0 + NDA], p0); p1 = mfma32(kf1[d0], qr[d0 + NDA], p1); }
                __builtin_amdgcn_sched_barrier(0);
            }
            asm volatile("s_nop 15\n\ts_nop 7" : "+v"(p0), "+v"(p1));
            const LAS unsigned char* vbase = Vb + (4 * hi + ((lane & 15) >> 2)) * 64 + ((lane >> 4) & 1) * 32 + (lane & 3) * 8;
            constexpr int KSA = NV > 2 ? 1 : 4;
            s16x4 vlo[4][NV], vh4[4][NV];
            if (hot) {
#pragma unroll
                for (int ks = 0; ks < KSA; ++ks)
#pragma unroll
                    for (int d = 0; d < NV; ++d) { vlo[ks][d] = vtr(vbase + d * 4096 + ks * 1024); vh4[ks][d] = vtr(vbase + d * 4096 + ks * 1024 + 512); }
            }
            __builtin_amdgcn_sched_barrier(0);
            if (MODE == 1) {
#pragma unroll
                for (int g = 0; g < 4; ++g)
#pragma unroll
                    for (int i = 0; i < 4; ++i) { p0[4 * g + i] -= ck0[g][i]; p1[4 * g + i] -= ck1[g][i]; }
                if (kt * 64 + 63 > q0 + wid * 32) {
                    const int qrel = q0 + wid * 32 + r32 - kt * 64;
#pragma unroll
                    for (int r = 0; r < 16; ++r) { const int kk = (r & 3) + 8 * (r >> 2) + 4 * hi; if (kk > qrel) p0[r] = -INFINITY; if (kk + 32 > qrel) p1[r] = -INFINITY; }
                }
            }
            if (MODE == 2) {
                if (wchunk - kt >= 3) { const float cb = xtra[191];
#pragma unroll
                    for (int r = 0; r < 16; ++r) { p0[r] += cb; p1[r] += cb; } }
                else { const int qrel = q0 + wid * 32 + r32 - kt * 64 + 63;
#pragma unroll
                    for (int r = 0; r < 16; ++r) { const int kk = (r & 3) + 8 * (r >> 2) + 4 * hi;
                        int i0 = qrel - kk, i1 = qrel - kk - 32; i0 = i0 < 0 ? 0 : (i0 > 191 ? 191 : i0); i1 = i1 < 0 ? 0 : (i1 > 191 ? 191 : i1);
                        p0[r] += xtra[i0]; p1[r] += xtra[i1]; } }
            }
            float mx = max3f(p0[0], p0[1], p1[0]), mx2 = max3f(p0[2], p0[3], p1[1]);
            mx = max3f(mx, p1[2], p1[3]);
#pragma unroll
            for (int r = 4; r < 16; r += 4) { mx = max3f(mx, p0[r], p0[r + 1]); mx2 = max3f(mx2, p0[r + 2], p0[r + 3]); mx = max3f(mx, p1[r], p1[r + 1]); mx2 = max3f(mx2, p1[r + 2], p1[r + 3]); }
            mx = max3f(mx, mx2, mx2);
            mx = max3f(mx, mx, lane_xor(mx, lane, 32));
            const bool dead = (MODE == 1) && !first && __all(mx < -160.0f);
            if (!dead) {
            if (MODE == 1 && !hot) {
#pragma unroll
                for (int ks = 0; ks < KSA; ++ks)
#pragma unroll
                    for (int d = 0; d < NV; ++d) { vlo[ks][d] = vtr(vbase + d * 4096 + ks * 1024); vh4[ks][d] = vtr(vbase + d * 4096 + ks * 1024 + 512); }
                hot = true;
            }
            if (first || __any(mx > 8.0f)) {
                const float dl = first ? mx : fmaxf(mx, 0.f);
                mrun += dl;
#pragma unroll
                for (int r = 0; r < 16; ++r) { p0[r] -= dl; p1[r] -= dl; }
                if (!first) { const float f = __builtin_amdgcn_exp2f(-dl); lrun *= f;
#pragma unroll
                    for (int d = 0; d < NV; ++d)
#pragma unroll
                        for (int r = 0; r < 16; ++r) o[d][r] *= f; }
                first = false;
            }
            float ls = 0.f;
#pragma unroll
            for (int r = 0; r < 16; ++r) { p0[r] = __builtin_amdgcn_exp2f(p0[r]); p1[r] = __builtin_amdgcn_exp2f(p1[r]); ls += p0[r] + p1[r]; }
            lrun += ls;
            u32x4 pw[4];
            pw[0] = (u32x4){pk2(p0[0], p0[1]), pk2(p0[2], p0[3]), pk2(p0[4], p0[5]), pk2(p0[6], p0[7])};
            pw[1] = (u32x4){pk2(p0[8], p0[9]), pk2(p0[10], p0[11]), pk2(p0[12], p0[13]), pk2(p0[14], p0[15])};
            pw[2] = (u32x4){pk2(p1[0], p1[1]), pk2(p1[2], p1[3]), pk2(p1[4], p1[5]), pk2(p1[6], p1[7])};
            pw[3] = (u32x4){pk2(p1[8], p1[9]), pk2(p1[10], p1[11]), pk2(p1[12], p1[13]), pk2(p1[14], p1[15])};
            __builtin_amdgcn_sched_barrier(0);
#pragma unroll
            for (int ks = 0; ks < 4; ++ks) {
                if (KSA < 4 && ks + 1 < 4) {
#pragma unroll
                    for (int d = 0; d < NV; ++d) { vlo[ks + 1][d] = vtr(vbase + d * 4096 + (ks + 1) * 1024); vh4[ks + 1][d] = vtr(vbase + d * 4096 + (ks + 1) * 1024 + 512); }
                    __builtin_amdgcn_sched_barrier(0);
                }
                const bf16x8 pf = __builtin_bit_cast(bf16x8, pw[ks]);
#pragma unroll
                for (int d = 0; d < NV; ++d) {
                    const s16x4 lo = vlo[ks][d], h4 = vh4[ks][d];
                    const bf16x8 vf = (bf16x8){lo[0], lo[1], lo[2], lo[3], h4[0], h4[1], h4[2], h4[3]};
                    o[d] = mfma32(vf, pf, o[d]);
                }
                if (KSA < 4) __builtin_amdgcn_sched_barrier(0);
            }
            } else { hot = false; }
        }
        if (more) LWRITE(cur ^ 1);
        __syncthreads();
        if (DEEP) {
#pragma unroll
            for (int i_ = 0; i_ < KPT; ++i_) kreg[i_] = kreg2[i_];
#pragma unroll
            for (int i_ = 0; i_ < VPT; ++i_) vreg[i_] = vreg2[i_];
            ckreg = ckreg2;
        }
    }
#undef GLOAD
#undef LWRITE
#undef KT
    lrun += lane_xor(lrun, lane, 32);
    const float rl = 1.0f / lrun;
    {
        constexpr int NCH16 = DV / 8, RB = DV * 2;
        LAS unsigned char* stg = lds + 65536 + wid * (32 * RB);
#pragma unroll
        for (int d = 0; d < NV; ++d)
#pragma unroll
            for (int g = 0; g < 4; ++g) { u32x2 w; w.x = pk2(o[d][4 * g] * rl, o[d][4 * g + 1] * rl); w.y = pk2(o[d][4 * g + 2] * rl, o[d][4 * g + 3] * rl);
                const int pi = 8 * d + 2 * g + hi, ch = pi >> 1, sub = pi & 1;
                *(LAS u32x2*)(stg + r32 * RB + ((ch ^ (r32 & (NCH16 - 1))) * 16) + sub * 8) = w; }
        bf16_t* ob = A.O + ((size_t)b * SEQ + q0 + wid * 32) * A.opitch + A.ocol + h * DV;
#pragma unroll
        for (int i = 0; i < (32 * NCH16) / 64; ++i) { const int row = i * (64 / NCH16) + lane / NCH16, ch = lane % NCH16;
            const u32x4 v = *(const LAS u32x4*)(stg + row * RB + ((ch ^ (row & (NCH16 - 1))) * 16));
            *(u32x4*)(ob + (size_t)row * A.opitch + ch * 8) = v; }
    }
    if (MODE != 3) {
        float sq = 0.f;
#pragma unroll
        for (int d = 0; d < NV; ++d)
#pragma unroll
            for (int r = 0; r < 16; ++r) { const float v = o[d][r] * rl; sq += v * v; }
        sq += lane_xor(sq, lane, 32);
        if (hi == 0) A.ssq[qrow * 12 + A.slot0 + h] = sq;
    }
}

__device__ __forceinline__ void phase_final(KArgs a, int wv) {
    const float* g = a->in[20];
    const bf16_t* XB = (const bf16_t*)(a->ws + (((3 * NLAYER) & 1) ? WS_XB2 : WS_XB));
    int tid_l = tid_from(wv); asm volatile("" : "+v"(tid_l));
    const int tid = tid_l, lane = tid & 63, wave = tid >> 6;
    for (int row = blockIdx.x * NWAVES + wave; row < T_TOK; row += gridDim.x * NWAVES) {
        const u32x2* xr = (const u32x2*)(XB + (size_t)row * DMODEL) + lane;
        f32x4 v[4]; float s = 0.f;
#pragma unroll
        for (int j = 0; j < 4; ++j) { const u32x2 w = xr[64 * j]; v[j] = (f32x4){bflo(w.x), bfhi(w.x), bflo(w.y), bfhi(w.y)}; s += (v[j][0] * v[j][0] + v[j][1] * v[j][1]) + (v[j][2] * v[j][2] + v[j][3] * v[j][3]); }
        const float rs = __builtin_amdgcn_rsqf(wave_sum(s, lane) * (1.0f / 1024.0f) + EPS);
        f32x4* orow = (f32x4*)(a->out + (size_t)row * DMODEL) + lane;
#pragma unroll
        for (int j = 0; j < 4; ++j) { const f32x4 gg = ((const f32x4*)g)[64 * j + lane]; orow[64 * j] = v[j] * rs * gg; }
    }
}

constexpr int PH_PER_LAYER = 9, N_PHASES = 1 + NLAYER * PH_PER_LAYER + 1;
__global__ void __launch_bounds__(NTHREADS, 2) fwd_kernel(Args args) {
    extern __shared__ __attribute__((aligned(16))) unsigned char lds_raw[];
    LAS unsigned char* lds = (LAS unsigned char*)lds_raw;
    const int lo = args.ph_lo, hi = args.ph_hi;
#define WSP(off) (wsl + (off))
#define LAUNDER_WS() KArgs ap = (KArgs)__builtin_amdgcn_kernarg_segment_ptr(); asm volatile("" : "+s"(ap)); unsigned char* wsl = ap->ws; \
    bf16_t* XB = (bf16_t*)WSP(WS_XB); bf16_t* XB2 = (bf16_t*)WSP(WS_XB2); (void)XB2; float* RS = (float*)WSP(WS_RS); bf16_t* PROJ = (bf16_t*)WSP(WS_PROJ); bf16_t* CQN = (bf16_t*)WSP(WS_CQN); bf16_t* CKVN = (bf16_t*)WSP(WS_CKVN); \
    bf16_t* QM = (bf16_t*)WSP(WS_QM); bf16_t* KV = (bf16_t*)WSP(WS_KV); bf16_t* Y = (bf16_t*)WSP(WS_Y); bf16_t* HID = (bf16_t*)WSP(WS_HID); \
    bf16_t* KPE = (bf16_t*)WSP(WS_KPE); bf16_t* MEMN = (bf16_t*)WSP(WS_MEMN); bf16_t* QC = QM; bf16_t* OC = KV; \
    const float* CUM = (const float*)WSP(WS_CUM); const float* rope = (const float*)WSP(WS_ROPE); float* SSQ = (float*)WSP(WS_SSQ); (void)SSQ; float* RSQ = (float*)WSP(WS_RSQ); float* RSKV = (float*)WSP(WS_RSKV); float* LF = (float*)WSP(WS_LC); (void)RSQ; (void)RSKV; (void)LF; \
    unsigned char* wl = wsl + WS_W + (size_t)l * W_LAYER; bf16_t* KVMEM = (bf16_t*)WSP(WS_KVMEM) + (size_t)l * 1024 * 1024; \
    (void)XB; (void)RS; (void)PROJ; (void)CQN; (void)CKVN; (void)QM; (void)KV; (void)Y; (void)HID; (void)KPE; (void)MEMN; (void)QC; (void)OC; (void)CUM; (void)rope; (void)wl; (void)KVMEM
    const int G = gridDim.x, bx = blockIdx.x;
    const int vcu = (G % 8 == 0) ? (bx % 8) * (G / 8) + bx / 8 : bx;
    volatile LAS unsigned* bst = (volatile LAS unsigned*)(lds + 131072 + 1024);
    const int wv = __builtin_amdgcn_readfirstlane((int)threadIdx.x >> 6);
    if (threadIdx.x < 4) bst[threadIdx.x] = 0u;
    __syncthreads();
    XcdBarrier gbar; gbar.bar = (unsigned*)(args.ws + WS_BAR); gbar.x = 0; gbar.st = bst; gbar.wv = wv;
    if (hi - lo > 1) gbar = xcd_barrier_post((unsigned*)(args.ws + WS_BAR), bst, wv);
    if (lo > 100000) cg::this_grid().sync();
    for (int p = lo; p < hi; ++p) {
        if (p == 0) { KArgs ap = (KArgs)__builtin_amdgcn_kernarg_segment_ptr(); asm volatile("" : "+s"(ap)); phase_prologue(ap, lds, wv, 0); }
        else if (p == N_PHASES - 1) { KArgs ap = (KArgs)__builtin_amdgcn_kernarg_segment_ptr(); asm volatile("" : "+s"(ap)); phase_final(ap, wv); }
        else {
        const int l = (p - 1) / PH_PER_LAYER, kph = (p - 1) - l * PH_PER_LAYER;
        LAUNDER_WS();
        switch (kph) {
        case 0: {
            pg8::Gemm g{((3 * l) & 1) ? XB2 : XB, (const bf16_t*)(wl + WO_IN), T_TOK, PROJ_W, 1024}; pg8::StaticOrder S; S.init(T_TOK, PROJ_W, G, bx);
            pg8::EpiWin E{PROJ, RS, RSQ, RSKV, KPE, LF, rope, ap->in[8] + l * 4};
            pg8::gemm_phase<pg8::EpiWin, pg8::StaticOrder, true, true>(lds, g, S, E, wv);
            if (l == 0) phase_prologue(ap, lds, wv, 1);
        }
        break;
        case 1: {
            { pg8::Gemm g{PROJ, (const bf16_t*)(wl + WO_UQ), T_TOK, 1280, 384, PROJ_W}; pg8::StaticOrder S; S.init(T_TOK, 1280, G, bx);
              pg8::EpiSplitQKV E{QM, KV, RSQ, RSKV};
              pg8::gemm_phase<pg8::EpiSplitQKV, pg8::StaticOrder, true, true>(lds, g, S, E, wv); }
            { pg8::Gemm g{MEMN, (const bf16_t*)(wl + WO_CKV), 1024, 1024, 1024}; pg8::StaticOrder S; S.init(1024, 1024, G, (bx + G - (128 % G)) % G);
              pg8::EpiScaleBf16<false> E{KVMEM, 1024, nullptr};
              pg8::gemm_phase<pg8::EpiScaleBf16<false>, pg8::StaticOrder, true, true>(lds, g, S, E, wv); }
            phase_cum(ap, lds, wv);
        }
        break;
        case 2: {
            { AttnT A{QM, 512, 0, KV, 768, 0, KPE, KV, 768, 256, Y, 1024, 0, nullptr, nullptr, rope, SSQ, 0};
              for (int u = vcu; u < 256; u += G) { const int bh = u >> 4, s = u & 15;
                  for (int hf = 0; hf < 2; ++hf) attn_unit<96, 128, 0>(lds, A, bh >> 2, bh & 3, hf ? s : 31 - s, wv); } }
            { AttnT A{PROJ, PROJ_W, 512, PROJ, PROJ_W, 768, nullptr, PROJ, PROJ_W, 1024, Y, 1024, 512, CUM, nullptr, nullptr, SSQ, 4};
              for (int u = vcu; u < 256; u += G) { const int bh = u >> 4, s = u & 15;
                  for (int hf = 0; hf < 2; ++hf) attn_unit<64, 64, 1>(lds, A, bh >> 2, bh & 3, hf ? s : 31 - s, wv); } }
            { AttnT A{PROJ, PROJ_W, 1280, PROJ, PROJ_W, 1536, nullptr, PROJ, PROJ_W, 1792, Y, 1024, 768, nullptr, ap->in[9] + l * 4 * 192, nullptr, SSQ, 8};
              for (int u = vcu; u < 512; u += G) { const int bh = (u >> 4) & 15, qb = (u & 15) + 16 * (u >> 8); attn_unit<64, 64, 2>(lds, A, bh >> 2, bh & 3, qb, wv); } }
        }
        break;
        case 3: {
            pg8::Gemm g{Y, (const bf16_t*)(wl + WO_O), T_TOK, 1024, 1024}; pg8::StaticOrder S; S.init(T_TOK, 1024, G, bx);
            pg8::EpiResidualY E{((3 * l) & 1) ? XB2 : XB, ((3 * l + 1) & 1) ? XB2 : XB, RS, SSQ};
            pg8::gemm_phase<pg8::EpiResidualY, pg8::StaticOrder, true, true>(lds, g, S, E, wv);
        }
        break;
        case 4: {
            pg8::Gemm g{((3 * l + 1) & 1) ? XB2 : XB, (const bf16_t*)(wl + WO_CQ), T_TOK, 512, 1024}; pg8::StaticOrder S; S.init(T_TOK, 512, G, bx);
            pg8::EpiScaleBf16<true> E{QC, 512, RS};
            pg8::gemm_phase<pg8::EpiScaleBf16<true>, pg8::StaticOrder, true, true>(lds, g, S, E, wv);
        }
        break;
        case 5: {
            AttnT A{QC, 512, 0, KVMEM, 1024, 0, nullptr, KVMEM, 1024, 512, OC, 512, 0, nullptr, nullptr, nullptr, nullptr, 0};
            for (int u = vcu; u < 512; u += G) { const int bh = (u >> 4) & 15, qb = (u & 15) + 16 * (u >> 8); attn_unit<128, 128, 3>(lds, A, bh >> 2, bh & 3, qb, wv); }
        }
        break;
        case 6: {
            pg8::Gemm g{OC, (const bf16_t*)(wl + WO_CO), T_TOK, 1024, 512}; pg8::StaticOrder S; S.init(T_TOK, 1024, G, bx);
            pg8::EpiResidual E{((3 * l + 1) & 1) ? XB2 : XB, ((3 * l + 2) & 1) ? XB2 : XB, RS, true};
            pg8::gemm_phase<pg8::EpiResidual, pg8::StaticOrder, true, true>(lds, g, S, E, wv);
        }
        break;
        case 7: {
            pg8::Gemm g{((3 * l + 2) & 1) ? XB2 : XB, (const bf16_t*)(wl + WO_GU), T_TOK, 2 * FFN_H, 1024}; pg8::StaticOrder S; S.init(T_TOK, 2 * FFN_H, G, bx);
            pg8::EpiSwiGLU E{HID, RS};
            pg8::gemm_phase<pg8::EpiSwiGLU, pg8::StaticOrder, true, true>(lds, g, S, E, wv);
        }
        break;
        case 8: {
            pg8::Gemm g{HID, (const bf16_t*)(wl + WO_DOWN), T_TOK, 1024, FFN_H}; pg8::StaticOrder S; S.init(T_TOK, 1024, G, bx);
            pg8::EpiResidual E{((3 * l + 2) & 1) ? XB2 : XB, ((3 * l + 3) & 1) ? XB2 : XB, RS, l + 1 < NLAYER};
            pg8::gemm_phase<pg8::EpiResidual, pg8::StaticOrder, true, true>(lds, g, S, E, wv);
        }
        break;

        default: break;
        }
        }
        if (p + 1 < hi) xcd_barrier(gbar);
    }
}

extern "C" void kernel_launch(void* const* d_in, const int* in_sizes, int n_in, void* d_out, int out_size, void* d_ws, size_t ws_size, hipStream_t stream) {
    static int grid = 0;
    if (grid == 0) {
        if (n_in != 21 || out_size != T_TOK * DMODEL || ws_size < WS_END) { fprintf(stderr, "kernel_launch: unexpected shapes (n_in %d, out %d, ws %zu)\n", n_in, out_size, ws_size); grid = -1; return; }
        int dev = 0, cus = 0, per_cu = 0;
        (void)hipGetDevice(&dev); (void)hipDeviceGetAttribute(&cus, hipDeviceAttributeMultiprocessorCount, dev);
        if (hipFuncSetAttribute((const void*)fwd_kernel, hipFuncAttributeMaxDynamicSharedMemorySize, LDS_BYTES) != hipSuccess) { fprintf(stderr, "kernel_launch: hipFuncSetAttribute failed\n"); grid = -1; return; }
        if (hipOccupancyMaxActiveBlocksPerMultiprocessor(&per_cu, (const void*)fwd_kernel, NTHREADS, LDS_BYTES) != hipSuccess || per_cu < 1) { fprintf(stderr, "kernel_launch: occupancy query gave %d\n", per_cu); per_cu = 1; }
        (void)hipGetLastError();
        grid = cus * 1;
        if (grid <= 0) grid = 256;
    }
    if (grid < 0) return;
    if (hipMemsetAsync((char*)d_ws + WS_BAR, 0, XCD_BAR_WORDS * 4, stream) != hipSuccess) { fprintf(stderr, "kernel_launch: memset failed\n"); return; }
    Args a{};
    for (int i = 0; i < 21; ++i) a.in[i] = (const float*)d_in[i];
    a.out = (float*)d_out; a.ws = (unsigned char*)d_ws;
#if MK_MULTI
    for (int p = 0; p < N_PHASES; ++p) { a.ph_lo = p; a.ph_hi = p + 1; hipLaunchKernelGGL(fwd_kernel, dim3(grid), dim3(NTHREADS), LDS_BYTES, stream, a); }
#else
    a.ph_lo = 0; a.ph_hi = N_PHASES;
    void* kargs[] = {&a};
    hipError_t e = hipLaunchCooperativeKernel((const void*)fwd_kernel, dim3(grid), dim3(NTHREADS), kargs, LDS_BYTES, stream);
    if (e != hipSuccess) fprintf(stderr, "kernel_launch: cooperative launch failed: %s (grid %d)\n", hipGetErrorString(e), grid);
#endif
}
```

```cpp
#include <hip/hip_runtime.h>
#include <hip/hip_cooperative_groups.h>
#include <cstdio>
#include <cstdint>
namespace cg = cooperative_groups;

#ifndef MK_MULTI
#define MK_MULTI 0
#endif

constexpr int NWAVES = 8, NTHREADS = 512;
constexpr int T_TOK = 32768, SEQ = 8192, NBATCH = 4, DMODEL = 1024, NLAYER = 2, MEMLEN = 256;
constexpr int IN_W = 1956, PROJ_W = 2048, FFN_H = 2816;
constexpr float EPS = 1e-6f, LOG2E = 1.4426950408889634f;
constexpr float SC_MLA = 0.10206207261596575f * 1.4426950408889634f;
constexpr float SC_64 = 0.125f * 1.4426950408889634f;
constexpr float SC_CROSS = 0.08838834764831845f * 1.4426950408889634f;

#define LAS __attribute__((address_space(3)))
typedef unsigned short bf16_t;
typedef float f32x4 __attribute__((ext_vector_type(4)));
typedef float f32x16 __attribute__((ext_vector_type(16)));
typedef short bf16x8 __attribute__((ext_vector_type(8)));
typedef short s16x4 __attribute__((ext_vector_type(4)));
typedef unsigned u32x4 __attribute__((ext_vector_type(4)));
typedef unsigned u32x2 __attribute__((ext_vector_type(2)));
typedef float f32x2_t __attribute__((ext_vector_type(2)));
typedef __bf16 bf16x2_t __attribute__((ext_vector_type(2)));

__device__ __forceinline__ unsigned pk2(float lo, float hi) { f32x2_t v = {lo, hi}; bf16x2_t b = __builtin_convertvector(v, bf16x2_t); return __builtin_bit_cast(unsigned, b); }
__device__ __forceinline__ float bflo(unsigned u) { return __uint_as_float(u << 16); }
__device__ __forceinline__ float bfhi(unsigned u) { return __uint_as_float(u & 0xffff0000u); }
__device__ __forceinline__ float bf2f(bf16_t h) { return __uint_as_float(((unsigned)h) << 16); }
__device__ __forceinline__ float lane_xor(float v, int lane, int m) { return __int_as_float(__builtin_amdgcn_ds_bpermute((lane ^ m) << 2, __float_as_int(v))); }
__device__ __forceinline__ float wave_sum(float v, int lane) {
#pragma unroll
    for (int o = 1; o < 64; o <<= 1) v += lane_xor(v, lane, o);
    return v;
}
__device__ __forceinline__ int lane_now() { int l; asm volatile("v_mbcnt_lo_u32_b32 %0, -1, 0\n\tv_mbcnt_hi_u32_b32 %0, -1, %0" : "=&v"(l)); return l; }
__device__ __forceinline__ int tid_from(int wv) { return wv * 64 + lane_now(); }

#define XB_TMO      128
#define XB_XCNT(j)  (256  + 64 * (j))
#define XB_XSUB(j)  (1280 + 64 * (j))
#define XB_XGEN(j)  (2304 + 64 * (j))
#define XB_TOP      3328
#define XB_TOPGEN   3392
#define XCD_BAR_WORDS 3456
#define XB_SPIN_CAP (1u << 18)


__device__ __forceinline__ unsigned xb_ld(unsigned* p)              { return __hip_atomic_load(p, __ATOMIC_RELAXED, __HIP_MEMORY_SCOPE_AGENT); }
__device__ __forceinline__ unsigned xb_add(unsigned* p, unsigned v) { return __hip_atomic_fetch_add(p, v, __ATOMIC_RELAXED, __HIP_MEMORY_SCOPE_AGENT); }
__device__ __forceinline__ unsigned xb_xcc_id() { return (unsigned)__builtin_amdgcn_s_getreg((3 << 11) | 20) & 0xFu; }
#define XB_SPIN(cond, bar) do { unsigned _sp = 0; while (cond) { __builtin_amdgcn_s_sleep(1); \
    if ((++_sp & 255u) == 0u) { if (xb_ld(&(bar)[XB_TMO])) break; if (_sp > XB_SPIN_CAP) { atomicAdd(&(bar)[XB_TMO], 1u); break; } } } } while (0)

struct XcdBarrier {
    unsigned* bar; unsigned x;
    volatile LAS unsigned* st; int wv;
};

__device__ __forceinline__ XcdBarrier xcd_barrier_post(unsigned* bar, volatile LAS unsigned* st, int wv) {
    XcdBarrier b; b.bar = bar; b.x = xb_xcc_id(); b.st = st; b.wv = wv;
    if (tid_from(wv) == 0) (void)xb_add(&bar[XB_XCNT(b.x)], 1u);
    return b;
}
__device__ __forceinline__ void xcd_barrier_complete(unsigned* bar, unsigned x, unsigned& nloc, unsigned& nx) {
    const unsigned G = gridDim.x * gridDim.y * gridDim.z;
    unsigned sum, cnt, mine, sp = 0u;
    for (;;) {
        sum = 0u; cnt = 0u; mine = 0u;
#pragma unroll
        for (unsigned j = 0; j < 16; ++j) { const unsigned c = xb_ld(&bar[XB_XCNT(j)]); sum += c; cnt += (c > 0u) ? 1u : 0u; mine = (j == x) ? c : mine; }
        if (sum == G) break;
        __builtin_amdgcn_s_sleep(1);
        if ((++sp & 255u) == 0u) { if (xb_ld(&bar[XB_TMO])) break; if (sp > XB_SPIN_CAP) { atomicAdd(&bar[XB_TMO], 1u); break; } }
    }
    nloc = mine > 0u ? mine : 1u; nx = cnt > 0u ? cnt : 1u;
}

__device__ __forceinline__ void xcd_barrier(const XcdBarrier& b) {
    asm volatile("s_waitcnt vmcnt(0)" ::: "memory");
    __syncthreads();
    if (tid_from(b.wv) == 0) {
        unsigned* bar = b.bar;
        __builtin_amdgcn_s_waitcnt(0);
        unsigned nloc = b.st[0], nx = b.st[1];
        if (nloc == 0u) { xcd_barrier_complete(bar, b.x, nloc, nx); b.st[0] = nloc; b.st[1] = nx; }
        const unsigned old = xb_add(&bar[XB_XSUB(b.x)], 1u);
        const unsigned gen = old / nloc;
        if (old + 1u == (gen + 1u) * nloc) {
            __builtin_amdgcn_fence(__ATOMIC_RELEASE, "agent");
            asm volatile("s_waitcnt vmcnt(0)" ::: "memory");
            const unsigned og = xb_add(&bar[XB_TOP], 1u);
            const unsigned tg = og / nx;
            if (og + 1u == (tg + 1u) * nx) xb_add(&bar[XB_TOPGEN], 1u);
            else XB_SPIN(xb_ld(&bar[XB_TOPGEN]) == tg, bar);
            __builtin_amdgcn_fence(__ATOMIC_ACQUIRE, "agent");
            xb_add(&bar[XB_XGEN(b.x)], 1u);
            asm volatile("s_waitcnt vmcnt(0)" ::: "memory");
        } else {
            XB_SPIN(xb_ld(&bar[XB_XGEN(b.x)]) == gen, bar);
            __builtin_amdgcn_fence(__ATOMIC_ACQUIRE, "agent");
            asm volatile("s_waitcnt vmcnt(0)" ::: "memory");
        }
    }
    __syncthreads();
}

namespace pg8 {
#define PG8_LAS __attribute__((address_space(3)))
typedef unsigned short bf16_t;
typedef short bf16x8 __attribute__((ext_vector_type(8)));
typedef float f32x4 __attribute__((ext_vector_type(4)));
typedef unsigned u32x4 __attribute__((ext_vector_type(4)));
constexpr int BM = 256, BK = 64, HALF = 128, HTB = HALF * BK * 2  , STAGE_BYTES = 8 * HTB, NXCD = 8, WGM = 8;

__host__ __device__ __forceinline__ int lds_byte(int r, int c) { const int st = (r >> 4) * 2 + (c >> 5), rr = r & 15, cc = c & 31, ob = rr * 64 + cc * 2; return st * 1024 + (ob ^ (((ob >> 9) & 1) << 5)); }
__host__ __device__ __forceinline__ void stage_rc(int b, int& R, int& C) { const int st = b / 1024, sb = b % 1024, swz = sb ^ (((sb >> 9) & 1) << 5); R = (st >> 1) * 16 + swz / 64; C = (st & 1) * 32 + (swz % 64) / 2; }
__host__ __device__ __forceinline__ int perm32(int rho) { const int n = rho >> 4, i = rho & 15; return 8 * (i >> 2) + 4 * n + (i & 3); }

struct Unit { int pm, pn; };
struct Gemm { const bf16_t* A; const bf16_t* Bt; int M, N, K; int lda; };

struct StaticOrder {
    int nM, nN, nwg, G, c;
    __host__ __device__ void init(int M, int N, int G_, int c_) { nM = M / BM; nN = N / BM; nwg = nM * nN; G = G_; c = c_; }
    __host__ __device__ bool next(int i, Unit& u) const {
        const long L = (long)i * G + c; if (L >= nwg) return false;
        int wgid = (int)L; { const int q = nwg / NXCD, r = nwg % NXCD, xcd = wgid % NXCD, off = wgid / NXCD; wgid = (xcd < r ? xcd * (q + 1) : r * (q + 1) + (xcd - r) * q) + off; }
        const int nig = WGM * nN, gid = wgid / nig, fm = gid * WGM, gsz = (nM - fm) < WGM ? (nM - fm) : WGM;
        u.pm = fm + ((wgid % nig) % gsz); u.pn = (wgid % nig) / gsz; return true;
    }
    __device__ __forceinline__ void a_ready(const Unit&) const {}
    __device__ __forceinline__ void done(const Unit&) const {}
    __device__ __forceinline__ void krange(const Unit&, int nt, int& kt0, int& nkt) const { kt0 = 0; nkt = nt; }
};
struct QkvOrder : StaticOrder {
    __device__ __forceinline__ void krange(const Unit& u, int, int& kt0, int& nkt) const { if (u.pn < 2) { kt0 = 0; nkt = 4; } else { kt0 = 4; nkt = 2; } }
};

__device__ __forceinline__ float row_rstd(const float* RS, int row) {
    const f32x4* p = (const f32x4*)(RS + (size_t)row * 16);
    const f32x4 a = p[0], b = p[1], c = p[2], d = p[3];
    const float s = ((a[0] + a[1]) + (a[2] + a[3])) + ((b[0] + b[1]) + (b[2] + b[3])) + ((c[0] + c[1]) + (c[2] + c[3])) + ((d[0] + d[1]) + (d[2] + d[3]));
    return __builtin_amdgcn_rsqf(s * (1.0f / 1024.0f) + 1e-6f);
}
__device__ __forceinline__ void st_bf8(bf16_t* p, f32x4 a, f32x4 c) { u32x4 w; w.x = ::pk2(a[0], a[1]); w.y = ::pk2(a[2], a[3]); w.z = ::pk2(c[0], c[1]); w.w = ::pk2(c[2], c[3]); *(u32x4*)p = w; }
__device__ __forceinline__ void st_bf4(bf16_t* p, f32x4 v) { u32x2 w; w.x = ::pk2(v[0], v[1]); w.y = ::pk2(v[2], v[3]); *(u32x2*)p = w; }

template <bool HAS_RS> struct EpiScaleBf16 {
    static constexpr bool PERM = true, AFTER_DRAIN = false, RESCALE = false;
    bf16_t* O; int ldc; const float* RS;
    __device__ __forceinline__ void operator()(const f32x4 (&acc)[2][2][4][2], const Unit& u, int wr, int wc, int fr, int fq) const {
        { int t2_ = (wr * 4 + wc) * 64 + ::lane_now(); asm volatile("" : "+v"(t2_)); fr = t2_ & 15; fq = (t2_ >> 4) & 3; }
        const int row0 = u.pm * BM + wr * 64 + fr, col0 = u.pn * BM + wc * 32 + 8 * fq;
#pragma unroll
        for (int ai = 0; ai < 2; ++ai)
#pragma unroll
            for (int m = 0; m < 4; ++m) {
                const int row = row0 + ai * HALF + m * 16;
                const float sc = HAS_RS ? row_rstd(RS, row) : 1.0f;
                bf16_t* rowp = O + (size_t)row * ldc;
#pragma unroll
                for (int bj = 0; bj < 2; ++bj) st_bf8(rowp + col0 + bj * HALF, acc[ai][bj][m][0] * sc, acc[ai][bj][m][1] * sc);
            }
    }
};
struct EpiQRope {
    static constexpr bool PERM = false, AFTER_DRAIN = false, RESCALE = false;
    bf16_t* O; int ldc; const float* rope;
    __device__ __forceinline__ void operator()(const f32x4 (&acc)[2][2][4][2], const Unit& u, int wr, int wc, int fr, int fq) const {
        { int t2_ = (wr * 4 + wc) * 64 + ::lane_now(); asm volatile("" : "+v"(t2_)); fr = t2_ & 15; fq = (t2_ >> 4) & 3; }
        const int row0 = u.pm * BM + wr * 64 + fr, col0 = u.pn * BM + wc * 32 + 4 * fq;
#pragma unroll
        for (int ai = 0; ai < 2; ++ai)
#pragma unroll
            for (int m = 0; m < 4; ++m) {
                const int row = row0 + ai * HALF + m * 16, pos = row & (::SEQ - 1);
                bf16_t* rowp = O + (size_t)row * ldc;
#pragma unroll
                for (int bj = 0; bj < 2; ++bj) {
                    const int c = col0 + bj * HALF;
                    if (c >= 384) continue;
                    f32x4 v0 = acc[ai][bj][m][0], v1 = acc[ai][bj][m][1];
                    if (((c >> 5) % 3) == 2) {
                        const f32x4* rp = (const f32x4*)(rope + ((size_t)pos * 16 + 4 * fq) * 2);
                        const f32x4 cs0 = rp[0], cs1 = rp[1];
                        const float co[4] = {cs0[0], cs0[2], cs1[0], cs1[2]}, si[4] = {cs0[1], cs0[3], cs1[1], cs1[3]};
                        f32x4 a, b;
#pragma unroll
                        for (int i = 0; i < 4; ++i) { a[i] = v0[i] * co[i] - v1[i] * si[i]; b[i] = v0[i] * si[i] + v1[i] * co[i]; }
                        v0 = a; v1 = b;
                    }
                    st_bf4(rowp + c, v0); st_bf4(rowp + c + 16, v1);
                }
            }
    }
};
struct EpiResidual {
    static constexpr bool PERM = true, AFTER_DRAIN = false, RESCALE = false;
    const bf16_t* XI; bf16_t* XB; float* RS; bool stats;
    __device__ __forceinline__ void operator()(const f32x4 (&acc)[2][2][4][2], const Unit& u, int wr, int wc, int fr, int fq) const {
        { int t2_ = (wr * 4 + wc) * 64 + ::lane_now(); asm volatile("" : "+v"(t2_)); fr = t2_ & 15; fq = (t2_ >> 4) & 3; }
        const int row0 = u.pm * BM + wr * 64 + fr, col0 = u.pn * BM + wc * 32 + 8 * fq;
#pragma unroll
        for (int ai = 0; ai < 2; ++ai)
#pragma unroll
            for (int m = 0; m < 4; ++m) {
                const int row = row0 + ai * HALF + m * 16;
                const size_t ro = (size_t)row * ::DMODEL;
                float ss = 0.f;
#pragma unroll
                for (int bj = 0; bj < 2; ++bj) {
                    const int c = col0 + bj * HALF;
                    const u32x4 xo = *(const u32x4*)(XI + ro + c);
                    const f32x4 x0 = (f32x4){::bflo(xo.x), ::bfhi(xo.x), ::bflo(xo.y), ::bfhi(xo.y)} + acc[ai][bj][m][0];
                    const f32x4 x1 = (f32x4){::bflo(xo.z), ::bfhi(xo.z), ::bflo(xo.w), ::bfhi(xo.w)} + acc[ai][bj][m][1];
                    st_bf8(XB + ro + c, x0, x1);
                    ss += ((x0[0] * x0[0] + x0[1] * x0[1]) + (x0[2] * x0[2] + x0[3] * x0[3])) + ((x1[0] * x1[0] + x1[1] * x1[1]) + (x1[2] * x1[2] + x1[3] * x1[3]));
                }
                { const int ln_ = fq * 16 + fr; ss += ::lane_xor(ss, ln_, 16); ss += ::lane_xor(ss, ln_, 32); }
                if (stats && fq == 0) RS[(size_t)row * 16 + u.pn * 4 + wc] = ss;
            }
    }
};
struct EpiSwiGLU {
    static constexpr bool PERM = true, AFTER_DRAIN = false, RESCALE = false;
    bf16_t* O; const float* RS;
    __device__ __forceinline__ void operator()(const f32x4 (&acc)[2][2][4][2], const Unit& u, int wr, int wc, int fr, int fq) const {
        { int t2_ = (wr * 4 + wc) * 64 + ::lane_now(); asm volatile("" : "+v"(t2_)); fr = t2_ & 15; fq = (t2_ >> 4) & 3; }
        const int row0 = u.pm * BM + wr * 64 + fr, col0 = u.pn * HALF + wc * 32 + 8 * fq;
#pragma unroll
        for (int ai = 0; ai < 2; ++ai)
#pragma unroll
            for (int m = 0; m < 4; ++m) {
                const int row = row0 + ai * HALF + m * 16;
                const float sc = row_rstd(RS, row);
                bf16_t* rowp = O + (size_t)row * ::FFN_H;
                f32x4 r2[2];
#pragma unroll
                for (int n = 0; n < 2; ++n) {
                    const f32x4 g = acc[ai][0][m][n] * sc, up = acc[ai][1][m][n] * sc;
#pragma unroll
                    for (int i = 0; i < 4; ++i) r2[n][i] = g[i] * __builtin_amdgcn_rcpf(1.0f + __builtin_amdgcn_exp2f(-g[i] * 1.4426950408889634f)) * up[i];
                }
                st_bf8(rowp + col0, r2[0], r2[1]);
            }
    }
};
struct EpiSplitQKV {
    static constexpr bool PERM = true, AFTER_DRAIN = false, RESCALE = false;
    bf16_t* QM; bf16_t* KV; const float* RSQ; const float* RSKV;
    __device__ __forceinline__ void operator()(const f32x4 (&acc)[2][2][4][2], const Unit& u, int wr, int wc, int fr, int fq) const {
        { int t2_ = (wr * 4 + wc) * 64 + ::lane_now(); asm volatile("" : "+v"(t2_)); fr = t2_ & 15; fq = (t2_ >> 4) & 3; }
        const bool isq = u.pn < 2;
        bf16_t* O = isq ? QM : KV; const int ldc = isq ? 512 : 768;
        const int row0 = u.pm * BM + wr * 64 + fr, col0 = (isq ? u.pn : u.pn - 2) * BM + wc * 32 + 8 * fq;
#pragma unroll
        for (int ai = 0; ai < 2; ++ai)
#pragma unroll
            for (int m = 0; m < 4; ++m) {
                const int row = row0 + ai * HALF + m * 16;
                const f32x4 ps = *(const f32x4*)((isq ? RSQ : RSKV) + (size_t)row * 4);
                const float sc = __builtin_amdgcn_rsqf(((ps[0] + ps[1]) + (ps[2] + ps[3])) * (isq ? 1.0f / 256.0f : 1.0f / 128.0f) + 1e-6f);
                bf16_t* rowp = O + (size_t)row * ldc;
#pragma unroll
                for (int bj = 0; bj < 2; ++bj) st_bf8(rowp + col0 + bj * HALF, acc[ai][bj][m][0] * sc, acc[ai][bj][m][1] * sc);
            }
    }
};
struct EpiResidualY {
    static constexpr bool PERM = true, AFTER_DRAIN = false, RESCALE = true;
    const bf16_t* XI; bf16_t* XB; float* RS; const float* SSQ;
    __device__ __forceinline__ static void group_rstd(const float* SSQ, int row, float& ra, float& rb, float& rc) {
        const f32x4* p = (const f32x4*)(SSQ + (size_t)row * 12);
        const f32x4 a = p[0], b = p[1], c = p[2];
        ra = __builtin_amdgcn_rsqf(((a[0] + a[1]) + (a[2] + a[3])) * (1.0f / 512.0f) + 1e-6f);
        rb = __builtin_amdgcn_rsqf(((b[0] + b[1]) + (b[2] + b[3])) * (1.0f / 256.0f) + 1e-6f);
        rc = __builtin_amdgcn_rsqf(((c[0] + c[1]) + (c[2] + c[3])) * (1.0f / 256.0f) + 1e-6f);
    }
    __device__ __forceinline__ void rescale(f32x4 (&acc)[2][2][4][2], const Unit& u, int t, int wr, int wc) const {
        int fr, fq; { int t2_ = (wr * 4 + wc) * 64 + ::lane_now(); asm volatile("" : "+v"(t2_)); fr = t2_ & 15; fq = (t2_ >> 4) & 3; } (void)fq;
        const int row0 = u.pm * BM + wr * 64 + fr;
#pragma unroll
        for (int ai = 0; ai < 2; ++ai)
#pragma unroll
            for (int m = 0; m < 4; ++m) {
                float ra, rb, rc; group_rstd(SSQ, row0 + ai * HALF + m * 16, ra, rb, rc);
                const float f = (t == 8) ? ra * __builtin_amdgcn_rcpf(rb) : rb * __builtin_amdgcn_rcpf(rc);
#pragma unroll
                for (int bj = 0; bj < 2; ++bj)
#pragma unroll
                    for (int n = 0; n < 2; ++n) acc[ai][bj][m][n] = acc[ai][bj][m][n] * f;
            }
    }
    __device__ __forceinline__ void operator()(const f32x4 (&acc)[2][2][4][2], const Unit& u, int wr, int wc, int fr, int fq) const {
        { int t2_ = (wr * 4 + wc) * 64 + ::lane_now(); asm volatile("" : "+v"(t2_)); fr = t2_ & 15; fq = (t2_ >> 4) & 3; }
        const int row0 = u.pm * BM + wr * 64 + fr, col0 = u.pn * BM + wc * 32 + 8 * fq;
#pragma unroll
        for (int ai = 0; ai < 2; ++ai)
#pragma unroll
            for (int m = 0; m < 4; ++m) {
                const int row = row0 + ai * HALF + m * 16;
                const size_t ro = (size_t)row * ::DMODEL;
                float ra, rb, rc; group_rstd(SSQ, row, ra, rb, rc); (void)ra; (void)rb;
                float ss = 0.f;
#pragma unroll
                for (int bj = 0; bj < 2; ++bj) {
                    const int c = col0 + bj * HALF;
                    const u32x4 xo = *(const u32x4*)(XI + ro + c);
                    const f32x4 x0 = (f32x4){::bflo(xo.x), ::bfhi(xo.x), ::bflo(xo.y), ::bfhi(xo.y)} + acc[ai][bj][m][0] * rc;
                    const f32x4 x1 = (f32x4){::bflo(xo.z), ::bfhi(xo.z), ::bflo(xo.w), ::bfhi(xo.w)} + acc[ai][bj][m][1] * rc;
                    st_bf8(XB + ro + c, x0, x1);
                    ss += ((x0[0] * x0[0] + x0[1] * x0[1]) + (x0[2] * x0[2] + x0[3] * x0[3])) + ((x1[0] * x1[0] + x1[1] * x1[1]) + (x1[2] * x1[2] + x1[3] * x1[3]));
                }
                { const int ln_ = fq * 16 + fr; ss += ::lane_xor(ss, ln_, 16); ss += ::lane_xor(ss, ln_, 32); }
                if (fq == 0) RS[(size_t)row * 16 + u.pn * 4 + wc] = ss;
            }
    }
};
struct EpiWin {
    static constexpr bool PERM = true, AFTER_DRAIN = false, RESCALE = false;
    bf16_t* O; const float* RS; float* RSQ; float* RSKV; bf16_t* KPE; float* LF; const float* rope; const float* fb;
    __device__ __forceinline__ void operator()(const f32x4 (&acc)[2][2][4][2], const Unit& u, int wr, int wc, int fr, int fq) const {
        { int t2_ = (wr * 4 + wc) * 64 + ::lane_now(); asm volatile("" : "+v"(t2_)); fr = t2_ & 15; fq = (t2_ >> 4) & 3; }
        const int row0 = u.pm * BM + wr * 64 + fr, col0 = u.pn * BM + wc * 32 + 8 * fq, ln_ = fq * 16 + fr;
#pragma unroll
        for (int ai = 0; ai < 2; ++ai)
#pragma unroll
            for (int m = 0; m < 4; ++m) {
                const int row = row0 + ai * HALF + m * 16;
                const float sc = row_rstd(RS, row);
                bf16_t* rowp = O + (size_t)row * ::PROJ_W;
                f32x4 v[2][2];
#pragma unroll
                for (int bj = 0; bj < 2; ++bj)
#pragma unroll
                    for (int n = 0; n < 2; ++n) v[bj][n] = acc[ai][bj][m][n] * sc;
#pragma unroll
                for (int bj = 0; bj < 2; ++bj) st_bf8(rowp + col0 + bj * HALF, v[bj][0], v[bj][1]);
                if (u.pn < 2) {
                    float s0 = 0.f, s1 = 0.f;
#pragma unroll
                    for (int n = 0; n < 2; ++n)
#pragma unroll
                        for (int i = 0; i < 4; ++i) { s0 += v[0][n][i] * v[0][n][i]; s1 += v[1][n][i] * v[1][n][i]; }
                    float ss = (u.pn == 0) ? s0 + s1 : s0;
                    ss += ::lane_xor(ss, ln_, 16); ss += ::lane_xor(ss, ln_, 32);
                    if (fq == 0) { if (u.pn == 0) RSQ[(size_t)row * 4 + wc] = ss; else RSKV[(size_t)row * 4 + wc] = ss; }
                    if (u.pn == 1 && wc == 0) {
                        const int pos = row & (::SEQ - 1), jb = 8 * (fq & 1);
                        const f32x4* rp = (const f32x4*)(rope + ((size_t)pos * 16 + jb) * 2);
                        f32x4 o2[2];
#pragma unroll
                        for (int n = 0; n < 2; ++n) { const f32x4 csA = rp[2 * n], csB = rp[2 * n + 1];
                            const float co[4] = {csA[0], csA[2], csB[0], csB[2]}, si[4] = {csA[1], csA[3], csB[1], csB[3]};
#pragma unroll
                            for (int i = 0; i < 4; ++i) { const float mine = v[1][n][i], oth = ::lane_xor(mine, ln_, 32);
                                o2[n][i] = (fq < 2) ? mine * co[i] - oth * si[i] : oth * si[i] + mine * co[i]; } }
                        st_bf8(KPE + (size_t)row * 32 + 8 * fq, o2[0], o2[1]);
                    }
                    if (u.pn == 1 && wc == 1 && fq == 0) {
                        f32x4 lf;
#pragma unroll
                        for (int i = 0; i < 4; ++i) { const float z = v[1][0][i] + fb[i]; lf[i] = 1.4426950408889634f * (fminf(z, 0.f) - log1pf(expf(-fabsf(z)))); }
                        *(f32x4*)(LF + (size_t)row * 4) = lf;
                    }
                }
            }
    }
};
template <class Epi, class Sched, bool ALIGN_EPI = false, bool SP2 = false>
__device__ __forceinline__ void gemm_phase(PG8_LAS unsigned char* lds, const Gemm g, const Sched& S, const Epi& E, int wv) {
    int tid_l = ::tid_from(wv); asm volatile("" : "+v"(tid_l));
    const int tid = tid_l, wid = wv, lane = tid & 63, wr = wid >> 2, wc = wid & 3, fr = lane & 15, fq = lane >> 4;
    const int K = g.K, nt = K / BK, lda = g.lda ? g.lda : K;
    unsigned voffA[2], voffB[2];
#pragma unroll
    for (int i = 0; i < 2; ++i) { int R, C; stage_rc(tid * 16 + i * 8192, R, C); const int Rb = Epi::PERM ? ((R & ~31) + perm32(R & 31)) : R;
        voffA[i] = (unsigned)(R * lda + C) * 2u; voffB[i] = (unsigned)(Rb * K + C) * 2u; }
    const size_t kstep = (size_t)(BK * 2);
    const size_t hstep = (size_t)HALF * K * 2;
    const size_t tstep = 2 * hstep;
    const size_t hstepA = (size_t)HALF * lda * 2, tstepA = 2 * hstepA;
    const unsigned ldsw = (unsigned)wid * 1024u;
    const int aoff = lds_byte(wr * 64 + fr, fq * 8), boff = lds_byte(wc * 32 + fr, fq * 8);
#define PG8_SA(b, h) (((b) * 2 + (h)) * HTB)
#define PG8_SB(b, h) ((4 + (b) * 2 + (h)) * HTB)
#define PG8_STAGE(bufoff, gbase, voff) do { _Pragma("unroll") for (int _i = 0; _i < 2; ++_i) \
        __builtin_amdgcn_global_load_lds((const unsigned*)((const char*)(gbase) + (voff)[_i]), (PG8_LAS unsigned*)(lds + (bufoff) + ldsw + _i * 8192), 16, 0, 0); } while (0)
#define PG8_LDA(dst, b, h) do { _Pragma("unroll") for (int m = 0; m < 4; ++m) _Pragma("unroll") for (int k = 0; k < 2; ++k) dst[m][k] = *(const PG8_LAS bf16x8*)(lds + PG8_SA(b, h) + aoff + m * 2048 + k * 1024); } while (0)
#define PG8_LDB(dst, b, h) do { _Pragma("unroll") for (int n = 0; n < 2; ++n) _Pragma("unroll") for (int k = 0; k < 2; ++k) dst[n][k] = *(const PG8_LAS bf16x8*)(lds + PG8_SB(b, h) + boff + n * 2048 + k * 1024); } while (0)
#define PG8_MMA(ai, bj, At, Bt) do { __builtin_amdgcn_s_setprio(1); _Pragma("unroll") for (int m = 0; m < 4; ++m) _Pragma("unroll") for (int n = 0; n < 2; ++n) _Pragma("unroll") for (int k = 0; k < 2; ++k) \
        acc[ai][bj][m][n] = __builtin_amdgcn_mfma_f32_16x16x32_bf16(Bt[n][k], At[m][k], acc[ai][bj][m][n], 0, 0, 0); __builtin_amdgcn_s_setprio(0); } while (0)
#define PG8_WAIT_V(n) asm volatile("s_waitcnt vmcnt(" #n ")" ::: "memory")
#define PG8_WAIT_L(n) asm volatile("s_waitcnt lgkmcnt(" #n ")" ::: "memory")
#define PG8_BAR __builtin_amdgcn_s_barrier()
#define PG8_SCHED __builtin_amdgcn_sched_barrier(0)
    Unit cur, nxt; int ui = 0;
    if (!S.next(0, cur)) return;
    f32x4 acc[2][2][4][2];
#pragma unroll
    for (int a = 0; a < 2; ++a)
#pragma unroll
        for (int b = 0; b < 2; ++b)
#pragma unroll
            for (int m = 0; m < 4; ++m)
#pragma unroll
                for (int n = 0; n < 2; ++n) acc[a][b][m][n] = (f32x4){0.f, 0.f, 0.f, 0.f};
    bf16x8 At[4][2], B0[2][2], B1[2][2];
    int ck0, cnt; S.krange(cur, nt, ck0, cnt);
    const char* cA = (const char*)g.A + (size_t)cur.pm * tstepA + (size_t)ck0 * kstep; const char* cB = (const char*)g.Bt + (size_t)cur.pn * tstep + (size_t)ck0 * kstep;
    S.a_ready(cur);
    if constexpr (SP2) {
        PG8_STAGE(PG8_SB(0, 0), cB, voffB); PG8_STAGE(PG8_SB(0, 1), cB + hstep, voffB); PG8_STAGE(PG8_SA(0, 0), cA, voffA); PG8_STAGE(PG8_SA(0, 1), cA + hstepA, voffA);
        if (wr == 1) PG8_BAR;
        PG8_WAIT_V(2); PG8_BAR;
        PG8_STAGE(PG8_SB(1, 0), cB + kstep, voffB); PG8_STAGE(PG8_SA(1, 0), cA + kstep, voffA); PG8_STAGE(PG8_SB(1, 1), cB + hstep + kstep, voffB);
        PG8_WAIT_V(6); PG8_BAR;
    } else {
        PG8_STAGE(PG8_SB(0, 0), cB, voffB); PG8_STAGE(PG8_SA(0, 0), cA, voffA); PG8_STAGE(PG8_SB(0, 1), cB + hstep, voffB); PG8_STAGE(PG8_SA(0, 1), cA + hstepA, voffA);
        if (wr == 1) PG8_BAR;
        PG8_WAIT_V(4); PG8_BAR;
        PG8_STAGE(PG8_SB(1, 0), cB + kstep, voffB); PG8_STAGE(PG8_SA(1, 0), cA + kstep, voffA); PG8_STAGE(PG8_SB(1, 1), cB + hstep + kstep, voffB);
        PG8_WAIT_V(6); PG8_BAR;
    }
    for (;;) {
        const bool has_next = S.next(ui + 1, nxt);
        int nk0 = 0, nnt = cnt; if (has_next) S.krange(nxt, nt, nk0, nnt);
        const char* nA = has_next ? (const char*)g.A + (size_t)nxt.pm * tstepA + (size_t)nk0 * kstep : cA; const char* nB = has_next ? (const char*)g.Bt + (size_t)nxt.pn * tstep + (size_t)nk0 * kstep : cB;
        for (int t = 0; t < cnt; t += 2) {
            if constexpr (Epi::RESCALE) { if (t == 8 || t == 12) E.rescale(acc, cur, t, wr, wc); }
            const bool last = (t == cnt - 2);
            const char* a1 = cA + (size_t)(t + 1) * kstep;
            const char* a2 = last ? nA : cA + (size_t)(t + 2) * kstep; const char* b2 = last ? nB : cB + (size_t)(t + 2) * kstep;
            const char* a3 = a2 + kstep; const char* b3 = b2 + kstep;
            if (last && has_next) S.a_ready(nxt);
            if constexpr (SP2) {
            PG8_LDB(B0, 0, 0); PG8_LDB(B1, 0, 1); PG8_SCHED; PG8_LDA(At, 0, 0); PG8_STAGE(PG8_SA(1, 1), a1 + hstepA, voffA);
            PG8_WAIT_V(8); PG8_WAIT_L(0); PG8_BAR; PG8_MMA(0, 0, At, B0); PG8_MMA(0, 1, At, B1); PG8_BAR; PG8_SCHED;
            PG8_LDA(At, 0, 1); PG8_STAGE(PG8_SB(0, 0), b2, voffB); PG8_STAGE(PG8_SB(0, 1), b2 + hstep, voffB); PG8_STAGE(PG8_SA(0, 0), a2, voffA);
            PG8_WAIT_V(8); PG8_WAIT_L(0); PG8_BAR; PG8_MMA(1, 0, At, B0); PG8_MMA(1, 1, At, B1); PG8_BAR; PG8_SCHED;
            PG8_LDB(B0, 1, 0); PG8_LDB(B1, 1, 1); PG8_SCHED; PG8_LDA(At, 1, 0); PG8_STAGE(PG8_SA(0, 1), a2 + hstepA, voffA);
            PG8_WAIT_V(8); PG8_WAIT_L(0); PG8_BAR; PG8_MMA(0, 0, At, B0); PG8_MMA(0, 1, At, B1); PG8_BAR; PG8_SCHED;
            PG8_LDA(At, 1, 1); PG8_STAGE(PG8_SB(1, 0), b3, voffB); PG8_STAGE(PG8_SB(1, 1), b3 + hstep, voffB); PG8_STAGE(PG8_SA(1, 0), a3, voffA);
            PG8_WAIT_V(8); PG8_WAIT_L(0); PG8_BAR; PG8_MMA(1, 0, At, B0); PG8_MMA(1, 1, At, B1); PG8_BAR; PG8_SCHED;
            } else {
            PG8_LDB(B0, 0, 0); PG8_SCHED; PG8_LDA(At, 0, 0); PG8_STAGE(PG8_SA(1, 1), a1 + hstepA, voffA);
            PG8_WAIT_L(8); PG8_BAR; PG8_WAIT_L(0); PG8_MMA(0, 0, At, B0); PG8_BAR; PG8_SCHED;
            PG8_LDB(B1, 0, 1); PG8_STAGE(PG8_SB(0, 0), b2, voffB);
            PG8_BAR; PG8_WAIT_L(0); PG8_MMA(0, 1, At, B1); PG8_BAR;
            PG8_LDA(At, 0, 1); PG8_STAGE(PG8_SA(0, 0), a2, voffA);
            PG8_BAR; PG8_WAIT_L(0); PG8_MMA(1, 0, At, B0); PG8_BAR; PG8_SCHED;
            PG8_STAGE(PG8_SB(0, 1), b2 + hstep, voffB);
            PG8_WAIT_V(6); PG8_BAR; PG8_MMA(1, 1, At, B1); PG8_BAR;
            PG8_LDB(B0, 1, 0); PG8_SCHED; PG8_LDA(At, 1, 0); PG8_STAGE(PG8_SA(0, 1), a2 + hstepA, voffA);
            PG8_WAIT_L(8); PG8_BAR; PG8_WAIT_L(0); PG8_MMA(0, 0, At, B0); PG8_BAR; PG8_SCHED;
            PG8_LDB(B1, 1, 1); PG8_STAGE(PG8_SB(1, 0), b3, voffB);
            PG8_BAR; PG8_WAIT_L(0); PG8_MMA(0, 1, At, B1); PG8_BAR;
            PG8_LDA(At, 1, 1); PG8_STAGE(PG8_SA(1, 0), a3, voffA);
            PG8_BAR; PG8_WAIT_L(0); PG8_MMA(1, 0, At, B0); PG8_BAR; PG8_SCHED;
            PG8_STAGE(PG8_SB(1, 1), b3 + hstep, voffB);
            PG8_WAIT_V(6); PG8_BAR; PG8_MMA(1, 1, At, B1); PG8_BAR;
            }
        }
        if constexpr (ALIGN_EPI) { if (wr == 0) PG8_BAR; }
        if constexpr (!Epi::AFTER_DRAIN) { E(acc, cur, wr, wc, fr, fq); S.done(cur); }
        if (!has_next) break;
#pragma unroll
        for (int a = 0; a < 2; ++a)
#pragma unroll
            for (int b = 0; b < 2; ++b)
#pragma unroll
                for (int m = 0; m < 4; ++m)
#pragma unroll
                    for (int n = 0; n < 2; ++n) acc[a][b][m][n] = (f32x4){0.f, 0.f, 0.f, 0.f};
        cur = nxt; cA = nA; cB = nB; cnt = nnt; ++ui;
        if constexpr (ALIGN_EPI) { if (wr == 1) PG8_BAR; }
    }
    PG8_WAIT_V(0);
    if constexpr (!ALIGN_EPI) { if (wr == 0) PG8_BAR; }
    PG8_BAR;
    if constexpr (Epi::AFTER_DRAIN) { E.fused(acc, cur, wr, wc, fr, fq, lds, wid, lane); S.done(cur); }
#undef PG8_SA
#undef PG8_SB
#undef PG8_STAGE
#undef PG8_LDA
#undef PG8_LDB
#undef PG8_MMA
#undef PG8_WAIT_V
#undef PG8_WAIT_L
#undef PG8_BAR
#undef PG8_SCHED
}
}
constexpr size_t MiB = 1u << 20;
constexpr size_t WS_W = 0, W_LAYER = 28 * MiB;
constexpr size_t WO_IN = 0, WO_UQ = 4 * MiB, WO_UKV = 4 * MiB + 512 * 1024, WO_O = 5 * MiB, WO_CQ = 7 * MiB, WO_CKV = 8 * MiB, WO_CO = 10 * MiB, WO_GU = 11 * MiB, WO_DOWN = 22 * MiB;
constexpr size_t WS_XB = 56 * MiB;
constexpr size_t WS_RS = 120 * MiB;
constexpr size_t WS_KPE = 122 * MiB;
constexpr size_t WS_LC = 124 * MiB;
constexpr size_t WS_CUM = 124 * MiB + 512 * 1024;
constexpr size_t WS_TOT = 125 * MiB;
constexpr size_t WS_ROPE = 125 * MiB + 512 * 1024;
constexpr size_t WS_MEMN = 127 * MiB;
constexpr size_t WS_KVMEM = 129 * MiB;
constexpr size_t WS_PROJ = 134 * MiB;
constexpr size_t WS_CQN = 262 * MiB;
constexpr size_t WS_CKVN = 278 * MiB;
constexpr size_t WS_QM = 294 * MiB;
constexpr size_t WS_HID = 134 * MiB;
constexpr size_t WS_KV = 326 * MiB;
constexpr size_t WS_Y = 374 * MiB;
constexpr size_t WS_SSQ = 438 * MiB;
constexpr size_t WS_RSQ = 440 * MiB;
constexpr size_t WS_RSKV = 440 * MiB + 512 * 1024;
constexpr size_t WS_BAR = 441 * MiB;
constexpr size_t WS_XB2 = 442 * MiB;
constexpr size_t WS_END = 506 * MiB;

constexpr int LDS_BYTES = 131072 + 4096;

struct Args { const float* in[21]; float* out; unsigned char* ws; int ph_lo, ph_hi; };
typedef const __attribute__((address_space(4))) Args* KArgs;

__device__ __forceinline__ int conv_map(int type, int n, float& sc) {
    sc = 1.0f;
    switch (type) {
    case 0:
        if (n < 416) return n;
        if (n < 420) return 1184 + (n - 416);
        if (n < 512) return -1;
        if (n < 1280) { if (n < 768) sc = SC_64; return 416 + (n - 512); }
        if (n < 1536) sc = SC_64;
        return 1188 + (n - 1280);
    case 1: sc = SC_MLA; return n < 384 ? n : -1;
    case 2: if (n < 256) return (n >> 6) * 192 + (n & 63); else { const int mm = n - 256; return (mm >> 7) * 192 + 64 + (mm & 127); }
    case 4: sc = SC_CROSS; return n;
    case 7: { const int t = n >> 8, c = n & 255; return c < 128 ? 128 * t + c : FFN_H + 128 * t + (c - 128); }
    default: return n;
    }
}
__device__ __forceinline__ void conv_tile(const float* src, const float* gain, bf16_t* dst, int K, int Nsrc, int Nd, int Kd, int type, int tile, LAS float* scr, int wv, int koff = 0) {
    int tid_l = tid_from(wv); asm volatile("" : "+v"(tid_l));
    const int tid = tid_l, ntn = Nd >> 8, kb = tile / ntn, nb = tile - kb * ntn, k0 = kb * 64, n0 = nb * 256;
    { const int nn = tid & 255, kh = tid >> 8; float sc; const int sn = conv_map(type, n0 + nn, sc);
      const float* sp = src + (size_t)(k0 + kh - koff) * Nsrc + (sn >= 0 ? sn : 0);
#pragma unroll 8
      for (int i = 0; i < 32; ++i) { const int kk = kh + 2 * i, k = k0 + kk; float v = 0.f;
          if (sn >= 0 && k >= koff && k - koff < K) { v = __builtin_nontemporal_load(sp + (size_t)(2 * i) * Nsrc) * sc; if (gain) v *= gain[k - koff]; }
          scr[nn * 65 + kk] = v; } }
    __syncthreads();
#pragma unroll
    for (int j = 0; j < 4; ++j) { const int idx = tid + 512 * j, nn = idx >> 3, kq = (idx & 7) * 8; const LAS float* s = scr + nn * 65 + kq;
      u32x4 o; o.x = pk2(s[0], s[1]); o.y = pk2(s[2], s[3]); o.z = pk2(s[4], s[5]); o.w = pk2(s[6], s[7]);
      *(u32x4*)(dst + (size_t)(n0 + nn) * Kd + k0 + kq) = o; }
    __syncthreads();
}
__device__ __forceinline__ void phase_prologue(KArgs a, LAS unsigned char* lds, int wv, int part) {
    LAS float* scr = (LAS float*)lds;
    unsigned char* ws = a->ws;
    int tid_l = tid_from(wv); asm volatile("" : "+v"(tid_l));
    const int tid = tid_l, lane = tid & 63, wave = tid >> 6;
    constexpr int NT_L = 128 + 12 + 18 + 64 + 32 + 64 + 32 + 352 + 176;
    const int g_lo = part == 0 ? 0 : 128, g_hi = part == 0 ? 128 : NLAYER * NT_L;
    for (int g = g_lo + blockIdx.x; g < g_hi; g += gridDim.x) {
        const int l = g / NT_L; int r = g - l * NT_L;
        bf16_t* wb = (bf16_t*)(ws + WS_W + (size_t)l * W_LAYER);
        if (r < 128) { conv_tile(a->in[3] + (size_t)l * 1024 * IN_W, a->in[2] + l * 1024, (bf16_t*)((unsigned char*)wb + WO_IN), 1024, IN_W, 2048, 1024, 0, r, scr, wv); continue; } r -= 128;
        if (r < 12) { conv_tile(a->in[5] + (size_t)l * 256 * 384, a->in[4] + l * 256, (bf16_t*)((unsigned char*)wb + WO_UQ), 256, 384, 512, 384, 1, r, scr, wv); continue; } r -= 12;
        if (r < 18) { conv_tile(a->in[7] + (size_t)l * 128 * 768, a->in[6] + l * 128, (bf16_t*)((unsigned char*)wb + WO_UQ) + (size_t)512 * 384, 128, 768, 768, 384, 2, r, scr, wv, 256); continue; } r -= 18;
        if (r < 64) { conv_tile(a->in[11] + (size_t)l * 1024 * 1024, a->in[10] + l * 1024, (bf16_t*)((unsigned char*)wb + WO_O), 1024, 1024, 1024, 1024, 3, r, scr, wv); continue; } r -= 64;
        if (r < 32) { conv_tile(a->in[14] + (size_t)l * 1024 * 512, a->in[12] + l * 1024, (bf16_t*)((unsigned char*)wb + WO_CQ), 1024, 512, 512, 1024, 4, r, scr, wv); continue; } r -= 32;
        if (r < 64) { conv_tile(a->in[15] + (size_t)l * 1024 * 1024, a->in[13] + l * 1024, (bf16_t*)((unsigned char*)wb + WO_CKV), 1024, 1024, 1024, 1024, 5, r, scr, wv); continue; } r -= 64;
        if (r < 32) { conv_tile(a->in[16] + (size_t)l * 512 * 1024, nullptr, (bf16_t*)((unsigned char*)wb + WO_CO), 512, 1024, 1024, 512, 6, r, scr, wv); continue; } r -= 32;
        if (r < 352) { conv_tile(a->in[18] + (size_t)l * 1024 * 2 * FFN_H, a->in[17] + l * 1024, (bf16_t*)((unsigned char*)wb + WO_GU), 1024, 2 * FFN_H, 2 * FFN_H, 1024, 7, r, scr, wv); continue; } r -= 352;
        conv_tile(a->in[19] + (size_t)l * FFN_H * 1024, nullptr, (bf16_t*)((unsigned char*)wb + WO_DOWN), FFN_H, 1024, 1024, FFN_H, 8, r, scr, wv);
    }
    if (part != 0) return;
    const int gw = blockIdx.x * NWAVES + wave, ngw = gridDim.x * NWAVES;
    bf16_t* XB = (bf16_t*)(ws + WS_XB); float* RS = (float*)(ws + WS_RS); bf16_t* MEMN = (bf16_t*)(ws + WS_MEMN);
    for (int row = gw; row < T_TOK + NBATCH * MEMLEN; row += ngw) {
        const bool ismem = row >= T_TOK; const int rr = ismem ? row - T_TOK : row;
        const f32x4* xr = (const f32x4*)((ismem ? a->in[1] : a->in[0]) + (size_t)rr * DMODEL) + lane;
        f32x4 v[4]; float s = 0.f;
#pragma unroll
        for (int j = 0; j < 4; ++j) { v[j] = __builtin_nontemporal_load(xr + 64 * j); s += (v[j][0] * v[j][0] + v[j][1] * v[j][1]) + (v[j][2] * v[j][2] + v[j][3] * v[j][3]); }
        s = wave_sum(s, lane);
        float sc = 1.0f;
        if (ismem) sc = __builtin_amdgcn_rsqf(s * (1.0f / 1024.0f) + EPS);
        else if (lane < 16) RS[(size_t)rr * 16 + lane] = lane == 0 ? s : 0.f;
        u32x2* o8 = (u32x2*)((ismem ? MEMN : XB) + (size_t)rr * DMODEL) + lane;
#pragma unroll
        for (int j = 0; j < 4; ++j) { u32x2 w; w.x = pk2(v[j][0] * sc, v[j][1] * sc); w.y = pk2(v[j][2] * sc, v[j][3] * sc); o8[64 * j] = w; }
    }
    float* rope = (float*)(ws + WS_ROPE);
    for (int i = blockIdx.x * NTHREADS + tid; i < SEQ * 16; i += gridDim.x * NTHREADS) {
        const int pos = i >> 4, j = i & 15;
        const float inv = powf(10000.0f, -(float)(2 * j) / 32.0f), ang = (float)pos * inv;
        rope[2 * i] = cosf(ang); rope[2 * i + 1] = sinf(ang);
    }
}

__device__ __forceinline__ void phase_cum(KArgs a, LAS unsigned char* lds, int wv) {
    unsigned char* ws = a->ws;
    const float* LF = (const float*)(ws + WS_LC); float* CUM = (float*)(ws + WS_CUM);
    LAS float* sc = (LAS float*)lds;
    LAS float* lc = (LAS float*)(lds + 2048);
    int tid_l = tid_from(wv); asm volatile("" : "+v"(tid_l));
    const int tid = tid_l, lane = tid & 63, wave = tid >> 6;
    const int gsz = (int)gridDim.x, half = gsz >= 256 ? gsz / 2 : 0;
    if ((int)blockIdx.x < half) return;
    for (int c = (int)blockIdx.x - half; c < T_TOK / 64; c += gsz - half) {
        const int b = c >> 7, ci = c & 127, n0 = ci * 64;
        { const f32x4* base = (const f32x4*)(LF + (size_t)b * SEQ * 4);
          f32x4 acc = (f32x4){0.f, 0.f, 0.f, 0.f};
          for (int t = tid; t < n0; t += NTHREADS) acc += base[t];
#pragma unroll
          for (int k = 0; k < 4; ++k) acc[k] = wave_sum(acc[k], lane);
          if (lane == 0) *(LAS f32x4*)(sc + wave * 4) = acc;
          if (tid < 256) lc[tid] = LF[((size_t)c * 64) * 4 + tid]; }
        __syncthreads();
        if (tid < 256) {
            const int h = tid & 3, i = tid >> 2; float p = 0.f;
#pragma unroll
            for (int w = 0; w < NWAVES; ++w) p += sc[w * 4 + h];
            for (int j = 0; j <= i; ++j) p += lc[j * 4 + h];
            CUM[(size_t)(c * 64 + i) * 4 + h] = p;
        }
        __syncthreads();
    }
}

__device__ __forceinline__ f32x16 mfma32(bf16x8 a, bf16x8 b, f32x16 c) { return __builtin_amdgcn_mfma_f32_32x32x16_bf16(a, b, c, 0, 0, 0); }
typedef short v4i16_t __attribute__((ext_vector_type(4)));
__device__ __forceinline__ float max3f(float a, float b, float c) { float r; asm("v_max3_f32 %0, %1, %2, %3" : "=v"(r) : "v"(a), "v"(b), "v"(c)); return r; }
__device__ __forceinline__ s16x4 vtr(const LAS unsigned char* p) { return __builtin_bit_cast(s16x4, __builtin_amdgcn_ds_read_tr16_b64_v4i16((LAS v4i16_t*)p)); }

struct AttnT {
    const bf16_t* Q; int qpitch, qcol;
    const bf16_t* K; int kpitch, kcol;
    const bf16_t* K2;
    const bf16_t* V; int vpitch, vcol;
    bf16_t* O; int opitch, ocol;
    const float* cum;
    const float* relb;
    const float* rope;
    float* ssq; int slot0;
};
template <int DQK, int DV, int MODE>
__device__ __forceinline__ void attn_unit(LAS unsigned char* lds, const AttnT& A, int b, int h, int qb, int wv) {
    constexpr int KB = DQK * 128, VB = DV * 128, KVB = KB + VB;
    constexpr int KPT = (8 * DQK + 511) / 512, VPT = (8 * DV + 511) / 512, ND = DQK / 16, NV = DV / 32;
    int tid_l = tid_from(wv); asm volatile("" : "+v"(tid_l));
    const int tid = tid_l, lane = tid & 63, r32 = lane & 31, hi = lane >> 5;
    const int wid = wv;
    LAS float* xtra = (LAS float*)(lds + 2 * KVB);
    const int q0 = qb * 256;
    const size_t qrow = (size_t)b * SEQ + q0 + wid * 32 + r32;
    const size_t krow0 = (MODE == 3) ? (size_t)b * MEMLEN : (size_t)b * SEQ;
    int kt_lo = 0, kt_hi = 4 * qb + 4;
    if (MODE == 2) kt_lo = (4 * qb - 8) > 0 ? (4 * qb - 8) : 0;
    if (MODE == 3) kt_hi = 4;
    const int wchunk = 4 * qb + (wid >> 1);
    int w_lo = 0, w_hi = wchunk;
    if (MODE == 2) w_lo = (wchunk - 8) > 0 ? (wchunk - 8) : 0;
    if (MODE == 3) w_hi = 3;
    bf16x8 qr[ND];
    { const bf16_t* qp = A.Q + qrow * A.qpitch + A.qcol + h * DQK + hi * 8;
#pragma unroll
      for (int d0 = 0; d0 < ND; ++d0) qr[d0] = *(const bf16x8*)(qp + d0 * 16); }
    if (MODE == 0) {
        const f32x4* rp = (const f32x4*)(A.rope + ((size_t)(q0 + wid * 32 + r32) * 16 + 8 * hi) * 2);
        bf16x8 a1 = qr[ND - 2], a2 = qr[ND - 1];
#pragma unroll
        for (int jj = 0; jj < 4; ++jj) { const f32x4 cs = rp[jj];
            const float x1a = bf2f((bf16_t)a1[2 * jj]), x2a = bf2f((bf16_t)a2[2 * jj]), x1b = bf2f((bf16_t)a1[2 * jj + 1]), x2b = bf2f((bf16_t)a2[2 * jj + 1]);
            const unsigned w1 = pk2(x1a * cs[0] - x2a * cs[1], x1b * cs[2] - x2b * cs[3]), w2 = pk2(x1a * cs[1] + x2a * cs[0], x1b * cs[3] + x2b * cs[2]);
            a1[2 * jj] = (short)(w1 & 0xffffu); a1[2 * jj + 1] = (short)(w1 >> 16); a2[2 * jj] = (short)(w2 & 0xffffu); a2[2 * jj + 1] = (short)(w2 >> 16); }
        qr[ND - 2] = a1; qr[ND - 1] = a2;
    }
    if (MODE == 2) { if (tid < 192) xtra[tid] = A.relb[h * 192 + tid] * LOG2E; }
    f32x16 o[NV];
#pragma unroll
    for (int d = 0; d < NV; ++d)
#pragma unroll
        for (int r = 0; r < 16; ++r) o[d][r] = 0.f;
    float mrun = 0.f, lrun = 0.f; bool first = true;
    u32x4 kreg[KPT], vreg[VPT]; float ckreg = 0.f;
    constexpr bool DEEP = (MODE != 3);
    u32x4 kreg2[KPT], vreg2[VPT]; float ckreg2 = 0.f;
#define GLOAD(kt, KR, VR, CR) do { const size_t rb_ = krow0 + (size_t)(kt) * 64; \
    _Pragma("unroll") for (int i_ = 0; i_ < KPT; ++i_) { const int e_ = tid + 512 * i_; if (e_ < 8 * DQK) { const int key_ = e_ & 63, c8_ = e_ >> 6; \
        const bf16_t* p_; if (MODE == 0 && c8_ >= 8) p_ = A.K2 + (rb_ + key_) * 32 + (c8_ - 8) * 8; else p_ = A.K + (rb_ + key_) * A.kpitch + A.kcol + h * (MODE == 0 ? 64 : DQK) + c8_ * 8; \
        KR[i_] = *(const u32x4*)p_; } } \
    _Pragma("unroll") for (int i_ = 0; i_ < VPT; ++i_) { const int e_ = tid + 512 * i_; const int part_ = e_ & 3, key_ = (e_ >> 2) & 63, d0_ = e_ >> 8; \
        VR[i_] = *(const u32x4*)(A.V + (rb_ + key_) * A.vpitch + A.vcol + h * DV + d0_ * 32 + part_ * 8); } \
    if (MODE == 1) { if (tid < 64) CR = A.cum[(rb_ + tid) * 4 + h]; } } while (0)
#define LWRITE(buf) do { LAS unsigned char* kb_ = lds + (buf) * KVB; \
    _Pragma("unroll") for (int i_ = 0; i_ < KPT; ++i_) { const int e_ = tid + 512 * i_; if (e_ < 8 * DQK) *(LAS u32x4*)(kb_ + e_ * 16) = kreg[i_]; } \
    _Pragma("unroll") for (int i_ = 0; i_ < VPT; ++i_) { const int e_ = tid + 512 * i_; *(LAS u32x4*)(kb_ + KB + e_ * 16) = vreg[i_]; } \
    if (MODE == 1) { if (tid < 64) xtra[(buf) * 64 + tid] = ckreg; } } while (0)
    const int nsteps = kt_hi - kt_lo;
#define KT(i_) ((MODE == 1) ? (kt_hi - 1 - (i_)) : (kt_lo + (i_)))
    GLOAD(KT(0), kreg, vreg, ckreg); LWRITE(0);
    if (DEEP) { if (1 < nsteps) GLOAD(KT(1), kreg, vreg, ckreg); }
    __syncthreads();
    bool hot = (MODE != 1);
#pragma unroll 1
    for (int it = 0; it < nsteps; ++it) {
        const int kt = KT(it);
        const int cur = it & 1;
        const bool more = it + 1 < nsteps;
        if (DEEP) { if (it + 2 < nsteps) GLOAD(KT(it + 2), kreg2, vreg2, ckreg2); } else { if (more) GLOAD(KT(it + 1), kreg, vreg, ckreg); }
        if (kt >= w_lo && kt <= w_hi) {
            const LAS unsigned char* Kb = lds + cur * KVB; const LAS unsigned char* Vb = Kb + KB;
            constexpr int NDA = ND > 6 ? ND / 2 : ND;
            bf16x8 kf0[NDA], kf1[NDA];
#pragma unroll
            for (int d0 = 0; d0 < NDA; ++d0) {
                kf0[d0] = *(const LAS bf16x8*)(Kb + (2 * d0 + hi) * 1024 + r32 * 16);
                kf1[d0] = *(const LAS bf16x8*)(Kb + (2 * d0 + hi) * 1024 + 512 + r32 * 16);
            }
            f32x4 ck0[4], ck1[4];
            if (MODE == 1) { const LAS float* ck = xtra + cur * 64;
#pragma unroll
                for (int g = 0; g < 4; ++g) { ck0[g] = *(const LAS f32x4*)(ck + 8 * g + 4 * hi); ck1[g] = *(const LAS f32x4*)(ck + 32 + 8 * g + 4 * hi); } }
            __builtin_amdgcn_sched_barrier(0);
            f32x16 p0, p1;
            { const float nm = -mrun;
#pragma unroll
            for (int r = 0; r < 16; ++r) { p0[r] = nm; p1[r] = nm; } }
#pragma unroll
            for (int d0 = 0; d0 < NDA; ++d0) { p0 = mfma32(kf0[d0], qr[d0], p0); p1 = mfma32(kf1[d0], qr[d0], p1); }
            __builtin_amdgcn_sched_barrier(0);
            if (NDA < ND) {
#pragma unroll
                for (int d0 = 0; d0 < ND - NDA; ++d0) {
                    kf0[d0] = *(const LAS bf16x8*)(Kb + (2 * (d0 + NDA) + hi) * 1024 + r32 * 16);
                    kf1[d0] = *(const LAS bf16x8*)(Kb + (2 * (d0 + NDA) + hi) * 1024 + 512 + r32 * 16);
                }
                __builtin_amdgcn_sched_barrier(0);
#pragma unroll
                for (int d0 = 0; d0 < ND - NDA; ++d0) { p0 = mfma32(kf0[d0], qr[d0 + NDA], p0); p1 = mfma32(kf1[d0], qr[d0 + NDA], p1); }
                __builtin_amdgcn_sched_barrier(0);
            }
            asm volatile("s_nop 15\n\ts_nop 7" : "+v"(p0), "+v"(p1));
            const LAS unsigned char* vbase = Vb + (4 * hi + ((lane & 15) >> 2)) * 64 + ((lane >> 4) & 1) * 32 + (lane & 3) * 8;
            constexpr int KSA = NV > 2 ? 1 : 4;
            s16x4 vlo[4][NV], vh4[4][NV];
            if (hot) {
#pragma unroll
                for (int ks = 0; ks < KSA; ++ks)
#pragma unroll
                    for (int d = 0; d < NV; ++d) { vlo[ks][d] = vtr(vbase + d * 4096 + ks * 1024); vh4[ks][d] = vtr(vbase + d * 4096 + ks * 1024 + 512); }
            }
            __builtin_amdgcn_sched_barrier(0);
            if (MODE == 1) {
#pragma unroll
                for (int g = 0; g < 4; ++g)
#pragma unroll
                    for (int i = 0; i < 4; ++i) { p0[4 * g + i] -= ck0[g][i]; p1[4 * g + i] -= ck1[g][i]; }
                if (kt * 64 + 63 > q0 + wid * 32) {
                    const int qrel = q0 + wid * 32 + r32 - kt * 64;
#pragma unroll
                    for (int r = 0; r < 16; ++r) { const int kk = (r & 3) + 8 * (r >> 2) + 4 * hi; if (kk > qrel) p0[r] = -INFINITY; if (kk + 32 > qrel) p1[r] = -INFINITY; }
                }
            }
            if (MODE == 2) {
                if (wchunk - kt >= 3) { const float cb = xtra[191];
#pragma unroll
                    for (int r = 0; r < 16; ++r) { p0[r] += cb; p1[r] += cb; } }
                else { const int qrel = q0 + wid * 32 + r32 - kt * 64 + 63;
#pragma unroll
                    for (int r = 0; r < 16; ++r) { const int kk = (r & 3) + 8 * (r >> 2) + 4 * hi;
                        int i0 = qrel - kk, i1 = qrel - kk - 32; i0 = i0 < 0 ? 0 : (i0 > 191 ? 191 : i0); i1 = i1 < 0 ? 0 : (i1 > 191 ? 191 : i1);
                        p0[r] += xtra[i0]; p1[r] += xtra[i1]; } }
            }
            float mx = max3f(p0[0], p0[1], p1[0]), mx2 = max3f(p0[2], p0[3], p1[1]);
            mx = max3f(mx, p1[2], p1[3]);
#pragma unroll
            for (int r = 4; r < 16; r += 4) { mx = max3f(mx, p0[r], p0[r + 1]); mx2 = max3f(mx2, p0[r + 2], p0[r + 3]); mx = max3f(mx, p1[r], p1[r + 1]); mx2 = max3f(mx2, p1[r + 2], p1[r + 3]); }
            mx = max3f(mx, mx2, mx2);
            mx = max3f(mx, mx, lane_xor(mx, lane, 32));
            const bool dead = (MODE == 1) && !first && __all(mx < -160.0f);
            if (!dead) {
            if (MODE == 1 && !hot) {
#pragma unroll
                for (int ks = 0; ks < KSA; ++ks)
#pragma unroll
                    for (int d = 0; d < NV; ++d) { vlo[ks][d] = vtr(vbase + d * 4096 + ks * 1024); vh4[ks][d] = vtr(vbase + d * 4096 + ks * 1024 + 512); }
                hot = true;
            }
            if (first || __any(mx > 8.0f)) {
                const float dl = first ? mx : fmaxf(mx, 0.f);
                mrun += dl;
#pragma unroll
                for (int r = 0; r < 16; ++r) { p0[r] -= dl; p1[r] -= dl; }
                if (!first) { const float f = __builtin_amdgcn_exp2f(-dl); lrun *= f;
#pragma unroll
                    for (int d = 0; d < NV; ++d)
#pragma unroll
                        for (int r = 0; r < 16; ++r) o[d][r] *= f; }
                first = false;
            }
            float ls = 0.f;
#pragma unroll
            for (int r = 0; r < 16; ++r) { p0[r] = __builtin_amdgcn_exp2f(p0[r]); p1[r] = __builtin_amdgcn_exp2f(p1[r]); ls += p0[r] + p1[r]; }
            lrun += ls;
            u32x4 pw[4];
            pw[0] = (u32x4){pk2(p0[0], p0[1]), pk2(p0[2], p0[3]), pk2(p0[4], p0[5]), pk2(p0[6], p0[7])};
            pw[1] = (u32x4){pk2(p0[8], p0[9]), pk2(p0[10], p0[11]), pk2(p0[12], p0[13]), pk2(p0[14], p0[15])};
            pw[2] = (u32x4){pk2(p1[0], p1[1]), pk2(p1[2], p1[3]), pk2(p1[4], p1[5]), pk2(p1[6], p1[7])};
            pw[3] = (u32x4){pk2(p1[8], p1[9]), pk2(p1[10], p1[11]), pk2(p1[12], p1[13]), pk2(p1[14], p1[15])};
            __builtin_amdgcn_sched_barrier(0);
#pragma unroll
            for (int ks = 0; ks < 4; ++ks) {
                if (KSA < 4 && ks + 1 < 4) {
#pragma unroll
                    for (int d = 0; d < NV; ++d) { vlo[ks + 1][d] = vtr(vbase + d * 4096 + (ks + 1) * 1024); vh4[ks + 1][d] = vtr(vbase + d * 4096 + (ks + 1) * 1024 + 512); }
                    __builtin_amdgcn_sched_barrier(0);
                }
                const bf16x8 pf = __builtin_bit_cast(bf16x8, pw[ks]);
#pragma unroll
                for (int d = 0; d < NV; ++d) {
                    const s16x4 lo = vlo[ks][d], h4 = vh4[ks][d];
                    const bf16x8 vf = (bf16x8){lo[0], lo[1], lo[2], lo[3], h4[0], h4[1], h4[2], h4[3]};
                    o[d] = mfma32(vf, pf, o[d]);
                }
                if (KSA < 4) __builtin_amdgcn_sched_barrier(0);
            }
            } else { hot = false; }
        }
        if (more) LWRITE(cur ^ 1);
        __syncthreads();
        if (DEEP) {
#pragma unroll
            for (int i_ = 0; i_ < KPT; ++i_) kreg[i_] = kreg2[i_];
#pragma unroll
            for (int i_ = 0; i_ < VPT; ++i_) vreg[i_] = vreg2[i_];
            ckreg = ckreg2;
        }
    }
#undef GLOAD
#undef LWRITE
#undef KT
    lrun += lane_xor(lrun, lane, 32);
    const float rl = 1.0f / lrun;
    {
        constexpr int NCH16 = DV / 8, RB = DV * 2;
        LAS unsigned char* stg = lds + 65536 + wid * (32 * RB);
#pragma unroll
        for (int d = 0; d < NV; ++d)
#pragma unroll
            for (int g = 0; g < 4; ++g) { u32x2 w; w.x = pk2(o[d][4 * g] * rl, o[d][4 * g + 1] * rl); w.y = pk2(o[d][4 * g + 2] * rl, o[d][4 * g + 3] * rl);
                const int pi = 8 * d + 2 * g + hi, ch = pi >> 1, sub = pi & 1;
                *(LAS u32x2*)(stg + r32 * RB + ((ch ^ (r32 & (NCH16 - 1))) * 16) + sub * 8) = w; }
        bf16_t* ob = A.O + ((size_t)b * SEQ + q0 + wid * 32) * A.opitch + A.ocol + h * DV;
#pragma unroll
        for (int i = 0; i < (32 * NCH16) / 64; ++i) { const int row = i * (64 / NCH16) + lane / NCH16, ch = lane % NCH16;
            const u32x4 v = *(const LAS u32x4*)(stg + row * RB + ((ch ^ (row & (NCH16 - 1))) * 16));
            *(u32x4*)(ob + (size_t)row * A.opitch + ch * 8) = v; }
    }
    if (MODE != 3) {
        float sq = 0.f;
#pragma unroll
        for (int d = 0; d < NV; ++d)
#pragma unroll
            for (int r = 0; r < 16; ++r) { const float v = o[d][r] * rl; sq += v * v; }
        sq += lane_xor(sq, lane, 32);
        if (hi == 0) A.ssq[qrow * 12 + A.slot0 + h] = sq;
    }
}

__device__ __forceinline__ void phase_final(KArgs a, int wv) {
    const float* g = a->in[20];
    const bf16_t* XB = (const bf16_t*)(a->ws + (((3 * NLAYER) & 1) ? WS_XB2 : WS_XB));
    int tid_l = tid_from(wv); asm volatile("" : "+v"(tid_l));
    const int tid = tid_l, lane = tid & 63, wave = tid >> 6;
    for (int row = blockIdx.x * NWAVES + wave; row < T_TOK; row += gridDim.x * NWAVES) {
        const u32x2* xr = (const u32x2*)(XB + (size_t)row * DMODEL) + lane;
        f32x4 v[4]; float s = 0.f;
#pragma unroll
        for (int j = 0; j < 4; ++j) { const u32x2 w = xr[64 * j]; v[j] = (f32x4){bflo(w.x), bfhi(w.x), bflo(w.y), bfhi(w.y)}; s += (v[j][0] * v[j][0] + v[j][1] * v[j][1]) + (v[j][2] * v[j][2] + v[j][3] * v[j][3]); }
        const float rs = __builtin_amdgcn_rsqf(wave_sum(s, lane) * (1.0f / 1024.0f) + EPS);
        f32x4* orow = (f32x4*)(a->out + (size_t)row * DMODEL) + lane;
#pragma unroll
        for (int j = 0; j < 4; ++j) { const f32x4 gg = ((const f32x4*)g)[64 * j + lane]; orow[64 * j] = v[j] * rs * gg; }
    }
}

constexpr int PH_PER_LAYER = 9, N_PHASES = 1 + NLAYER * PH_PER_LAYER + 1;
__global__ void __launch_bounds__(NTHREADS, 2) fwd_kernel(Args args) {
    extern __shared__ __attribute__((aligned(16))) unsigned char lds_raw[];
    LAS unsigned char* lds = (LAS unsigned char*)lds_raw;
    const int lo = args.ph_lo, hi = args.ph_hi;
#define WSP(off) (wsl + (off))
#define LAUNDER_WS() KArgs ap = (KArgs)__builtin_amdgcn_kernarg_segment_ptr(); asm volatile("" : "+s"(ap)); unsigned char* wsl = ap->ws; \
    bf16_t* XB = (bf16_t*)WSP(WS_XB); bf16_t* XB2 = (bf16_t*)WSP(WS_XB2); (void)XB2; float* RS = (float*)WSP(WS_RS); bf16_t* PROJ = (bf16_t*)WSP(WS_PROJ); bf16_t* CQN = (bf16_t*)WSP(WS_CQN); bf16_t* CKVN = (bf16_t*)WSP(WS_CKVN); \
    bf16_t* QM = (bf16_t*)WSP(WS_QM); bf16_t* KV = (bf16_t*)WSP(WS_KV); bf16_t* Y = (bf16_t*)WSP(WS_Y); bf16_t* HID = (bf16_t*)WSP(WS_HID); \
    bf16_t* KPE = (bf16_t*)WSP(WS_KPE); bf16_t* MEMN = (bf16_t*)WSP(WS_MEMN); bf16_t* QC = QM; bf16_t* OC = KV; \
    const float* CUM = (const float*)WSP(WS_CUM); const float* rope = (const float*)WSP(WS_ROPE); float* SSQ = (float*)WSP(WS_SSQ); (void)SSQ; float* RSQ = (float*)WSP(WS_RSQ); float* RSKV = (float*)WSP(WS_RSKV); float* LF = (float*)WSP(WS_LC); (void)RSQ; (void)RSKV; (void)LF; \
    unsigned char* wl = wsl + WS_W + (size_t)l * W_LAYER; bf16_t* KVMEM = (bf16_t*)WSP(WS_KVMEM) + (size_t)l * 1024 * 1024; \
    (void)XB; (void)RS; (void)PROJ; (void)CQN; (void)CKVN; (void)QM; (void)KV; (void)Y; (void)HID; (void)KPE; (void)MEMN; (void)QC; (void)OC; (void)CUM; (void)rope; (void)wl; (void)KVMEM
    const int G = gridDim.x, bx = blockIdx.x;
    const int vcu = (G % 8 == 0) ? (bx % 8) * (G / 8) + bx / 8 : bx;
    volatile LAS unsigned* bst = (volatile LAS unsigned*)(lds + 131072 + 1024);
    const int wv = __builtin_amdgcn_readfirstlane((int)threadIdx.x >> 6);
    if (threadIdx.x < 4) bst[threadIdx.x] = 0u;
    __syncthreads();
    XcdBarrier gbar; gbar.bar = (unsigned*)(args.ws + WS_BAR); gbar.x = 0; gbar.st = bst; gbar.wv = wv;
    if (hi - lo > 1) gbar = xcd_barrier_post((unsigned*)(args.ws + WS_BAR), bst, wv);
    if (lo > 100000) cg::this_grid().sync();
    for (int p = lo; p < hi; ++p) {
        if (p == 0) { KArgs ap = (KArgs)__builtin_amdgcn_kernarg_segment_ptr(); asm volatile("" : "+s"(ap)); phase_prologue(ap, lds, wv, 0); }
        else if (p == N_PHASES - 1) { KArgs ap = (KArgs)__builtin_amdgcn_kernarg_segment_ptr(); asm volatile("" : "+s"(ap)); phase_final(ap, wv); }
        else {
        const int l = (p - 1) / PH_PER_LAYER, kph = (p - 1) - l * PH_PER_LAYER;
        LAUNDER_WS();
        switch (kph) {
        case 0: {
            pg8::Gemm g{((3 * l) & 1) ? XB2 : XB, (const bf16_t*)(wl + WO_IN), T_TOK, PROJ_W, 1024}; pg8::StaticOrder S; S.init(T_TOK, PROJ_W, G, bx);
            pg8::EpiWin E{PROJ, RS, RSQ, RSKV, KPE, LF, rope, ap->in[8] + l * 4};
            pg8::gemm_phase<pg8::EpiWin, pg8::StaticOrder, true, true>(lds, g, S, E, wv);
            if (l == 0) phase_prologue(ap, lds, wv, 1);
        }
        break;
        case 1: {
            { pg8::Gemm g{PROJ, (const bf16_t*)(wl + WO_UQ), T_TOK, 1280, 384, PROJ_W}; pg8::QkvOrder S; S.init(T_TOK, 1280, G, bx);
              pg8::EpiSplitQKV E{QM, KV, RSQ, RSKV};
              pg8::gemm_phase<pg8::EpiSplitQKV, pg8::QkvOrder, true, true>(lds, g, S, E, wv); }
            { pg8::Gemm g{MEMN, (const bf16_t*)(wl + WO_CKV), 1024, 1024, 1024}; pg8::StaticOrder S; S.init(1024, 1024, G, (bx + G - (128 % G)) % G);
              pg8::EpiScaleBf16<false> E{KVMEM, 1024, nullptr};
              pg8::gemm_phase<pg8::EpiScaleBf16<false>, pg8::StaticOrder, true, true>(lds, g, S, E, wv); }
            phase_cum(ap, lds, wv);
        }
        break;
        case 2: {
            { AttnT A{QM, 512, 0, KV, 768, 0, KPE, KV, 768, 256, Y, 1024, 0, nullptr, nullptr, rope, SSQ, 0};
              for (int u = vcu; u < 256; u += G) { const int bh = u >> 4, s = u & 15;
                  for (int hf = 0; hf < 2; ++hf) attn_unit<96, 128, 0>(lds, A, bh >> 2, bh & 3, hf ? s : 31 - s, wv); } }
            { AttnT A{PROJ, PROJ_W, 512, PROJ, PROJ_W, 768, nullptr, PROJ, PROJ_W, 1024, Y, 1024, 512, CUM, nullptr, nullptr, SSQ, 4};
              for (int u = vcu; u < 256; u += G) { const int bh = u >> 4, s = u & 15;
                  for (int hf = 0; hf < 2; ++hf) attn_unit<64, 64, 1>(lds, A, bh >> 2, bh & 3, hf ? s : 31 - s, wv); } }
            { AttnT A{PROJ, PROJ_W, 1280, PROJ, PROJ_W, 1536, nullptr, PROJ, PROJ_W, 1792, Y, 1024, 768, nullptr, ap->in[9] + l * 4 * 192, nullptr, SSQ, 8};
              for (int u = vcu; u < 512; u += G) { const int bh = (u >> 4) & 15, qb = (u & 15) + 16 * (u >> 8); attn_unit<64, 64, 2>(lds, A, bh >> 2, bh & 3, qb, wv); } }
        }
        break;
        case 3: {
            pg8::Gemm g{Y, (const bf16_t*)(wl + WO_O), T_TOK, 1024, 1024}; pg8::StaticOrder S; S.init(T_TOK, 1024, G, bx);
            pg8::EpiResidualY E{((3 * l) & 1) ? XB2 : XB, ((3 * l + 1) & 1) ? XB2 : XB, RS, SSQ};
            pg8::gemm_phase<pg8::EpiResidualY, pg8::StaticOrder, true, true>(lds, g, S, E, wv);
        }
        break;
        case 4: {
            pg8::Gemm g{((3 * l + 1) & 1) ? XB2 : XB, (const bf16_t*)(wl + WO_CQ), T_TOK, 512, 1024}; pg8::StaticOrder S; S.init(T_TOK, 512, G, bx);
            pg8::EpiScaleBf16<true> E{QC, 512, RS};
            pg8::gemm_phase<pg8::EpiScaleBf16<true>, pg8::StaticOrder, true, true>(lds, g, S, E, wv);
        }
        break;
        case 5: {
            AttnT A{QC, 512, 0, KVMEM, 1024, 0, nullptr, KVMEM, 1024, 512, OC, 512, 0, nullptr, nullptr, nullptr, nullptr, 0};
            for (int u = vcu; u < 512; u += G) { const int bh = (u >> 4) & 15, qb = (u & 15) + 16 * (u >> 8); attn_unit<128, 128, 3>(lds, A, bh >> 2, bh & 3, qb, wv); }
        }
        break;
        case 6: {
            pg8::Gemm g{OC, (const bf16_t*)(wl + WO_CO), T_TOK, 1024, 512}; pg8::StaticOrder S; S.init(T_TOK, 1024, G, bx);
            pg8::EpiResidual E{((3 * l + 1) & 1) ? XB2 : XB, ((3 * l + 2) & 1) ? XB2 : XB, RS, true};
            pg8::gemm_phase<pg8::EpiResidual, pg8::StaticOrder, true, true>(lds, g, S, E, wv);
        }
        break;
        case 7: {
            pg8::Gemm g{((3 * l + 2) & 1) ? XB2 : XB, (const bf16_t*)(wl + WO_GU), T_TOK, 2 * FFN_H, 1024}; pg8::StaticOrder S; S.init(T_TOK, 2 * FFN_H, G, bx);
            pg8::EpiSwiGLU E{HID, RS};
            pg8::gemm_phase<pg8::EpiSwiGLU, pg8::StaticOrder, true, true>(lds, g, S, E, wv);
        }
        break;
        case 8: {
            pg8::Gemm g{HID, (const bf16_t*)(wl + WO_DOWN), T_TOK, 1024, FFN_H}; pg8::StaticOrder S; S.init(T_TOK, 1024, G, bx);
            pg8::EpiResidual E{((3 * l + 2) & 1) ? XB2 : XB, ((3 * l + 3) & 1) ? XB2 : XB, RS, l + 1 < NLAYER};
            pg8::gemm_phase<pg8::EpiResidual, pg8::StaticOrder, true, true>(lds, g, S, E, wv);
        }
        break;

        default: break;
        }
        }
        if (p + 1 < hi) xcd_barrier(gbar);
    }
}

extern "C" void kernel_launch(void* const* d_in, const int* in_sizes, int n_in, void* d_out, int out_size, void* d_ws, size_t ws_size, hipStream_t stream) {
    static int grid = 0;
    if (grid == 0) {
        if (n_in != 21 || out_size != T_TOK * DMODEL || ws_size < WS_END) { fprintf(stderr, "kernel_launch: unexpected shapes (n_in %d, out %d, ws %zu)\n", n_in, out_size, ws_size); grid = -1; return; }
        int dev = 0, cus = 0, per_cu = 0;
        (void)hipGetDevice(&dev); (void)hipDeviceGetAttribute(&cus, hipDeviceAttributeMultiprocessorCount, dev);
        if (hipFuncSetAttribute((const void*)fwd_kernel, hipFuncAttributeMaxDynamicSharedMemorySize, LDS_BYTES) != hipSuccess) { fprintf(stderr, "kernel_launch: hipFuncSetAttribute failed\n"); grid = -1; return; }
        if (hipOccupancyMaxActiveBlocksPerMultiprocessor(&per_cu, (const void*)fwd_kernel, NTHREADS, LDS_BYTES) != hipSuccess || per_cu < 1) { fprintf(stderr, "kernel_launch: occupancy query gave %d\n", per_cu); per_cu = 1; }
        (void)hipGetLastError();
        grid = cus * 1;
        if (grid <= 0) grid = 256;
    }
    if (grid < 0) return;
    if (hipMemsetAsync((char*)d_ws + WS_BAR, 0, XCD_BAR_WORDS * 4, stream) != hipSuccess) { fprintf(stderr, "kernel_launch: memset failed\n"); return; }
    Args a{};
    for (int i = 0; i < 21; ++i) a.in[i] = (const float*)d_in[i];
    a.out = (float*)d_out; a.ws = (unsigned char*)d_ws;
#if MK_MULTI
    for (int p = 0; p < N_PHASES; ++p) { a.ph_lo = p; a.ph_hi = p + 1; hipLaunchKernelGGL(fwd_kernel, dim3(grid), dim3(NTHREADS), LDS_BYTES, stream, a); }
#else
    a.ph_lo = 0; a.ph_hi = N_PHASES;
    void* kargs[] = {&a};
    hipError_t e = hipLaunchCooperativeKernel((const void*)fwd_kernel, dim3(grid), dim3(NTHREADS), kargs, LDS_BYTES, stream);
    if (e != hipSuccess) fprintf(stderr, "kernel_launch: cooperative launch failed: %s (grid %d)\n", hipGetErrorString(e), grid);
#endif
}
```

```cpp
#include <hip/hip_runtime.h>
#include <hip/hip_cooperative_groups.h>
#include <cstdio>
#include <cstdint>
namespace cg = cooperative_groups;

#ifndef MK_MULTI
#define MK_MULTI 0
#endif

constexpr int NWAVES = 8, NTHREADS = 512;
constexpr int T_TOK = 32768, SEQ = 8192, NBATCH = 4, DMODEL = 1024, NLAYER = 2, MEMLEN = 256;
constexpr int IN_W = 1956, PROJ_W = 2048, FFN_H = 2816;
constexpr float EPS = 1e-6f, LOG2E = 1.4426950408889634f;
constexpr float SC_MLA = 0.10206207261596575f * 1.4426950408889634f;
constexpr float SC_64 = 0.125f * 1.4426950408889634f;
constexpr float SC_CROSS = 0.08838834764831845f * 1.4426950408889634f;

#define LAS __attribute__((address_space(3)))
typedef unsigned short bf16_t;
typedef float f32x4 __attribute__((ext_vector_type(4)));
typedef float f32x16 __attribute__((ext_vector_type(16)));
typedef short bf16x8 __attribute__((ext_vector_type(8)));
typedef short s16x4 __attribute__((ext_vector_type(4)));
typedef unsigned u32x4 __attribute__((ext_vector_type(4)));
typedef unsigned u32x2 __attribute__((ext_vector_type(2)));
typedef float f32x2_t __attribute__((ext_vector_type(2)));
typedef __bf16 bf16x2_t __attribute__((ext_vector_type(2)));

__device__ __forceinline__ unsigned pk2(float lo, float hi) { f32x2_t v = {lo, hi}; bf16x2_t b = __builtin_convertvector(v, bf16x2_t); return __builtin_bit_cast(unsigned, b); }
__device__ __forceinline__ float bflo(unsigned u) { return __uint_as_float(u << 16); }
__device__ __forceinline__ float bfhi(unsigned u) { return __uint_as_float(u & 0xffff0000u); }
__device__ __forceinline__ float bf2f(bf16_t h) { return __uint_as_float(((unsigned)h) << 16); }
__device__ __forceinline__ float lane_xor(float v, int lane, int m) { return __int_as_float(__builtin_amdgcn_ds_bpermute((lane ^ m) << 2, __float_as_int(v))); }
__device__ __forceinline__ float wave_sum(float v, int lane) {
#pragma unroll
    for (int o = 1; o < 64; o <<= 1) v += lane_xor(v, lane, o);
    return v;
}
__device__ __forceinline__ int lane_now() { int l; asm volatile("v_mbcnt_lo_u32_b32 %0, -1, 0\n\tv_mbcnt_hi_u32_b32 %0, -1, %0" : "=&v"(l)); return l; }
__device__ __forceinline__ int tid_from(int wv) { return wv * 64 + lane_now(); }

#define XB_TMO      128
#define XB_XCNT(j)  (256  + 64 * (j))
#define XB_XSUB(j)  (1280 + 64 * (j))
#define XB_XGEN(j)  (2304 + 64 * (j))
#define XB_TOP      3328
#define XB_TOPGEN   3392
#define XCD_BAR_WORDS 3456
#define XB_SPIN_CAP (1u << 18)


__device__ __forceinline__ unsigned xb_ld(unsigned* p)              { return __hip_atomic_load(p, __ATOMIC_RELAXED, __HIP_MEMORY_SCOPE_AGENT); }
__device__ __forceinline__ unsigned xb_add(unsigned* p, unsigned v) { return __hip_atomic_fetch_add(p, v, __ATOMIC_RELAXED, __HIP_MEMORY_SCOPE_AGENT); }
__device__ __forceinline__ unsigned xb_xcc_id() { return (unsigned)__builtin_amdgcn_s_getreg((3 << 11) | 20) & 0xFu; }
#define XB_SPIN(cond, bar) do { unsigned _sp = 0; while (cond) { __builtin_amdgcn_s_sleep(1); \
    if ((++_sp & 255u) == 0u) { if (xb_ld(&(bar)[XB_TMO])) break; if (_sp > XB_SPIN_CAP) { atomicAdd(&(bar)[XB_TMO], 1u); break; } } } } while (0)

struct XcdBarrier {
    unsigned* bar; unsigned x;
    volatile LAS unsigned* st; int wv;
};

__device__ __forceinline__ XcdBarrier xcd_barrier_post(unsigned* bar, volatile LAS unsigned* st, int wv) {
    XcdBarrier b; b.bar = bar; b.x = xb_xcc_id(); b.st = st; b.wv = wv;
    if (tid_from(wv) == 0) (void)xb_add(&bar[XB_XCNT(b.x)], 1u);
    return b;
}
__device__ __forceinline__ void xcd_barrier_complete(unsigned* bar, unsigned x, unsigned& nloc, unsigned& nx) {
    const unsigned G = gridDim.x * gridDim.y * gridDim.z;
    unsigned sum, cnt, mine, sp = 0u;
    for (;;) {
        sum = 0u; cnt = 0u; mine = 0u;
#pragma unroll
        for (unsigned j = 0; j < 16; ++j) { const unsigned c = xb_ld(&bar[XB_XCNT(j)]); sum += c; cnt += (c > 0u) ? 1u : 0u; mine = (j == x) ? c : mine; }
        if (sum == G) break;
        __builtin_amdgcn_s_sleep(1);
        if ((++sp & 255u) == 0u) { if (xb_ld(&bar[XB_TMO])) break; if (sp > XB_SPIN_CAP) { atomicAdd(&bar[XB_TMO], 1u); break; } }
    }
    nloc = mine > 0u ? mine : 1u; nx = cnt > 0u ? cnt : 1u;
}

__device__ __forceinline__ void xcd_barrier(const XcdBarrier& b) {
    asm volatile("s_waitcnt vmcnt(0)" ::: "memory");
    __syncthreads();
    if (tid_from(b.wv) == 0) {
        unsigned* bar = b.bar;
        __builtin_amdgcn_s_waitcnt(0);
        unsigned nloc = b.st[0], nx = b.st[1];
        if (nloc == 0u) { xcd_barrier_complete(bar, b.x, nloc, nx); b.st[0] = nloc; b.st[1] = nx; }
        const unsigned old = xb_add(&bar[XB_XSUB(b.x)], 1u);
        const unsigned gen = old / nloc;
        if (old + 1u == (gen + 1u) * nloc) {
            __builtin_amdgcn_fence(__ATOMIC_RELEASE, "agent");
            asm volatile("s_waitcnt vmcnt(0)" ::: "memory");
            const unsigned og = xb_add(&bar[XB_TOP], 1u);
            const unsigned tg = og / nx;
            if (og + 1u == (tg + 1u) * nx) xb_add(&bar[XB_TOPGEN], 1u);
            else XB_SPIN(xb_ld(&bar[XB_TOPGEN]) == tg, bar);
            __builtin_amdgcn_fence(__ATOMIC_ACQUIRE, "agent");
            xb_add(&bar[XB_XGEN(b.x)], 1u);
            asm volatile("s_waitcnt vmcnt(0)" ::: "memory");
        } else {
            XB_SPIN(xb_ld(&bar[XB_XGEN(b.x)]) == gen, bar);
            __builtin_amdgcn_fence(__ATOMIC_ACQUIRE, "agent");
            asm volatile("s_waitcnt vmcnt(0)" ::: "memory");
        }
    }
    __syncthreads();
}

namespace pg8 {
#define PG8_LAS __attribute__((address_space(3)))
typedef unsigned short bf16_t;
typedef short bf16x8 __attribute__((ext_vector_type(8)));
typedef float f32x4 __attribute__((ext_vector_type(4)));
typedef unsigned u32x4 __attribute__((ext_vector_type(4)));
constexpr int BM = 256, BK = 64, HALF = 128, HTB = HALF * BK * 2  , STAGE_BYTES = 8 * HTB, NXCD = 8, WGM = 8;

__host__ __device__ __forceinline__ int lds_byte(int r, int c) { const int st = (r >> 4) * 2 + (c >> 5), rr = r & 15, cc = c & 31, ob = rr * 64 + cc * 2; return st * 1024 + (ob ^ (((ob >> 9) & 1) << 5)); }
__host__ __device__ __forceinline__ void stage_rc(int b, int& R, int& C) { const int st = b / 1024, sb = b % 1024, swz = sb ^ (((sb >> 9) & 1) << 5); R = (st >> 1) * 16 + swz / 64; C = (st & 1) * 32 + (swz % 64) / 2; }
__host__ __device__ __forceinline__ int perm32(int rho) { const int n = rho >> 4, i = rho & 15; return 8 * (i >> 2) + 4 * n + (i & 3); }

struct Unit { int pm, pn; };
struct Gemm { const bf16_t* A; const bf16_t* Bt; int M, N, K; int lda; };

struct StaticOrder {
    int nM, nN, nwg, G, c;
    __host__ __device__ void init(int M, int N, int G_, int c_) { nM = M / BM; nN = N / BM; nwg = nM * nN; G = G_; c = c_; }
    __host__ __device__ bool next(int i, Unit& u) const {
        const long L = (long)i * G + c; if (L >= nwg) return false;
        int wgid = (int)L; { const int q = nwg / NXCD, r = nwg % NXCD, xcd = wgid % NXCD, off = wgid / NXCD; wgid = (xcd < r ? xcd * (q + 1) : r * (q + 1) + (xcd - r) * q) + off; }
        const int nig = WGM * nN, gid = wgid / nig, fm = gid * WGM, gsz = (nM - fm) < WGM ? (nM - fm) : WGM;
        u.pm = fm + ((wgid % nig) % gsz); u.pn = (wgid % nig) / gsz; return true;
    }
    __device__ __forceinline__ void a_ready(const Unit&) const {}
    __device__ __forceinline__ void done(const Unit&) const {}
    __device__ __forceinline__ void krange(const Unit&, int nt, int& kt0, int& nkt) const { kt0 = 0; nkt = nt; }
};
struct QkvOrder : StaticOrder {
    __device__ __forceinline__ void krange(const Unit& u, int, int& kt0, int& nkt) const { if (u.pn < 2) { kt0 = 0; nkt = 4; } else { kt0 = 4; nkt = 2; } }
};

__device__ __forceinline__ float row_rstd(const float* RS, int row) {
    const f32x4* p = (const f32x4*)(RS + (size_t)row * 16);
    const f32x4 a = p[0], b = p[1], c = p[2], d = p[3];
    const float s = ((a[0] + a[1]) + (a[2] + a[3])) + ((b[0] + b[1]) + (b[2] + b[3])) + ((c[0] + c[1]) + (c[2] + c[3])) + ((d[0] + d[1]) + (d[2] + d[3]));
    return __builtin_amdgcn_rsqf(s * (1.0f / 1024.0f) + 1e-6f);
}
__device__ __forceinline__ void st_bf8(bf16_t* p, f32x4 a, f32x4 c) { u32x4 w; w.x = ::pk2(a[0], a[1]); w.y = ::pk2(a[2], a[3]); w.z = ::pk2(c[0], c[1]); w.w = ::pk2(c[2], c[3]); *(u32x4*)p = w; }
__device__ __forceinline__ void st_bf4(bf16_t* p, f32x4 v) { u32x2 w; w.x = ::pk2(v[0], v[1]); w.y = ::pk2(v[2], v[3]); *(u32x2*)p = w; }

template <bool HAS_RS> struct EpiScaleBf16 {
    static constexpr bool PERM = true, AFTER_DRAIN = false, RESCALE = false;
    bf16_t* O; int ldc; const float* RS;
    __device__ __forceinline__ void operator()(const f32x4 (&acc)[2][2][4][2], const Unit& u, int wr, int wc, int fr, int fq) const {
        { int t2_ = (wr * 4 + wc) * 64 + ::lane_now(); asm volatile("" : "+v"(t2_)); fr = t2_ & 15; fq = (t2_ >> 4) & 3; }
        const int row0 = u.pm * BM + wr * 64 + fr, col0 = u.pn * BM + wc * 32 + 8 * fq;
#pragma unroll
        for (int ai = 0; ai < 2; ++ai)
#pragma unroll
            for (int m = 0; m < 4; ++m) {
                const int row = row0 + ai * HALF + m * 16;
                const float sc = HAS_RS ? row_rstd(RS, row) : 1.0f;
                bf16_t* rowp = O + (size_t)row * ldc;
#pragma unroll
                for (int bj = 0; bj < 2; ++bj) st_bf8(rowp + col0 + bj * HALF, acc[ai][bj][m][0] * sc, acc[ai][bj][m][1] * sc);
            }
    }
};
struct EpiQRope {
    static constexpr bool PERM = false, AFTER_DRAIN = false, RESCALE = false;
    bf16_t* O; int ldc; const float* rope;
    __device__ __forceinline__ void operator()(const f32x4 (&acc)[2][2][4][2], const Unit& u, int wr, int wc, int fr, int fq) const {
        { int t2_ = (wr * 4 + wc) * 64 + ::lane_now(); asm volatile("" : "+v"(t2_)); fr = t2_ & 15; fq = (t2_ >> 4) & 3; }
        const int row0 = u.pm * BM + wr * 64 + fr, col0 = u.pn * BM + wc * 32 + 4 * fq;
#pragma unroll
        for (int ai = 0; ai < 2; ++ai)
#pragma unroll
            for (int m = 0; m < 4; ++m) {
                const int row = row0 + ai * HALF + m * 16, pos = row & (::SEQ - 1);
                bf16_t* rowp = O + (size_t)row * ldc;
#pragma unroll
                for (int bj = 0; bj < 2; ++bj) {
                    const int c = col0 + bj * HALF;
                    if (c >= 384) continue;
                    f32x4 v0 = acc[ai][bj][m][0], v1 = acc[ai][bj][m][1];
                    if (((c >> 5) % 3) == 2) {
                        const f32x4* rp = (const f32x4*)(rope + ((size_t)pos * 16 + 4 * fq) * 2);
                        const f32x4 cs0 = rp[0], cs1 = rp[1];
                        const float co[4] = {cs0[0], cs0[2], cs1[0], cs1[2]}, si[4] = {cs0[1], cs0[3], cs1[1], cs1[3]};
                        f32x4 a, b;
#pragma unroll
                        for (int i = 0; i < 4; ++i) { a[i] = v0[i] * co[i] - v1[i] * si[i]; b[i] = v0[i] * si[i] + v1[i] * co[i]; }
                        v0 = a; v1 = b;
                    }
                    st_bf4(rowp + c, v0); st_bf4(rowp + c + 16, v1);
                }
            }
    }
};
struct EpiResidual {
    static constexpr bool PERM = true, AFTER_DRAIN = false, RESCALE = false;
    const bf16_t* XI; bf16_t* XB; float* RS; bool stats;
    __device__ __forceinline__ void operator()(const f32x4 (&acc)[2][2][4][2], const Unit& u, int wr, int wc, int fr, int fq) const {
        { int t2_ = (wr * 4 + wc) * 64 + ::lane_now(); asm volatile("" : "+v"(t2_)); fr = t2_ & 15; fq = (t2_ >> 4) & 3; }
        const int row0 = u.pm * BM + wr * 64 + fr, col0 = u.pn * BM + wc * 32 + 8 * fq;
#pragma unroll
        for (int ai = 0; ai < 2; ++ai)
#pragma unroll
            for (int m = 0; m < 4; ++m) {
                const int row = row0 + ai * HALF + m * 16;
                const size_t ro = (size_t)row * ::DMODEL;
                float ss = 0.f;
#pragma unroll
                for (int bj = 0; bj < 2; ++bj) {
                    const int c = col0 + bj * HALF;
                    const u32x4 xo = *(const u32x4*)(XI + ro + c);
                    const f32x4 x0 = (f32x4){::bflo(xo.x), ::bfhi(xo.x), ::bflo(xo.y), ::bfhi(xo.y)} + acc[ai][bj][m][0];
                    const f32x4 x1 = (f32x4){::bflo(xo.z), ::bfhi(xo.z), ::bflo(xo.w), ::bfhi(xo.w)} + acc[ai][bj][m][1];
                    st_bf8(XB + ro + c, x0, x1);
                    ss += ((x0[0] * x0[0] + x0[1] * x0[1]) + (x0[2] * x0[2] + x0[3] * x0[3])) + ((x1[0] * x1[0] + x1[1] * x1[1]) + (x1[2] * x1[2] + x1[3] * x1[3]));
                }
                { const int ln_ = fq * 16 + fr; ss += ::lane_xor(ss, ln_, 16); ss += ::lane_xor(ss, ln_, 32); }
                if (stats && fq == 0) RS[(size_t)row * 16 + u.pn * 4 + wc] = ss;
            }
    }
};
struct EpiSwiGLU {
    static constexpr bool PERM = true, AFTER_DRAIN = false, RESCALE = false;
    bf16_t* O; const float* RS;
    __device__ __forceinline__ void operator()(const f32x4 (&acc)[2][2][4][2], const Unit& u, int wr, int wc, int fr, int fq) const {
        { int t2_ = (wr * 4 + wc) * 64 + ::lane_now(); asm volatile("" : "+v"(t2_)); fr = t2_ & 15; fq = (t2_ >> 4) & 3; }
        const int row0 = u.pm * BM + wr * 64 + fr, col0 = u.pn * HALF + wc * 32 + 8 * fq;
#pragma unroll
        for (int ai = 0; ai < 2; ++ai)
#pragma unroll
            for (int m = 0; m < 4; ++m) {
                const int row = row0 + ai * HALF + m * 16;
                const float sc = row_rstd(RS, row);
                bf16_t* rowp = O + (size_t)row * ::FFN_H;
                f32x4 r2[2];
#pragma unroll
                for (int n = 0; n < 2; ++n) {
                    const f32x4 g = acc[ai][0][m][n] * sc, up = acc[ai][1][m][n] * sc;
#pragma unroll
                    for (int i = 0; i < 4; ++i) r2[n][i] = g[i] * __builtin_amdgcn_rcpf(1.0f + __builtin_amdgcn_exp2f(-g[i] * 1.4426950408889634f)) * up[i];
                }
                st_bf8(rowp + col0, r2[0], r2[1]);
            }
    }
};
struct EpiSplitQKV {
    static constexpr bool PERM = true, AFTER_DRAIN = false, RESCALE = false;
    bf16_t* QM; bf16_t* KV; const float* RSQ; const float* RSKV;
    __device__ __forceinline__ void operator()(const f32x4 (&acc)[2][2][4][2], const Unit& u, int wr, int wc, int fr, int fq) const {
        { int t2_ = (wr * 4 + wc) * 64 + ::lane_now(); asm volatile("" : "+v"(t2_)); fr = t2_ & 15; fq = (t2_ >> 4) & 3; }
        const bool isq = u.pn < 2;
        bf16_t* O = isq ? QM : KV; const int ldc = isq ? 512 : 768;
        const int row0 = u.pm * BM + wr * 64 + fr, col0 = (isq ? u.pn : u.pn - 2) * BM + wc * 32 + 8 * fq;
#pragma unroll
        for (int ai = 0; ai < 2; ++ai)
#pragma unroll
            for (int m = 0; m < 4; ++m) {
                const int row = row0 + ai * HALF + m * 16;
                const f32x4 ps = *(const f32x4*)((isq ? RSQ : RSKV) + (size_t)row * 4);
                const float sc = __builtin_amdgcn_rsqf(((ps[0] + ps[1]) + (ps[2] + ps[3])) * (isq ? 1.0f / 256.0f : 1.0f / 128.0f) + 1e-6f);
                bf16_t* rowp = O + (size_t)row * ldc;
#pragma unroll
                for (int bj = 0; bj < 2; ++bj) st_bf8(rowp + col0 + bj * HALF, acc[ai][bj][m][0] * sc, acc[ai][bj][m][1] * sc);
            }
    }
};
struct EpiResidualY {
    static constexpr bool PERM = true, AFTER_DRAIN = false, RESCALE = true;
    const bf16_t* XI; bf16_t* XB; float* RS; const float* SSQ;
    __device__ __forceinline__ static void group_rstd(const float* SSQ, int row, float& ra, float& rb, float& rc) {
        const f32x4* p = (const f32x4*)(SSQ + (size_t)row * 12);
        const f32x4 a = p[0], b = p[1], c = p[2];
        ra = __builtin_amdgcn_rsqf(((a[0] + a[1]) + (a[2] + a[3])) * (1.0f / 512.0f) + 1e-6f);
        rb = __builtin_amdgcn_rsqf(((b[0] + b[1]) + (b[2] + b[3])) * (1.0f / 256.0f) + 1e-6f);
        rc = __builtin_amdgcn_rsqf(((c[0] + c[1]) + (c[2] + c[3])) * (1.0f / 256.0f) + 1e-6f);
    }
    __device__ __forceinline__ void rescale(f32x4 (&acc)[2][2][4][2], const Unit& u, int t, int wr, int wc) const {
        int fr, fq; { int t2_ = (wr * 4 + wc) * 64 + ::lane_now(); asm volatile("" : "+v"(t2_)); fr = t2_ & 15; fq = (t2_ >> 4) & 3; } (void)fq;
        const int row0 = u.pm * BM + wr * 64 + fr;
#pragma unroll
        for (int ai = 0; ai < 2; ++ai)
#pragma unroll
            for (int m = 0; m < 4; ++m) {
                float ra, rb, rc; group_rstd(SSQ, row0 + ai * HALF + m * 16, ra, rb, rc);
                const float f = (t == 8) ? ra * __builtin_amdgcn_rcpf(rb) : rb * __builtin_amdgcn_rcpf(rc);
#pragma unroll
                for (int bj = 0; bj < 2; ++bj)
#pragma unroll
                    for (int n = 0; n < 2; ++n) acc[ai][bj][m][n] = acc[ai][bj][m][n] * f;
            }
    }
    __device__ __forceinline__ void operator()(const f32x4 (&acc)[2][2][4][2], const Unit& u, int wr, int wc, int fr, int fq) const {
        { int t2_ = (wr * 4 + wc) * 64 + ::lane_now(); asm volatile("" : "+v"(t2_)); fr = t2_ & 15; fq = (t2_ >> 4) & 3; }
        const int row0 = u.pm * BM + wr * 64 + fr, col0 = u.pn * BM + wc * 32 + 8 * fq;
#pragma unroll
        for (int ai = 0; ai < 2; ++ai)
#pragma unroll
            for (int m = 0; m < 4; ++m) {
                const int row = row0 + ai * HALF + m * 16;
                const size_t ro = (size_t)row * ::DMODEL;
                float ra, rb, rc; group_rstd(SSQ, row, ra, rb, rc); (void)ra; (void)rb;
                float ss = 0.f;
#pragma unroll
                for (int bj = 0; bj < 2; ++bj) {
                    const int c = col0 + bj * HALF;
                    const u32x4 xo = *(const u32x4*)(XI + ro + c);
                    const f32x4 x0 = (f32x4){::bflo(xo.x), ::bfhi(xo.x), ::bflo(xo.y), ::bfhi(xo.y)} + acc[ai][bj][m][0] * rc;
                    const f32x4 x1 = (f32x4){::bflo(xo.z), ::bfhi(xo.z), ::bflo(xo.w), ::bfhi(xo.w)} + acc[ai][bj][m][1] * rc;
                    st_bf8(XB + ro + c, x0, x1);
                    ss += ((x0[0] * x0[0] + x0[1] * x0[1]) + (x0[2] * x0[2] + x0[3] * x0[3])) + ((x1[0] * x1[0] + x1[1] * x1[1]) + (x1[2] * x1[2] + x1[3] * x1[3]));
                }
                { const int ln_ = fq * 16 + fr; ss += ::lane_xor(ss, ln_, 16); ss += ::lane_xor(ss, ln_, 32); }
                if (fq == 0) RS[(size_t)row * 16 + u.pn * 4 + wc] = ss;
            }
    }
};
struct EpiWin {
    static constexpr bool PERM = true, AFTER_DRAIN = false, RESCALE = false;
    bf16_t* O; const float* RS; float* RSQ; float* RSKV; bf16_t* KPE; float* LF; const float* rope; const float* fb;
    __device__ __forceinline__ void operator()(const f32x4 (&acc)[2][2][4][2], const Unit& u, int wr, int wc, int fr, int fq) const {
        { int t2_ = (wr * 4 + wc) * 64 + ::lane_now(); asm volatile("" : "+v"(t2_)); fr = t2_ & 15; fq = (t2_ >> 4) & 3; }
        const int row0 = u.pm * BM + wr * 64 + fr, col0 = u.pn * BM + wc * 32 + 8 * fq, ln_ = fq * 16 + fr;
#pragma unroll
        for (int ai = 0; ai < 2; ++ai)
#pragma unroll
            for (int m = 0; m < 4; ++m) {
                const int row = row0 + ai * HALF + m * 16;
                const float sc = row_rstd(RS, row);
                bf16_t* rowp = O + (size_t)row * ::PROJ_W;
                f32x4 v[2][2];
#pragma unroll
                for (int bj = 0; bj < 2; ++bj)
#pragma unroll
                    for (int n = 0; n < 2; ++n) v[bj][n] = acc[ai][bj][m][n] * sc;
#pragma unroll
                for (int bj = 0; bj < 2; ++bj) st_bf8(rowp + col0 + bj * HALF, v[bj][0], v[bj][1]);
                if (u.pn < 2) {
                    float s0 = 0.f, s1 = 0.f;
#pragma unroll
                    for (int n = 0; n < 2; ++n)
#pragma unroll
                        for (int i = 0; i < 4; ++i) { s0 += v[0][n][i] * v[0][n][i]; s1 += v[1][n][i] * v[1][n][i]; }
                    float ss = (u.pn == 0) ? s0 + s1 : s0;
                    ss += ::lane_xor(ss, ln_, 16); ss += ::lane_xor(ss, ln_, 32);
                    if (fq == 0) { if (u.pn == 0) RSQ[(size_t)row * 4 + wc] = ss; else RSKV[(size_t)row * 4 + wc] = ss; }
                    if (u.pn == 1 && wc == 0) {
                        const int pos = row & (::SEQ - 1), jb = 8 * (fq & 1);
                        const f32x4* rp = (const f32x4*)(rope + ((size_t)pos * 16 + jb) * 2);
                        f32x4 o2[2];
#pragma unroll
                        for (int n = 0; n < 2; ++n) { const f32x4 csA = rp[2 * n], csB = rp[2 * n + 1];
                            const float co[4] = {csA[0], csA[2], csB[0], csB[2]}, si[4] = {csA[1], csA[3], csB[1], csB[3]};
#pragma unroll
                            for (int i = 0; i < 4; ++i) { const float mine = v[1][n][i], oth = ::lane_xor(mine, ln_, 32);
                                o2[n][i] = (fq < 2) ? mine * co[i] - oth * si[i] : oth * si[i] + mine * co[i]; } }
                        st_bf8(KPE + (size_t)row * 32 + 8 * fq, o2[0], o2[1]);
                    }
                    if (u.pn == 1 && wc == 1 && fq == 0) {
                        f32x4 lf;
#pragma unroll
                        for (int i = 0; i < 4; ++i) { const float z = v[1][0][i] + fb[i]; lf[i] = -__builtin_amdgcn_logf(1.0f + __builtin_amdgcn_exp2f(-1.4426950408889634f * z)); }
                        *(f32x4*)(LF + (size_t)row * 4) = lf;
                    }
                }
            }
    }
};
template <class Epi, class Sched, bool ALIGN_EPI = false, bool SP2 = false>
__device__ __forceinline__ void gemm_phase(PG8_LAS unsigned char* lds, const Gemm g, const Sched& S, const Epi& E, int wv) {
    int tid_l = ::tid_from(wv); asm volatile("" : "+v"(tid_l));
    const int tid = tid_l, wid = wv, lane = tid & 63, wr = wid >> 2, wc = wid & 3, fr = lane & 15, fq = lane >> 4;
    const int K = g.K, nt = K / BK, lda = g.lda ? g.lda : K;
    unsigned voffA[2], voffB[2];
#pragma unroll
    for (int i = 0; i < 2; ++i) { int R, C; stage_rc(tid * 16 + i * 8192, R, C); const int Rb = Epi::PERM ? ((R & ~31) + perm32(R & 31)) : R;
        voffA[i] = (unsigned)(R * lda + C) * 2u; voffB[i] = (unsigned)(Rb * K + C) * 2u; }
    const size_t kstep = (size_t)(BK * 2);
    const size_t hstep = (size_t)HALF * K * 2;
    const size_t tstep = 2 * hstep;
    const size_t hstepA = (size_t)HALF * lda * 2, tstepA = 2 * hstepA;
    const unsigned ldsw = (unsigned)wid * 1024u;
    const int aoff = lds_byte(wr * 64 + fr, fq * 8), boff = lds_byte(wc * 32 + fr, fq * 8);
#define PG8_SA(b, h) (((b) * 2 + (h)) * HTB)
#define PG8_SB(b, h) ((4 + (b) * 2 + (h)) * HTB)
#define PG8_STAGE(bufoff, gbase, voff) do { _Pragma("unroll") for (int _i = 0; _i < 2; ++_i) \
        __builtin_amdgcn_global_load_lds((const unsigned*)((const char*)(gbase) + (voff)[_i]), (PG8_LAS unsigned*)(lds + (bufoff) + ldsw + _i * 8192), 16, 0, 0); } while (0)
#define PG8_LDA(dst, b, h) do { _Pragma("unroll") for (int m = 0; m < 4; ++m) _Pragma("unroll") for (int k = 0; k < 2; ++k) dst[m][k] = *(const PG8_LAS bf16x8*)(lds + PG8_SA(b, h) + aoff + m * 2048 + k * 1024); } while (0)
#define PG8_LDB(dst, b, h) do { _Pragma("unroll") for (int n = 0; n < 2; ++n) _Pragma("unroll") for (int k = 0; k < 2; ++k) dst[n][k] = *(const PG8_LAS bf16x8*)(lds + PG8_SB(b, h) + boff + n * 2048 + k * 1024); } while (0)
#define PG8_MMA(ai, bj, At, Bt) do { __builtin_amdgcn_s_setprio(1); _Pragma("unroll") for (int m = 0; m < 4; ++m) _Pragma("unroll") for (int n = 0; n < 2; ++n) _Pragma("unroll") for (int k = 0; k < 2; ++k) \
        acc[ai][bj][m][n] = __builtin_amdgcn_mfma_f32_16x16x32_bf16(Bt[n][k], At[m][k], acc[ai][bj][m][n], 0, 0, 0); __builtin_amdgcn_s_setprio(0); } while (0)
#define PG8_WAIT_V(n) asm volatile("s_waitcnt vmcnt(" #n ")" ::: "memory")
#define PG8_WAIT_L(n) asm volatile("s_waitcnt lgkmcnt(" #n ")" ::: "memory")
#define PG8_BAR __builtin_amdgcn_s_barrier()
#define PG8_SCHED __builtin_amdgcn_sched_barrier(0)
    Unit cur, nxt; int ui = 0;
    if (!S.next(0, cur)) return;
    f32x4 acc[2][2][4][2];
#pragma unroll
    for (int a = 0; a < 2; ++a)
#pragma unroll
        for (int b = 0; b < 2; ++b)
#pragma unroll
            for (int m = 0; m < 4; ++m)
#pragma unroll
                for (int n = 0; n < 2; ++n) acc[a][b][m][n] = (f32x4){0.f, 0.f, 0.f, 0.f};
    bf16x8 At[4][2], B0[2][2], B1[2][2];
    int ck0, cnt; S.krange(cur, nt, ck0, cnt);
    const char* cA = (const char*)g.A + (size_t)cur.pm * tstepA + (size_t)ck0 * kstep; const char* cB = (const char*)g.Bt + (size_t)cur.pn * tstep + (size_t)ck0 * kstep;
    S.a_ready(cur);
    if constexpr (SP2) {
        PG8_STAGE(PG8_SB(0, 0), cB, voffB); PG8_STAGE(PG8_SB(0, 1), cB + hstep, voffB); PG8_STAGE(PG8_SA(0, 0), cA, voffA); PG8_STAGE(PG8_SA(0, 1), cA + hstepA, voffA);
        if (wr == 1) PG8_BAR;
        PG8_WAIT_V(2); PG8_BAR;
        PG8_STAGE(PG8_SB(1, 0), cB + kstep, voffB); PG8_STAGE(PG8_SA(1, 0), cA + kstep, voffA); PG8_STAGE(PG8_SB(1, 1), cB + hstep + kstep, voffB);
        PG8_WAIT_V(6); PG8_BAR;
    } else {
        PG8_STAGE(PG8_SB(0, 0), cB, voffB); PG8_STAGE(PG8_SA(0, 0), cA, voffA); PG8_STAGE(PG8_SB(0, 1), cB + hstep, voffB); PG8_STAGE(PG8_SA(0, 1), cA + hstepA, voffA);
        if (wr == 1) PG8_BAR;
        PG8_WAIT_V(4); PG8_BAR;
        PG8_STAGE(PG8_SB(1, 0), cB + kstep, voffB); PG8_STAGE(PG8_SA(1, 0), cA + kstep, voffA); PG8_STAGE(PG8_SB(1, 1), cB + hstep + kstep, voffB);
        PG8_WAIT_V(6); PG8_BAR;
    }
    for (;;) {
        const bool has_next = S.next(ui + 1, nxt);
        int nk0 = 0, nnt = cnt; if (has_next) S.krange(nxt, nt, nk0, nnt);
        const char* nA = has_next ? (const char*)g.A + (size_t)nxt.pm * tstepA + (size_t)nk0 * kstep : cA; const char* nB = has_next ? (const char*)g.Bt + (size_t)nxt.pn * tstep + (size_t)nk0 * kstep : cB;
        for (int t = 0; t < cnt; t += 2) {
            if constexpr (Epi::RESCALE) { if (t == 8 || t == 12) E.rescale(acc, cur, t, wr, wc); }
            const bool last = (t == cnt - 2);
            const char* a1 = cA + (size_t)(t + 1) * kstep;
            const char* a2 = last ? nA : cA + (size_t)(t + 2) * kstep; const char* b2 = last ? nB : cB + (size_t)(t + 2) * kstep;
            const char* a3 = a2 + kstep; const char* b3 = b2 + kstep;
            if (last && has_next) S.a_ready(nxt);
            if constexpr (SP2) {
            PG8_LDB(B0, 0, 0); PG8_LDB(B1, 0, 1); PG8_SCHED; PG8_LDA(At, 0, 0); PG8_STAGE(PG8_SA(1, 1), a1 + hstepA, voffA);
            PG8_WAIT_V(8); PG8_WAIT_L(0); PG8_BAR; PG8_MMA(0, 0, At, B0); PG8_MMA(0, 1, At, B1); PG8_BAR; PG8_SCHED;
            PG8_LDA(At, 0, 1); PG8_STAGE(PG8_SB(0, 0), b2, voffB); PG8_STAGE(PG8_SB(0, 1), b2 + hstep, voffB); PG8_STAGE(PG8_SA(0, 0), a2, voffA);
            PG8_WAIT_V(8); PG8_WAIT_L(0); PG8_BAR; PG8_MMA(1, 0, At, B0); PG8_MMA(1, 1, At, B1); PG8_BAR; PG8_SCHED;
            PG8_LDB(B0, 1, 0); PG8_LDB(B1, 1, 1); PG8_SCHED; PG8_LDA(At, 1, 0); PG8_STAGE(PG8_SA(0, 1), a2 + hstepA, voffA);
            PG8_WAIT_V(8); PG8_WAIT_L(0); PG8_BAR; PG8_MMA(0, 0, At, B0); PG8_MMA(0, 1, At, B1); PG8_BAR; PG8_SCHED;
            PG8_LDA(At, 1, 1); PG8_STAGE(PG8_SB(1, 0), b3, voffB); PG8_STAGE(PG8_SB(1, 1), b3 + hstep, voffB); PG8_STAGE(PG8_SA(1, 0), a3, voffA);
            PG8_WAIT_V(8); PG8_WAIT_L(0); PG8_BAR; PG8_MMA(1, 0, At, B0); PG8_MMA(1, 1, At, B1); PG8_BAR; PG8_SCHED;
            } else {
            PG8_LDB(B0, 0, 0); PG8_SCHED; PG8_LDA(At, 0, 0); PG8_STAGE(PG8_SA(1, 1), a1 + hstepA, voffA);
            PG8_WAIT_L(8); PG8_BAR; PG8_WAIT_L(0); PG8_MMA(0, 0, At, B0); PG8_BAR; PG8_SCHED;
            PG8_LDB(B1, 0, 1); PG8_STAGE(PG8_SB(0, 0), b2, voffB);
            PG8_BAR; PG8_WAIT_L(0); PG8_MMA(0, 1, At, B1); PG8_BAR;
            PG8_LDA(At, 0, 1); PG8_STAGE(PG8_SA(0, 0), a2, voffA);
            PG8_BAR; PG8_WAIT_L(0); PG8_MMA(1, 0, At, B0); PG8_BAR; PG8_SCHED;
            PG8_STAGE(PG8_SB(0, 1), b2 + hstep, voffB);
            PG8_WAIT_V(6); PG8_BAR; PG8_MMA(1, 1, At, B1); PG8_BAR;
            PG8_LDB(B0, 1, 0); PG8_SCHED; PG8_LDA(At, 1, 0); PG8_STAGE(PG8_SA(0, 1), a2 + hstepA, voffA);
            PG8_WAIT_L(8); PG8_BAR; PG8_WAIT_L(0); PG8_MMA(0, 0, At, B0); PG8_BAR; PG8_SCHED;
            PG8_LDB(B1, 1, 1); PG8_STAGE(PG8_SB(1, 0), b3, voffB);
            PG8_BAR; PG8_WAIT_L(0); PG8_MMA(0, 1, At, B1); PG8_BAR;
            PG8_LDA(At, 1, 1); PG8_STAGE(PG8_SA(1, 0), a3, voffA);
            PG8_BAR; PG8_WAIT_L(0); PG8_MMA(1, 0, At, B0); PG8_BAR; PG8_SCHED;
            PG8_STAGE(PG8_SB(1, 1), b3 + hstep, voffB);
            PG8_WAIT_V(6); PG8_BAR; PG8_MMA(1, 1, At, B1); PG8_BAR;
            }
        }
        if constexpr (ALIGN_EPI) { if (wr == 0) PG8_BAR; }
        if constexpr (!Epi::AFTER_DRAIN) { E(acc, cur, wr, wc, fr, fq); S.done(cur); }
        if (!has_next) break;
#pragma unroll
        for (int a = 0; a < 2; ++a)
#pragma unroll
            for (int b = 0; b < 2; ++b)
#pragma unroll
                for (int m = 0; m < 4; ++m)
#pragma unroll
                    for (int n = 0; n < 2; ++n) acc[a][b][m][n] = (f32x4){0.f, 0.f, 0.f, 0.f};
        cur = nxt; cA = nA; cB = nB; cnt = nnt; ++ui;
        if constexpr (ALIGN_EPI) { if (wr == 1) PG8_BAR; }
    }
    PG8_WAIT_V(0);
    if constexpr (!ALIGN_EPI) { if (wr == 0) PG8_BAR; }
    PG8_BAR;
    if constexpr (Epi::AFTER_DRAIN) { E.fused(acc, cur, wr, wc, fr, fq, lds, wid, lane); S.done(cur); }
#undef PG8_SA
#undef PG8_SB
#undef PG8_STAGE
#undef PG8_LDA
#undef PG8_LDB
#undef PG8_MMA
#undef PG8_WAIT_V
#undef PG8_WAIT_L
#undef PG8_BAR
#undef PG8_SCHED
}
}
constexpr size_t MiB = 1u << 20;
constexpr size_t WS_W = 0, W_LAYER = 28 * MiB;
constexpr size_t WO_IN = 0, WO_UQ = 4 * MiB, WO_UKV = 4 * MiB + 512 * 1024, WO_O = 5 * MiB, WO_CQ = 7 * MiB, WO_CKV = 8 * MiB, WO_CO = 10 * MiB, WO_GU = 11 * MiB, WO_DOWN = 22 * MiB;
constexpr size_t WS_XB = 56 * MiB;
constexpr size_t WS_RS = 120 * MiB;
constexpr size_t WS_KPE = 122 * MiB;
constexpr size_t WS_LC = 124 * MiB;
constexpr size_t WS_CUM = 124 * MiB + 512 * 1024;
constexpr size_t WS_TOT = 125 * MiB;
constexpr size_t WS_ROPE = 125 * MiB + 512 * 1024;
constexpr size_t WS_MEMN = 127 * MiB;
constexpr size_t WS_KVMEM = 129 * MiB;
constexpr size_t WS_PROJ = 134 * MiB;
constexpr size_t WS_CQN = 262 * MiB;
constexpr size_t WS_CKVN = 278 * MiB;
constexpr size_t WS_QM = 294 * MiB;
constexpr size_t WS_HID = 134 * MiB;
constexpr size_t WS_KV = 326 * MiB;
constexpr size_t WS_Y = 374 * MiB;
constexpr size_t WS_SSQ = 438 * MiB;
constexpr size_t WS_RSQ = 440 * MiB;
constexpr size_t WS_RSKV = 440 * MiB + 512 * 1024;
constexpr size_t WS_BAR = 441 * MiB;
constexpr size_t WS_XB2 = 442 * MiB;
constexpr size_t WS_END = 506 * MiB;

constexpr int LDS_BYTES = 131072 + 4096;

struct Args { const float* in[21]; float* out; unsigned char* ws; int ph_lo, ph_hi; };
typedef const __attribute__((address_space(4))) Args* KArgs;

__device__ __forceinline__ int conv_map(int type, int n, float& sc) {
    sc = 1.0f;
    switch (type) {
    case 0:
        if (n < 416) return n;
        if (n < 420) return 1184 + (n - 416);
        if (n < 512) return -1;
        if (n < 1280) { if (n < 768) sc = SC_64; return 416 + (n - 512); }
        if (n < 1536) sc = SC_64;
        return 1188 + (n - 1280);
    case 1: sc = SC_MLA; return n < 384 ? n : -1;
    case 2: if (n < 256) return (n >> 6) * 192 + (n & 63); else { const int mm = n - 256; return (mm >> 7) * 192 + 64 + (mm & 127); }
    case 4: sc = SC_CROSS; return n;
    case 7: { const int t = n >> 8, c = n & 255; return c < 128 ? 128 * t + c : FFN_H + 128 * t + (c - 128); }
    default: return n;
    }
}
__device__ __forceinline__ void conv_tile(const float* src, const float* gain, bf16_t* dst, int K, int Nsrc, int Nd, int Kd, int type, int tile, LAS float* scr, int wv, int koff = 0) {
    int tid_l = tid_from(wv); asm volatile("" : "+v"(tid_l));
    const int tid = tid_l, ntn = Nd >> 8, kb = tile / ntn, nb = tile - kb * ntn, k0 = kb * 64, n0 = nb * 256;
    { const int nn = tid & 255, kh = tid >> 8; float sc; const int sn = conv_map(type, n0 + nn, sc);
      const float* sp = src + (size_t)(k0 + kh - koff) * Nsrc + (sn >= 0 ? sn : 0);
#pragma unroll 8
      for (int i = 0; i < 32; ++i) { const int kk = kh + 2 * i, k = k0 + kk; float v = 0.f;
          if (sn >= 0 && k >= koff && k - koff < K) { v = __builtin_nontemporal_load(sp + (size_t)(2 * i) * Nsrc) * sc; if (gain) v *= gain[k - koff]; }
          scr[nn * 65 + kk] = v; } }
    __syncthreads();
#pragma unroll
    for (int j = 0; j < 4; ++j) { const int idx = tid + 512 * j, nn = idx >> 3, kq = (idx & 7) * 8; const LAS float* s = scr + nn * 65 + kq;
      u32x4 o; o.x = pk2(s[0], s[1]); o.y = pk2(s[2], s[3]); o.z = pk2(s[4], s[5]); o.w = pk2(s[6], s[7]);
      *(u32x4*)(dst + (size_t)(n0 + nn) * Kd + k0 + kq) = o; }
    __syncthreads();
}
__device__ __forceinline__ void phase_prologue(KArgs a, LAS unsigned char* lds, int wv, int part) {
    LAS float* scr = (LAS float*)lds;
    unsigned char* ws = a->ws;
    int tid_l = tid_from(wv); asm volatile("" : "+v"(tid_l));
    const int tid = tid_l, lane = tid & 63, wave = tid >> 6;
    constexpr int NT_L = 128 + 12 + 18 + 64 + 32 + 64 + 32 + 352 + 176;
    const int g_lo = part == 0 ? 0 : 128, g_hi = part == 0 ? 128 : NLAYER * NT_L;
    for (int g = g_lo + blockIdx.x; g < g_hi; g += gridDim.x) {
        const int l = g / NT_L; int r = g - l * NT_L;
        bf16_t* wb = (bf16_t*)(ws + WS_W + (size_t)l * W_LAYER);
        if (r < 128) { conv_tile(a->in[3] + (size_t)l * 1024 * IN_W, a->in[2] + l * 1024, (bf16_t*)((unsigned char*)wb + WO_IN), 1024, IN_W, 2048, 1024, 0, r, scr, wv); continue; } r -= 128;
        if (r < 12) { conv_tile(a->in[5] + (size_t)l * 256 * 384, a->in[4] + l * 256, (bf16_t*)((unsigned char*)wb + WO_UQ), 256, 384, 512, 384, 1, r, scr, wv); continue; } r -= 12;
        if (r < 18) { conv_tile(a->in[7] + (size_t)l * 128 * 768, a->in[6] + l * 128, (bf16_t*)((unsigned char*)wb + WO_UQ) + (size_t)512 * 384, 128, 768, 768, 384, 2, r, scr, wv, 256); continue; } r -= 18;
        if (r < 64) { conv_tile(a->in[11] + (size_t)l * 1024 * 1024, a->in[10] + l * 1024, (bf16_t*)((unsigned char*)wb + WO_O), 1024, 1024, 1024, 1024, 3, r, scr, wv); continue; } r -= 64;
        if (r < 32) { conv_tile(a->in[14] + (size_t)l * 1024 * 512, a->in[12] + l * 1024, (bf16_t*)((unsigned char*)wb + WO_CQ), 1024, 512, 512, 1024, 4, r, scr, wv); continue; } r -= 32;
        if (r < 64) { conv_tile(a->in[15] + (size_t)l * 1024 * 1024, a->in[13] + l * 1024, (bf16_t*)((unsigned char*)wb + WO_CKV), 1024, 1024, 1024, 1024, 5, r, scr, wv); continue; } r -= 64;
        if (r < 32) { conv_tile(a->in[16] + (size_t)l * 512 * 1024, nullptr, (bf16_t*)((unsigned char*)wb + WO_CO), 512, 1024, 1024, 512, 6, r, scr, wv); continue; } r -= 32;
        if (r < 352) { conv_tile(a->in[18] + (size_t)l * 1024 * 2 * FFN_H, a->in[17] + l * 1024, (bf16_t*)((unsigned char*)wb + WO_GU), 1024, 2 * FFN_H, 2 * FFN_H, 1024, 7, r, scr, wv); continue; } r -= 352;
        conv_tile(a->in[19] + (size_t)l * FFN_H * 1024, nullptr, (bf16_t*)((unsigned char*)wb + WO_DOWN), FFN_H, 1024, 1024, FFN_H, 8, r, scr, wv);
    }
    if (part != 0) return;
    const int gw = blockIdx.x * NWAVES + wave, ngw = gridDim.x * NWAVES;
    bf16_t* XB = (bf16_t*)(ws + WS_XB); float* RS = (float*)(ws + WS_RS); bf16_t* MEMN = (bf16_t*)(ws + WS_MEMN);
    for (int row = gw; row < T_TOK + NBATCH * MEMLEN; row += ngw) {
        const bool ismem = row >= T_TOK; const int rr = ismem ? row - T_TOK : row;
        const f32x4* xr = (const f32x4*)((ismem ? a->in[1] : a->in[0]) + (size_t)rr * DMODEL) + lane;
        f32x4 v[4]; float s = 0.f;
#pragma unroll
        for (int j = 0; j < 4; ++j) { v[j] = __builtin_nontemporal_load(xr + 64 * j); s += (v[j][0] * v[j][0] + v[j][1] * v[j][1]) + (v[j][2] * v[j][2] + v[j][3] * v[j][3]); }
        s = wave_sum(s, lane);
        float sc = 1.0f;
        if (ismem) sc = __builtin_amdgcn_rsqf(s * (1.0f / 1024.0f) + EPS);
        else if (lane < 16) RS[(size_t)rr * 16 + lane] = lane == 0 ? s : 0.f;
        u32x2* o8 = (u32x2*)((ismem ? MEMN : XB) + (size_t)rr * DMODEL) + lane;
#pragma unroll
        for (int j = 0; j < 4; ++j) { u32x2 w; w.x = pk2(v[j][0] * sc, v[j][1] * sc); w.y = pk2(v[j][2] * sc, v[j][3] * sc); o8[64 * j] = w; }
    }
    float* rope = (float*)(ws + WS_ROPE);
    for (int i = blockIdx.x * NTHREADS + tid; i < SEQ * 16; i += gridDim.x * NTHREADS) {
        const int pos = i >> 4, j = i & 15;
        const float inv = powf(10000.0f, -(float)(2 * j) / 32.0f), ang = (float)pos * inv;
        rope[2 * i] = cosf(ang); rope[2 * i + 1] = sinf(ang);
    }
}

__device__ __forceinline__ void phase_cum(KArgs a, LAS unsigned char* lds, int wv) {
    unsigned char* ws = a->ws;
    const float* LF = (const float*)(ws + WS_LC); float* CUM = (float*)(ws + WS_CUM);
    LAS float* sc = (LAS float*)lds;
    LAS float* lc = (LAS float*)(lds + 2048);
    int tid_l = tid_from(wv); asm volatile("" : "+v"(tid_l));
    const int tid = tid_l, lane = tid & 63, wave = tid >> 6;
    const int gsz = (int)gridDim.x, half = gsz >= 256 ? gsz / 2 : 0;
    if ((int)blockIdx.x < half) return;
    for (int c = (int)blockIdx.x - half; c < T_TOK / 64; c += gsz - half) {
        const int b = c >> 7, ci = c & 127, n0 = ci * 64;
        { const f32x4* base = (const f32x4*)(LF + (size_t)b * SEQ * 4);
          f32x4 acc = (f32x4){0.f, 0.f, 0.f, 0.f};
          for (int t = tid; t < n0; t += NTHREADS) acc += base[t];
#pragma unroll
          for (int k = 0; k < 4; ++k) acc[k] = wave_sum(acc[k], lane);
          if (lane == 0) *(LAS f32x4*)(sc + wave * 4) = acc;
          if (tid < 256) lc[tid] = LF[((size_t)c * 64) * 4 + tid]; }
        __syncthreads();
        if (tid < 256) {
            const int h = tid & 3, i = tid >> 2; float p = 0.f;
#pragma unroll
            for (int w = 0; w < NWAVES; ++w) p += sc[w * 4 + h];
            for (int j = 0; j <= i; ++j) p += lc[j * 4 + h];
            CUM[(size_t)(c * 64 + i) * 4 + h] = p;
        }
        __syncthreads();
    }
}

__device__ __forceinline__ f32x16 mfma32(bf16x8 a, bf16x8 b, f32x16 c) { return __builtin_amdgcn_mfma_f32_32x32x16_bf16(a, b, c, 0, 0, 0); }
typedef short v4i16_t __attribute__((ext_vector_type(4)));
__device__ __forceinline__ float max3f(float a, float b, float c) { float r; asm("v_max3_f32 %0, %1, %2, %3" : "=v"(r) : "v"(a), "v"(b), "v"(c)); return r; }
__device__ __forceinline__ s16x4 vtr(const LAS unsigned char* p) { return __builtin_bit_cast(s16x4, __builtin_amdgcn_ds_read_tr16_b64_v4i16((LAS v4i16_t*)p)); }

struct AttnT {
    const bf16_t* Q; int qpitch, qcol;
    const bf16_t* K; int kpitch, kcol;
    const bf16_t* K2;
    const bf16_t* V; int vpitch, vcol;
    bf16_t* O; int opitch, ocol;
    const float* cum;
    const float* relb;
    const float* rope;
    float* ssq; int slot0;
};
template <int DQK, int DV, int MODE>
__device__ __forceinline__ void attn_unit(LAS unsigned char* lds, const AttnT& A, int b, int h, int qb, int wv) {
    constexpr int KB = DQK * 128, VB = DV * 128, KVB = KB + VB;
    constexpr int KPT = (8 * DQK + 511) / 512, VPT = (8 * DV + 511) / 512, ND = DQK / 16, NV = DV / 32;
    int tid_l = tid_from(wv); asm volatile("" : "+v"(tid_l));
    const int tid = tid_l, lane = tid & 63, r32 = lane & 31, hi = lane >> 5;
    const int wid = wv;
    LAS float* xtra = (LAS float*)(lds + 2 * KVB);
    const int q0 = qb * 256;
    const size_t qrow = (size_t)b * SEQ + q0 + wid * 32 + r32;
    const size_t krow0 = (MODE == 3) ? (size_t)b * MEMLEN : (size_t)b * SEQ;
    int kt_lo = 0, kt_hi = 4 * qb + 4;
    if (MODE == 2) kt_lo = (4 * qb - 8) > 0 ? (4 * qb - 8) : 0;
    if (MODE == 3) kt_hi = 4;
    const int wchunk = 4 * qb + (wid >> 1);
    int w_lo = 0, w_hi = wchunk;
    if (MODE == 2) w_lo = (wchunk - 8) > 0 ? (wchunk - 8) : 0;
    if (MODE == 3) w_hi = 3;
    bf16x8 qr[ND];
    { const bf16_t* qp = A.Q + qrow * A.qpitch + A.qcol + h * DQK + hi * 8;
#pragma unroll
      for (int d0 = 0; d0 < ND; ++d0) qr[d0] = *(const bf16x8*)(qp + d0 * 16); }
    if (MODE == 0) {
        const f32x4* rp = (const f32x4*)(A.rope + ((size_t)(q0 + wid * 32 + r32) * 16 + 8 * hi) * 2);
        bf16x8 a1 = qr[ND - 2], a2 = qr[ND - 1];
#pragma unroll
        for (int jj = 0; jj < 4; ++jj) { const f32x4 cs = rp[jj];
            const float x1a = bf2f((bf16_t)a1[2 * jj]), x2a = bf2f((bf16_t)a2[2 * jj]), x1b = bf2f((bf16_t)a1[2 * jj + 1]), x2b = bf2f((bf16_t)a2[2 * jj + 1]);
            const unsigned w1 = pk2(x1a * cs[0] - x2a * cs[1], x1b * cs[2] - x2b * cs[3]), w2 = pk2(x1a * cs[1] + x2a * cs[0], x1b * cs[3] + x2b * cs[2]);
            a1[2 * jj] = (short)(w1 & 0xffffu); a1[2 * jj + 1] = (short)(w1 >> 16); a2[2 * jj] = (short)(w2 & 0xffffu); a2[2 * jj + 1] = (short)(w2 >> 16); }
        qr[ND - 2] = a1; qr[ND - 1] = a2;
    }
    if (MODE == 2) { if (tid < 192) xtra[tid] = A.relb[h * 192 + tid] * LOG2E; }
    f32x16 o[NV];
#pragma unroll
    for (int d = 0; d < NV; ++d)
#pragma unroll
        for (int r = 0; r < 16; ++r) o[d][r] = 0.f;
    float mrun = 0.f, lrun = 0.f; bool first = true;
    u32x4 kreg[KPT], vreg[VPT]; float ckreg = 0.f;
    constexpr bool DEEP = (MODE != 3);
    u32x4 kreg2[KPT], vreg2[VPT]; float ckreg2 = 0.f;
#define GLOAD(kt, KR, VR, CR) do { const size_t rb_ = krow0 + (size_t)(kt) * 64; \
    _Pragma("unroll") for (int i_ = 0; i_ < KPT; ++i_) { const int e_ = tid + 512 * i_; if (e_ < 8 * DQK) { const int key_ = e_ & 63, c8_ = e_ >> 6; \
        const bf16_t* p_; if (MODE == 0 && c8_ >= 8) p_ = A.K2 + (rb_ + key_) * 32 + (c8_ - 8) * 8; else p_ = A.K + (rb_ + key_) * A.kpitch + A.kcol + h * (MODE == 0 ? 64 : DQK) + c8_ * 8; \
        KR[i_] = *(const u32x4*)p_; } } \
    _Pragma("unroll") for (int i_ = 0; i_ < VPT; ++i_) { const int e_ = tid + 512 * i_; const int part_ = e_ & 3, key_ = (e_ >> 2) & 63, d0_ = e_ >> 8; \
        VR[i_] = *(const u32x4*)(A.V + (rb_ + key_) * A.vpitch + A.vcol + h * DV + d0_ * 32 + part_ * 8); } \
    if (MODE == 1) { if (tid < 64) CR = A.cum[(rb_ + tid) * 4 + h]; } } while (0)
#define LWRITE(buf) do { LAS unsigned char* kb_ = lds + (buf) * KVB; \
    _Pragma("unroll") for (int i_ = 0; i_ < KPT; ++i_) { const int e_ = tid + 512 * i_; if (e_ < 8 * DQK) *(LAS u32x4*)(kb_ + e_ * 16) = kreg[i_]; } \
    _Pragma("unroll") for (int i_ = 0; i_ < VPT; ++i_) { const int e_ = tid + 512 * i_; *(LAS u32x4*)(kb_ + KB + e_ * 16) = vreg[i_]; } \
    if (MODE == 1) { if (tid < 64) xtra[(buf) * 64 + tid] = ckreg; } } while (0)
    const int nsteps = kt_hi - kt_lo;
#define KT(i_) ((MODE == 1) ? (kt_hi - 1 - (i_)) : (kt_lo + (i_)))
    GLOAD(KT(0), kreg, vreg, ckreg); LWRITE(0);
    if (DEEP) { if (1 < nsteps) GLOAD(KT(1), kreg, vreg, ckreg); }
    __syncthreads();
    bool hot = (MODE != 1);
#pragma unroll 1
    for (int it = 0; it < nsteps; ++it) {
        const int kt = KT(it);
        const int cur = it & 1;
        const bool more = it + 1 < nsteps;
        if (DEEP) { if (it + 2 < nsteps) GLOAD(KT(it + 2), kreg2, vreg2, ckreg2); } else { if (more) GLOAD(KT(it + 1), kreg, vreg, ckreg); }
        if (kt >= w_lo && kt <= w_hi) {
            const LAS unsigned char* Kb = lds + cur * KVB; const LAS unsigned char* Vb = Kb + KB;
            constexpr int NDA = ND > 6 ? ND / 2 : ND;
            bf16x8 kf0[NDA], kf1[NDA];
#pragma unroll
            for (int d0 = 0; d0 < NDA; ++d0) {
                kf0[d0] = *(const LAS bf16x8*)(Kb + (2 * d0 + hi) * 1024 + r32 * 16);
                kf1[d0] = *(const LAS bf16x8*)(Kb + (2 * d0 + hi) * 1024 + 512 + r32 * 16);
            }
            f32x4 ck0[4], ck1[4];
            if (MODE == 1) { const LAS float* ck = xtra + cur * 64;
#pragma unroll
                for (int g = 0; g < 4; ++g) { ck0[g] = *(const LAS f32x4*)(ck + 8 * g + 4 * hi); ck1[g] = *(const LAS f32x4*)(ck + 32 + 8 * g + 4 * hi); } }
            __builtin_amdgcn_sched_barrier(0);
            f32x16 p0, p1;
            { const float nm = -mrun;
#pragma unroll
            for (int r = 0; r < 16; ++r) { p0[r] = nm; p1[r] = nm; } }
#pragma unroll
            for (int d0 = 0; d0 < NDA; ++d0) { p0 = mfma32(kf0[d0], qr[d0], p0); p1 = mfma32(kf1[d0], qr[d0], p1); }
            __builtin_amdgcn_sched_barrier(0);
            if (NDA < ND) {
#pragma unroll
                for (int d0 = 0; d0 < ND - NDA; ++d0) {
                    kf0[d0] = *(const LAS bf16x8*)(Kb + (2 * (d0 + NDA) + hi) * 1024 + r32 * 16);
                    kf1[d0] = *(const LAS bf16x8*)(Kb + (2 * (d0 + NDA) + hi) * 1024 + 512 + r32 * 16);
                }
                __builtin_amdgcn_sched_barrier(0);
#pragma unroll
                for (int d0 = 0; d0 < ND - NDA; ++d0) { p0 = mfma32(kf0[d0], qr[d0 + NDA], p0); p1 = mfma32(kf1[d0], qr[d0 + NDA], p1); }
                __builtin_amdgcn_sched_barrier(0);
            }
            asm volatile("s_nop 15\n\ts_nop 7" : "+v"(p0), "+v"(p1));
            const LAS unsigned char* vbase = Vb + (4 * hi + ((lane & 15) >> 2)) * 64 + ((lane >> 4) & 1) * 32 + (lane & 3) * 8;
            constexpr int KSA = NV > 2 ? 1 : 4;
            s16x4 vlo[4][NV], vh4[4][NV];
            if (hot) {
#pragma unroll
                for (int ks = 0; ks < KSA; ++ks)
#pragma unroll
                    for (int d = 0; d < NV; ++d) { vlo[ks][d] = vtr(vbase + d * 4096 + ks * 1024); vh4[ks][d] = vtr(vbase + d * 4096 + ks * 1024 + 512); }
            }
            __builtin_amdgcn_sched_barrier(0);
            if (MODE == 1) {
#pragma unroll
                for (int g = 0; g < 4; ++g)
#pragma unroll
                    for (int i = 0; i < 4; ++i) { p0[4 * g + i] -= ck0[g][i]; p1[4 * g + i] -= ck1[g][i]; }
                if (kt * 64 + 63 > q0 + wid * 32) {
                    const int qrel = q0 + wid * 32 + r32 - kt * 64;
#pragma unroll
                    for (int r = 0; r < 16; ++r) { const int kk = (r & 3) + 8 * (r >> 2) + 4 * hi; if (kk > qrel) p0[r] = -INFINITY; if (kk + 32 > qrel) p1[r] = -INFINITY; }
                }
            }
            if (MODE == 2) {
                if (wchunk - kt >= 3) { const float cb = xtra[191];
#pragma unroll
                    for (int r = 0; r < 16; ++r) { p0[r] += cb; p1[r] += cb; } }
                else { const int qrel = q0 + wid * 32 + r32 - kt * 64 + 63;
#pragma unroll
                    for (int r = 0; r < 16; ++r) { const int kk = (r & 3) + 8 * (r >> 2) + 4 * hi;
                        int i0 = qrel - kk, i1 = qrel - kk - 32; i0 = i0 < 0 ? 0 : (i0 > 191 ? 191 : i0); i1 = i1 < 0 ? 0 : (i1 > 191 ? 191 : i1);
                        p0[r] += xtra[i0]; p1[r] += xtra[i1]; } }
            }
            float mx = max3f(p0[0], p0[1], p1[0]), mx2 = max3f(p0[2], p0[3], p1[1]);
            mx = max3f(mx, p1[2], p1[3]);
#pragma unroll
            for (int r = 4; r < 16; r += 4) { mx = max3f(mx, p0[r], p0[r + 1]); mx2 = max3f(mx2, p0[r + 2], p0[r + 3]); mx = max3f(mx, p1[r], p1[r + 1]); mx2 = max3f(mx2, p1[r + 2], p1[r + 3]); }
            mx = max3f(mx, mx2, mx2);
            mx = max3f(mx, mx, lane_xor(mx, lane, 32));
            const bool dead = (MODE == 1) && !first && __all(mx < -160.0f);
            if (!dead) {
            if (MODE == 1 && !hot) {
#pragma unroll
                for (int ks = 0; ks < KSA; ++ks)
#pragma unroll
                    for (int d = 0; d < NV; ++d) { vlo[ks][d] = vtr(vbase + d * 4096 + ks * 1024); vh4[ks][d] = vtr(vbase + d * 4096 + ks * 1024 + 512); }
                hot = true;
            }
            if (first || __any(mx > 8.0f)) {
                const float dl = first ? mx : fmaxf(mx, 0.f);
                mrun += dl;
#pragma unroll
                for (int r = 0; r < 16; ++r) { p0[r] -= dl; p1[r] -= dl; }
                if (!first) { const float f = __builtin_amdgcn_exp2f(-dl); lrun *= f;
#pragma unroll
                    for (int d = 0; d < NV; ++d)
#pragma unroll
                        for (int r = 0; r < 16; ++r) o[d][r] *= f; }
                first = false;
            }
            float ls = 0.f;
#pragma unroll
            for (int r = 0; r < 16; ++r) { p0[r] = __builtin_amdgcn_exp2f(p0[r]); p1[r] = __builtin_amdgcn_exp2f(p1[r]); ls += p0[r] + p1[r]; }
            lrun += ls;
            u32x4 pw[4];
            pw[0] = (u32x4){pk2(p0[0], p0[1]), pk2(p0[2], p0[3]), pk2(p0[4], p0[5]), pk2(p0[6], p0[7])};
            pw[1] = (u32x4){pk2(p0[8], p0[9]), pk2(p0[10], p0[11]), pk2(p0[12], p0[13]), pk2(p0[14], p0[15])};
            pw[2] = (u32x4){pk2(p1[0], p1[1]), pk2(p1[2], p1[3]), pk2(p1[4], p1[5]), pk2(p1[6], p1[7])};
            pw[3] = (u32x4){pk2(p1[8], p1[9]), pk2(p1[10], p1[11]), pk2(p1[12], p1[13]), pk2(p1[14], p1[15])};
            __builtin_amdgcn_sched_barrier(0);
#pragma unroll
            for (int ks = 0; ks < 4; ++ks) {
                if (KSA < 4 && ks + 1 < 4) {
#pragma unroll
                    for (int d = 0; d < NV; ++d) { vlo[ks + 1][d] = vtr(vbase + d * 4096 + (ks + 1) * 1024); vh4[ks + 1][d] = vtr(vbase + d * 4096 + (ks + 1) * 1024 + 512); }
                    __builtin_amdgcn_sched_barrier(0);
                }
                const bf16x8 pf = __builtin_bit_cast(bf16x8, pw[ks]);
#pragma unroll
                for (int d = 0; d < NV; ++d) {
                    const s16x4 lo = vlo[ks][d], h4 = vh4[ks][d];
                    const bf16x8 vf = (bf16x8){lo[0], lo[1], lo[2], lo[3], h4[0], h4[1], h4[2], h4[3]};
                    o[d] = mfma32(vf, pf, o[d]);
                }
                if (KSA < 4) __builtin_amdgcn_sched_barrier(0);
            }
            } else { hot = false; }
        }
        if (more) LWRITE(cur ^ 1);
        __syncthreads();
        if (DEEP) {
#pragma unroll
            for (int i_ = 0; i_ < KPT; ++i_) kreg[i_] = kreg2[i_];
#pragma unroll
            for (int i_ = 0; i_ < VPT; ++i_) vreg[i_] = vreg2[i_];
            ckreg = ckreg2;
        }
    }
#undef GLOAD
#undef LWRITE
#undef KT
    lrun += lane_xor(lrun, lane, 32);
    const float rl = 1.0f / lrun;
    {
        constexpr int NCH16 = DV / 8, RB = DV * 2;
        LAS unsigned char* stg = lds + 65536 + wid * (32 * RB);
#pragma unroll
        for (int d = 0; d < NV; ++d)
#pragma unroll
            for (int g = 0; g < 4; ++g) { u32x2 w; w.x = pk2(o[d][4 * g] * rl, o[d][4 * g + 1] * rl); w.y = pk2(o[d][4 * g + 2] * rl, o[d][4 * g + 3] * rl);
                const int pi = 8 * d + 2 * g + hi, ch = pi >> 1, sub = pi & 1;
                *(LAS u32x2*)(stg + r32 * RB + ((ch ^ (r32 & (NCH16 - 1))) * 16) + sub * 8) = w; }
        bf16_t* ob = A.O + ((size_t)b * SEQ + q0 + wid * 32) * A.opitch + A.ocol + h * DV;
#pragma unroll
        for (int i = 0; i < (32 * NCH16) / 64; ++i) { const int row = i * (64 / NCH16) + lane / NCH16, ch = lane % NCH16;
            const u32x4 v = *(const LAS u32x4*)(stg + row * RB + ((ch ^ (row & (NCH16 - 1))) * 16));
            *(u32x4*)(ob + (size_t)row * A.opitch + ch * 8) = v; }
    }
    if (MODE != 3) {
        float sq = 0.f;
#pragma unroll
        for (int d = 0; d < NV; ++d)
#pragma unroll
            for (int r = 0; r < 16; ++r) { const float v = o[d][r] * rl; sq += v * v; }
        sq += lane_xor(sq, lane, 32);
        if (hi == 0) A.ssq[qrow * 12 + A.slot0 + h] = sq;
    }
}

__device__ __forceinline__ void phase_final(KArgs a, int wv) {
    const float* g = a->in[20];
    const bf16_t* XB = (const bf16_t*)(a->ws + (((3 * NLAYER) & 1) ? WS_XB2 : WS_XB));
    int tid_l = tid_from(wv); asm volatile("" : "+v"(tid_l));
    const int tid = tid_l, lane = tid & 63, wave = tid >> 6;
    for (int row = blockIdx.x * NWAVES + wave; row < T_TOK; row += gridDim.x * NWAVES) {
        const u32x2* xr = (const u32x2*)(XB + (size_t)row * DMODEL) + lane;
        f32x4 v[4]; float s = 0.f;
#pragma unroll
        for (int j = 0; j < 4; ++j) { const u32x2 w = xr[64 * j]; v[j] = (f32x4){bflo(w.x), bfhi(w.x), bflo(w.y), bfhi(w.y)}; s += (v[j][0] * v[j][0] + v[j][1] * v[j][1]) + (v[j][2] * v[j][2] + v[j][3] * v[j][3]); }
        const float rs = __builtin_amdgcn_rsqf(wave_sum(s, lane) * (1.0f / 1024.0f) + EPS);
        f32x4* orow = (f32x4*)(a->out + (size_t)row * DMODEL) + lane;
#pragma unroll
        for (int j = 0; j < 4; ++j) { const f32x4 gg = ((const f32x4*)g)[64 * j + lane]; orow[64 * j] = v[j] * rs * gg; }
    }
}

constexpr int PH_PER_LAYER = 9, N_PHASES = 1 + NLAYER * PH_PER_LAYER + 1;
__global__ void __launch_bounds__(NTHREADS, 2) fwd_kernel(Args args) {
    extern __shared__ __attribute__((aligned(16))) unsigned char lds_raw[];
    LAS unsigned char* lds = (LAS unsigned char*)lds_raw;
    const int lo = args.ph_lo, hi = args.ph_hi;
#define WSP(off) (wsl + (off))
#define LAUNDER_WS() KArgs ap = (KArgs)__builtin_amdgcn_kernarg_segment_ptr(); asm volatile("" : "+s"(ap)); unsigned char* wsl = ap->ws; \
    bf16_t* XB = (bf16_t*)WSP(WS_XB); bf16_t* XB2 = (bf16_t*)WSP(WS_XB2); (void)XB2; float* RS = (float*)WSP(WS_RS); bf16_t* PROJ = (bf16_t*)WSP(WS_PROJ); bf16_t* CQN = (bf16_t*)WSP(WS_CQN); bf16_t* CKVN = (bf16_t*)WSP(WS_CKVN); \
    bf16_t* QM = (bf16_t*)WSP(WS_QM); bf16_t* KV = (bf16_t*)WSP(WS_KV); bf16_t* Y = (bf16_t*)WSP(WS_Y); bf16_t* HID = (bf16_t*)WSP(WS_HID); \
    bf16_t* KPE = (bf16_t*)WSP(WS_KPE); bf16_t* MEMN = (bf16_t*)WSP(WS_MEMN); bf16_t* QC = QM; bf16_t* OC = KV; \
    const float* CUM = (const float*)WSP(WS_CUM); const float* rope = (const float*)WSP(WS_ROPE); float* SSQ = (float*)WSP(WS_SSQ); (void)SSQ; float* RSQ = (float*)WSP(WS_RSQ); float* RSKV = (float*)WSP(WS_RSKV); float* LF = (float*)WSP(WS_LC); (void)RSQ; (void)RSKV; (void)LF; \
    unsigned char* wl = wsl + WS_W + (size_t)l * W_LAYER; bf16_t* KVMEM = (bf16_t*)WSP(WS_KVMEM) + (size_t)l * 1024 * 1024; \
    (void)XB; (void)RS; (void)PROJ; (void)CQN; (void)CKVN; (void)QM; (void)KV; (void)Y; (void)HID; (void)KPE; (void)MEMN; (void)QC; (void)OC; (void)CUM; (void)rope; (void)wl; (void)KVMEM
    const int G = gridDim.x, bx = blockIdx.x;
    const int vcu = (G % 8 == 0) ? (bx % 8) * (G / 8) + bx / 8 : bx;
    volatile LAS unsigned* bst = (volatile LAS unsigned*)(lds + 131072 + 1024);
    const int wv = __builtin_amdgcn_readfirstlane((int)threadIdx.x >> 6);
    if (threadIdx.x < 4) bst[threadIdx.x] = 0u;
    __syncthreads();
    XcdBarrier gbar; gbar.bar = (unsigned*)(args.ws + WS_BAR); gbar.x = 0; gbar.st = bst; gbar.wv = wv;
    if (hi - lo > 1) gbar = xcd_barrier_post((unsigned*)(args.ws + WS_BAR), bst, wv);
    if (lo > 100000) cg::this_grid().sync();
    for (int p = lo; p < hi; ++p) {
        if (p == 0) { KArgs ap = (KArgs)__builtin_amdgcn_kernarg_segment_ptr(); asm volatile("" : "+s"(ap)); phase_prologue(ap, lds, wv, 0); }
        else if (p == N_PHASES - 1) { KArgs ap = (KArgs)__builtin_amdgcn_kernarg_segment_ptr(); asm volatile("" : "+s"(ap)); phase_final(ap, wv); }
        else {
        const int l = (p - 1) / PH_PER_LAYER, kph = (p - 1) - l * PH_PER_LAYER;
        LAUNDER_WS();
        switch (kph) {
        case 0: {
            pg8::Gemm g{((3 * l) & 1) ? XB2 : XB, (const bf16_t*)(wl + WO_IN), T_TOK, PROJ_W, 1024}; pg8::StaticOrder S; S.init(T_TOK, PROJ_W, G, bx);
            pg8::EpiWin E{PROJ, RS, RSQ, RSKV, KPE, LF, rope, ap->in[8] + l * 4};
            pg8::gemm_phase<pg8::EpiWin, pg8::StaticOrder, true, true>(lds, g, S, E, wv);
            if (l == 0) phase_prologue(ap, lds, wv, 1);
        }
        break;
        case 1: {
            { pg8::Gemm g{PROJ, (const bf16_t*)(wl + WO_UQ), T_TOK, 1280, 384, PROJ_W}; pg8::QkvOrder S; S.init(T_TOK, 1280, G, bx);
              pg8::EpiSplitQKV E{QM, KV, RSQ, RSKV};
              pg8::gemm_phase<pg8::EpiSplitQKV, pg8::QkvOrder, true, true>(lds, g, S, E, wv); }
            { pg8::Gemm g{MEMN, (const bf16_t*)(wl + WO_CKV), 1024, 1024, 1024}; pg8::StaticOrder S; S.init(1024, 1024, G, (bx + G - (128 % G)) % G);
              pg8::EpiScaleBf16<false> E{KVMEM, 1024, nullptr};
              pg8::gemm_phase<pg8::EpiScaleBf16<false>, pg8::StaticOrder, true, true>(lds, g, S, E, wv); }
            phase_cum(ap, lds, wv);
        }
        break;
        case 2: {
            { AttnT A{QM, 512, 0, KV, 768, 0, KPE, KV, 768, 256, Y, 1024, 0, nullptr, nullptr, rope, SSQ, 0};
              for (int u = vcu; u < 256; u += G) { const int bh = u >> 4, s = u & 15;
                  for (int hf = 0; hf < 2; ++hf) attn_unit<96, 128, 0>(lds, A, bh >> 2, bh & 3, hf ? s : 31 - s, wv); } }
            { AttnT A{PROJ, PROJ_W, 512, PROJ, PROJ_W, 768, nullptr, PROJ, PROJ_W, 1024, Y, 1024, 512, CUM, nullptr, nullptr, SSQ, 4};
              for (int u = vcu; u < 256; u += G) { const int bh = u >> 4, s = u & 15;
                  for (int hf = 0; hf < 2; ++hf) attn_unit<64, 64, 1>(lds, A, bh >> 2, bh & 3, hf ? s : 31 - s, wv); } }
            { AttnT A{PROJ, PROJ_W, 1280, PROJ, PROJ_W, 1536, nullptr, PROJ, PROJ_W, 1792, Y, 1024, 768, nullptr, ap->in[9] + l * 4 * 192, nullptr, SSQ, 8};
              for (int u = vcu; u < 512; u += G) { const int bh = (u >> 4) & 15, qb = (u & 15) + 16 * (u >> 8); attn_unit<64, 64, 2>(lds, A, bh >> 2, bh & 3, qb, wv); } }
        }
        break;
        case 3: {
            pg8::Gemm g{Y, (const bf16_t*)(wl + WO_O), T_TOK, 1024, 1024}; pg8::StaticOrder S; S.init(T_TOK, 1024, G, bx);
            pg8::EpiResidualY E{((3 * l) & 1) ? XB2 : XB, ((3 * l + 1) & 1) ? XB2 : XB, RS, SSQ};
            pg8::gemm_phase<pg8::EpiResidualY, pg8::StaticOrder, true, true>(lds, g, S, E, wv);
        }
        break;
        case 4: {
            pg8::Gemm g{((3 * l + 1) & 1) ? XB2 : XB, (const bf16_t*)(wl + WO_CQ), T_TOK, 512, 1024}; pg8::StaticOrder S; S.init(T_TOK, 512, G, bx);
            pg8::EpiScaleBf16<true> E{QC, 512, RS};
            pg8::gemm_phase<pg8::EpiScaleBf16<true>, pg8::StaticOrder, true, true>(lds, g, S, E, wv);
        }
        break;
        case 5: {
            AttnT A{QC, 512, 0, KVMEM, 1024, 0, nullptr, KVMEM, 1024, 512, OC, 512, 0, nullptr, nullptr, nullptr, nullptr, 0};
            for (int u = vcu; u < 512; u += G) { const int bh = (u >> 4) & 15, qb = (u & 15) + 16 * (u >> 8); attn_unit<128, 128, 3>(lds, A, bh >> 2, bh & 3, qb, wv); }
        }
        break;
        case 6: {
            pg8::Gemm g{OC, (const bf16_t*)(wl + WO_CO), T_TOK, 1024, 512}; pg8::StaticOrder S; S.init(T_TOK, 1024, G, bx);
            pg8::EpiResidual E{((3 * l + 1) & 1) ? XB2 : XB, ((3 * l + 2) & 1) ? XB2 : XB, RS, true};
            pg8::gemm_phase<pg8::EpiResidual, pg8::StaticOrder, true, true>(lds, g, S, E, wv);
        }
        break;
        case 7: {
            pg8::Gemm g{((3 * l + 2) & 1) ? XB2 : XB, (const bf16_t*)(wl + WO_GU), T_TOK, 2 * FFN_H, 1024}; pg8::StaticOrder S; S.init(T_TOK, 2 * FFN_H, G, bx);
            pg8::EpiSwiGLU E{HID, RS};
            pg8::gemm_phase<pg8::EpiSwiGLU, pg8::StaticOrder, true, true>(lds, g, S, E, wv);
        }
        break;
        case 8: {
            pg8::Gemm g{HID, (const bf16_t*)(wl + WO_DOWN), T_TOK, 1024, FFN_H}; pg8::StaticOrder S; S.init(T_TOK, 1024, G, bx);
            pg8::EpiResidual E{((3 * l + 2) & 1) ? XB2 : XB, ((3 * l + 3) & 1) ? XB2 : XB, RS, l + 1 < NLAYER};
            pg8::gemm_phase<pg8::EpiResidual, pg8::StaticOrder, true, true>(lds, g, S, E, wv);
        }
        break;

        default: break;
        }
        }
        if (p + 1 < hi) xcd_barrier(gbar);
    }
}

extern "C" void kernel_launch(void* const* d_in, const int* in_sizes, int n_in, void* d_out, int out_size, void* d_ws, size_t ws_size, hipStream_t stream) {
    static int grid = 0;
    if (grid == 0) {
        if (n_in != 21 || out_size != T_TOK * DMODEL || ws_size < WS_END) { fprintf(stderr, "kernel_launch: unexpected shapes (n_in %d, out %d, ws %zu)\n", n_in, out_size, ws_size); grid = -1; return; }
        int dev = 0, cus = 0, per_cu = 0;
        (void)hipGetDevice(&dev); (void)hipDeviceGetAttribute(&cus, hipDeviceAttributeMultiprocessorCount, dev);
        if (hipFuncSetAttribute((const void*)fwd_kernel, hipFuncAttributeMaxDynamicSharedMemorySize, LDS_BYTES) != hipSuccess) { fprintf(stderr, "kernel_launch: hipFuncSetAttribute failed\n"); grid = -1; return; }
        if (hipOccupancyMaxActiveBlocksPerMultiprocessor(&per_cu, (const void*)fwd_kernel, NTHREADS, LDS_BYTES) != hipSuccess || per_cu < 1) { fprintf(stderr, "kernel_launch: occupancy query gave %d\n", per_cu); per_cu = 1; }
        (void)hipGetLastError();
        grid = cus * 1;
        if (grid <= 0) grid = 256;
    }
    if (grid < 0) return;
    if (hipMemsetAsync((char*)d_ws + WS_BAR, 0, XCD_BAR_WORDS * 4, stream) != hipSuccess) { fprintf(stderr, "kernel_launch: memset failed\n"); return; }
    Args a{};
    for (int i = 0; i < 21; ++i) a.in[i] = (const float*)d_in[i];
    a.out = (float*)d_out; a.ws = (unsigned char*)d_ws;
#if MK_MULTI
    for (int p = 0; p < N_PHASES; ++p) { a.ph_lo = p; a.ph_hi = p + 1; hipLaunchKernelGGL(fwd_kernel, dim3(grid), dim3(NTHREADS), LDS_BYTES, stream, a); }
#else
    a.ph_lo = 0; a.ph_hi = N_PHASES;
    void* kargs[] = {&a};
    hipError_t e = hipLaunchCooperativeKernel((const void*)fwd_kernel, dim3(grid), dim3(NTHREADS), kargs, LDS_BYTES, stream);
    if (e != hipSuccess) fprintf(stderr, "kernel_launch: cooperative launch failed: %s (grid %d)\n", hipGetErrorString(e), grid);
#endif
}
```

```cpp
#include <hip/hip_runtime.h>
#include <hip/hip_cooperative_groups.h>
#include <cstdio>
#include <cstdint>
namespace cg = cooperative_groups;

#ifndef MK_MULTI
#define MK_MULTI 0
#endif

constexpr int NWAVES = 8, NTHREADS = 512;
constexpr int T_TOK = 32768, SEQ = 8192, NBATCH = 4, DMODEL = 1024, NLAYER = 2, MEMLEN = 256;
constexpr int IN_W = 1956, PROJ_W = 2048, FFN_H = 2816;
constexpr float EPS = 1e-6f, LOG2E = 1.4426950408889634f;
constexpr float SC_MLA = 0.10206207261596575f * 1.4426950408889634f;
constexpr float SC_64 = 0.125f * 1.4426950408889634f;
constexpr float SC_CROSS = 0.08838834764831845f * 1.4426950408889634f;

#define LAS __attribute__((address_space(3)))
typedef unsigned short bf16_t;
typedef float f32x4 __attribute__((ext_vector_type(4)));
typedef float f32x16 __attribute__((ext_vector_type(16)));
typedef short bf16x8 __attribute__((ext_vector_type(8)));
typedef short s16x4 __attribute__((ext_vector_type(4)));
typedef unsigned u32x4 __attribute__((ext_vector_type(4)));
typedef unsigned u32x2 __attribute__((ext_vector_type(2)));
typedef float f32x2_t __attribute__((ext_vector_type(2)));
typedef __bf16 bf16x2_t __attribute__((ext_vector_type(2)));

__device__ __forceinline__ unsigned pk2(float lo, float hi) { f32x2_t v = {lo, hi}; bf16x2_t b = __builtin_convertvector(v, bf16x2_t); return __builtin_bit_cast(unsigned, b); }
__device__ __forceinline__ float bflo(unsigned u) { return __uint_as_float(u << 16); }
__device__ __forceinline__ float bfhi(unsigned u) { return __uint_as_float(u & 0xffff0000u); }
__device__ __forceinline__ float bf2f(bf16_t h) { return __uint_as_float(((unsigned)h) << 16); }
__device__ __forceinline__ float lane_xor(float v, int lane, int m) { return __int_as_float(__builtin_amdgcn_ds_bpermute((lane ^ m) << 2, __float_as_int(v))); }
__device__ __forceinline__ float wave_sum(float v, int lane) {
#pragma unroll
    for (int o = 1; o < 64; o <<= 1) v += lane_xor(v, lane, o);
    return v;
}
__device__ __forceinline__ int lane_now() { int l; asm volatile("v_mbcnt_lo_u32_b32 %0, -1, 0\n\tv_mbcnt_hi_u32_b32 %0, -1, %0" : "=&v"(l)); return l; }
__device__ __forceinline__ int tid_from(int wv) { return wv * 64 + lane_now(); }

#define XB_TMO      128
#define XB_XCNT(j)  (256  + 64 * (j))
#define XB_XSUB(j)  (1280 + 64 * (j))
#define XB_XGEN(j)  (2304 + 64 * (j))
#define XB_TOP      3328
#define XB_TOPGEN   3392
#define XCD_BAR_WORDS 3456
#define XB_SPIN_CAP (1u << 18)


__device__ __forceinline__ unsigned xb_ld(unsigned* p)              { return __hip_atomic_load(p, __ATOMIC_RELAXED, __HIP_MEMORY_SCOPE_AGENT); }
__device__ __forceinline__ unsigned xb_add(unsigned* p, unsigned v) { return __hip_atomic_fetch_add(p, v, __ATOMIC_RELAXED, __HIP_MEMORY_SCOPE_AGENT); }
__device__ __forceinline__ unsigned xb_xcc_id() { return (unsigned)__builtin_amdgcn_s_getreg((3 << 11) | 20) & 0xFu; }
#define XB_SPIN(cond, bar) do { unsigned _sp = 0; while (cond) { __builtin_amdgcn_s_sleep(1); \
    if ((++_sp & 255u) == 0u) { if (xb_ld(&(bar)[XB_TMO])) break; if (_sp > XB_SPIN_CAP) { atomicAdd(&(bar)[XB_TMO], 1u); break; } } } } while (0)

struct XcdBarrier {
    unsigned* bar; unsigned x;
    volatile LAS unsigned* st; int wv;
};

__device__ __forceinline__ XcdBarrier xcd_barrier_post(unsigned* bar, volatile LAS unsigned* st, int wv) {
    XcdBarrier b; b.bar = bar; b.x = xb_xcc_id(); b.st = st; b.wv = wv;
    if (tid_from(wv) == 0) (void)xb_add(&bar[XB_XCNT(b.x)], 1u);
    return b;
}
__device__ __forceinline__ void xcd_barrier_complete(unsigned* bar, unsigned x, unsigned& nloc, unsigned& nx) {
    const unsigned G = gridDim.x * gridDim.y * gridDim.z;
    unsigned sum, cnt, mine, sp = 0u;
    for (;;) {
        sum = 0u; cnt = 0u; mine = 0u;
#pragma unroll
        for (unsigned j = 0; j < 16; ++j) { const unsigned c = xb_ld(&bar[XB_XCNT(j)]); sum += c; cnt += (c > 0u) ? 1u : 0u; mine = (j == x) ? c : mine; }
        if (sum == G) break;
        __builtin_amdgcn_s_sleep(1);
        if ((++sp & 255u) == 0u) { if (xb_ld(&bar[XB_TMO])) break; if (sp > XB_SPIN_CAP) { atomicAdd(&bar[XB_TMO], 1u); break; } }
    }
    nloc = mine > 0u ? mine : 1u; nx = cnt > 0u ? cnt : 1u;
}

__device__ __forceinline__ void xcd_barrier(const XcdBarrier& b) {
    asm volatile("s_waitcnt vmcnt(0)" ::: "memory");
    __syncthreads();
    if (tid_from(b.wv) == 0) {
        unsigned* bar = b.bar;
        __builtin_amdgcn_s_waitcnt(0);
        unsigned nloc = b.st[0], nx = b.st[1];
        if (nloc == 0u) { xcd_barrier_complete(bar, b.x, nloc, nx); b.st[0] = nloc; b.st[1] = nx; }
        const unsigned old = xb_add(&bar[XB_XSUB(b.x)], 1u);
        const unsigned gen = old / nloc;
        if (old + 1u == (gen + 1u) * nloc) {
            __builtin_amdgcn_fence(__ATOMIC_RELEASE, "agent");
            asm volatile("s_waitcnt vmcnt(0)" ::: "memory");
            const unsigned og = xb_add(&bar[XB_TOP], 1u);
            const unsigned tg = og / nx;
            if (og + 1u == (tg + 1u) * nx) xb_add(&bar[XB_TOPGEN], 1u);
            else XB_SPIN(xb_ld(&bar[XB_TOPGEN]) == tg, bar);
            __builtin_amdgcn_fence(__ATOMIC_ACQUIRE, "agent");
            xb_add(&bar[XB_XGEN(b.x)], 1u);
            asm volatile("s_waitcnt vmcnt(0)" ::: "memory");
        } else {
            XB_SPIN(xb_ld(&bar[XB_XGEN(b.x)]) == gen, bar);
            __builtin_amdgcn_fence(__ATOMIC_ACQUIRE, "agent");
            asm volatile("s_waitcnt vmcnt(0)" ::: "memory");
        }
    }
    __syncthreads();
}

namespace pg8 {
#define PG8_LAS __attribute__((address_space(3)))
typedef unsigned short bf16_t;
typedef short bf16x8 __attribute__((ext_vector_type(8)));
typedef float f32x4 __attribute__((ext_vector_type(4)));
typedef unsigned u32x4 __attribute__((ext_vector_type(4)));
constexpr int BM = 256, BK = 64, HALF = 128, HTB = HALF * BK * 2  , STAGE_BYTES = 8 * HTB, NXCD = 8, WGM = 8;

__host__ __device__ __forceinline__ int lds_byte(int r, int c) { const int st = (r >> 4) * 2 + (c >> 5), rr = r & 15, cc = c & 31, ob = rr * 64 + cc * 2; return st * 1024 + (ob ^ (((ob >> 9) & 1) << 5)); }
__host__ __device__ __forceinline__ void stage_rc(int b, int& R, int& C) { const int st = b / 1024, sb = b % 1024, swz = sb ^ (((sb >> 9) & 1) << 5); R = (st >> 1) * 16 + swz / 64; C = (st & 1) * 32 + (swz % 64) / 2; }
__host__ __device__ __forceinline__ int perm32(int rho) { const int n = rho >> 4, i = rho & 15; return 8 * (i >> 2) + 4 * n + (i & 3); }

struct Unit { int pm, pn; };
struct Gemm { const bf16_t* A; const bf16_t* Bt; int M, N, K; int lda; };

struct StaticOrder {
    int nM, nN, nwg, G, c;
    __host__ __device__ void init(int M, int N, int G_, int c_) { nM = M / BM; nN = N / BM; nwg = nM * nN; G = G_; c = c_; }
    __host__ __device__ bool next(int i, Unit& u) const {
        const long L = (long)i * G + c; if (L >= nwg) return false;
        int wgid = (int)L; { const int q = nwg / NXCD, r = nwg % NXCD, xcd = wgid % NXCD, off = wgid / NXCD; wgid = (xcd < r ? xcd * (q + 1) : r * (q + 1) + (xcd - r) * q) + off; }
        const int nig = WGM * nN, gid = wgid / nig, fm = gid * WGM, gsz = (nM - fm) < WGM ? (nM - fm) : WGM;
        u.pm = fm + ((wgid % nig) % gsz); u.pn = (wgid % nig) / gsz; return true;
    }
    __device__ __forceinline__ void a_ready(const Unit&) const {}
    __device__ __forceinline__ void done(const Unit&) const {}
    __device__ __forceinline__ void krange(const Unit&, int nt, int& kt0, int& nkt) const { kt0 = 0; nkt = nt; }
};
struct QkvOrder : StaticOrder {
    __device__ __forceinline__ void krange(const Unit& u, int, int& kt0, int& nkt) const { if (u.pn < 2) { kt0 = 0; nkt = 4; } else { kt0 = 4; nkt = 2; } }
};

__device__ __forceinline__ float row_rstd(const float* RS, int row) {
    const f32x4* p = (const f32x4*)(RS + (size_t)row * 16);
    const f32x4 a = p[0], b = p[1], c = p[2], d = p[3];
    const float s = ((a[0] + a[1]) + (a[2] + a[3])) + ((b[0] + b[1]) + (b[2] + b[3])) + ((c[0] + c[1]) + (c[2] + c[3])) + ((d[0] + d[1]) + (d[2] + d[3]));
    return __builtin_amdgcn_rsqf(s * (1.0f / 1024.0f) + 1e-6f);
}
__device__ __forceinline__ void st_bf8(bf16_t* p, f32x4 a, f32x4 c) { u32x4 w; w.x = ::pk2(a[0], a[1]); w.y = ::pk2(a[2], a[3]); w.z = ::pk2(c[0], c[1]); w.w = ::pk2(c[2], c[3]); *(u32x4*)p = w; }
__device__ __forceinline__ void st_bf4(bf16_t* p, f32x4 v) { u32x2 w; w.x = ::pk2(v[0], v[1]); w.y = ::pk2(v[2], v[3]); *(u32x2*)p = w; }

template <bool HAS_RS> struct EpiScaleBf16 {
    static constexpr bool PERM = true, AFTER_DRAIN = false, RESCALE = false;
    bf16_t* O; int ldc; const float* RS;
    __device__ __forceinline__ void operator()(const f32x4 (&acc)[2][2][4][2], const Unit& u, int wr, int wc, int fr, int fq) const {
        { int t2_ = (wr * 4 + wc) * 64 + ::lane_now(); asm volatile("" : "+v"(t2_)); fr = t2_ & 15; fq = (t2_ >> 4) & 3; }
        const int row0 = u.pm * BM + wr * 64 + fr, col0 = u.pn * BM + wc * 32 + 8 * fq;
#pragma unroll
        for (int ai = 0; ai < 2; ++ai)
#pragma unroll
            for (int m = 0; m < 4; ++m) {
                const int row = row0 + ai * HALF + m * 16;
                const float sc = HAS_RS ? row_rstd(RS, row) : 1.0f;
                bf16_t* rowp = O + (size_t)row * ldc;
#pragma unroll
                for (int bj = 0; bj < 2; ++bj) st_bf8(rowp + col0 + bj * HALF, acc[ai][bj][m][0] * sc, acc[ai][bj][m][1] * sc);
            }
    }
};
struct EpiQRope {
    static constexpr bool PERM = false, AFTER_DRAIN = false, RESCALE = false;
    bf16_t* O; int ldc; const float* rope;
    __device__ __forceinline__ void operator()(const f32x4 (&acc)[2][2][4][2], const Unit& u, int wr, int wc, int fr, int fq) const {
        { int t2_ = (wr * 4 + wc) * 64 + ::lane_now(); asm volatile("" : "+v"(t2_)); fr = t2_ & 15; fq = (t2_ >> 4) & 3; }
        const int row0 = u.pm * BM + wr * 64 + fr, col0 = u.pn * BM + wc * 32 + 4 * fq;
#pragma unroll
        for (int ai = 0; ai < 2; ++ai)
#pragma unroll
            for (int m = 0; m < 4; ++m) {
                const int row = row0 + ai * HALF + m * 16, pos = row & (::SEQ - 1);
                bf16_t* rowp = O + (size_t)row * ldc;
#pragma unroll
                for (int bj = 0; bj < 2; ++bj) {
                    const int c = col0 + bj * HALF;
                    if (c >= 384) continue;
                    f32x4 v0 = acc[ai][bj][m][0], v1 = acc[ai][bj][m][1];
                    if (((c >> 5) % 3) == 2) {
                        const f32x4* rp = (const f32x4*)(rope + ((size_t)pos * 16 + 4 * fq) * 2);
                        const f32x4 cs0 = rp[0], cs1 = rp[1];
                        const float co[4] = {cs0[0], cs0[2], cs1[0], cs1[2]}, si[4] = {cs0[1], cs0[3], cs1[1], cs1[3]};
                        f32x4 a, b;
#pragma unroll
                        for (int i = 0; i < 4; ++i) { a[i] = v0[i] * co[i] - v1[i] * si[i]; b[i] = v0[i] * si[i] + v1[i] * co[i]; }
                        v0 = a; v1 = b;
                    }
                    st_bf4(rowp + c, v0); st_bf4(rowp + c + 16, v1);
                }
            }
    }
};
struct EpiResidual {
    static constexpr bool PERM = true, AFTER_DRAIN = false, RESCALE = false;
    const bf16_t* XI; bf16_t* XB; float* RS; bool stats;
    __device__ __forceinline__ void operator()(const f32x4 (&acc)[2][2][4][2], const Unit& u, int wr, int wc, int fr, int fq) const {
        { int t2_ = (wr * 4 + wc) * 64 + ::lane_now(); asm volatile("" : "+v"(t2_)); fr = t2_ & 15; fq = (t2_ >> 4) & 3; }
        const int row0 = u.pm * BM + wr * 64 + fr, col0 = u.pn * BM + wc * 32 + 8 * fq;
#pragma unroll
        for (int ai = 0; ai < 2; ++ai)
#pragma unroll
            for (int m = 0; m < 4; ++m) {
                const int row = row0 + ai * HALF + m * 16;
                const size_t ro = (size_t)row * ::DMODEL;
                float ss = 0.f;
#pragma unroll
                for (int bj = 0; bj < 2; ++bj) {
                    const int c = col0 + bj * HALF;
                    const u32x4 xo = *(const u32x4*)(XI + ro + c);
                    const f32x4 x0 = (f32x4){::bflo(xo.x), ::bfhi(xo.x), ::bflo(xo.y), ::bfhi(xo.y)} + acc[ai][bj][m][0];
                    const f32x4 x1 = (f32x4){::bflo(xo.z), ::bfhi(xo.z), ::bflo(xo.w), ::bfhi(xo.w)} + acc[ai][bj][m][1];
                    st_bf8(XB + ro + c, x0, x1);
                    ss += ((x0[0] * x0[0] + x0[1] * x0[1]) + (x0[2] * x0[2] + x0[3] * x0[3])) + ((x1[0] * x1[0] + x1[1] * x1[1]) + (x1[2] * x1[2] + x1[3] * x1[3]));
                }
                { const int ln_ = fq * 16 + fr; ss += ::lane_xor(ss, ln_, 16); ss += ::lane_xor(ss, ln_, 32); }
                if (stats && fq == 0) RS[(size_t)row * 16 + u.pn * 4 + wc] = ss;
            }
    }
};
struct EpiSwiGLU {
    static constexpr bool PERM = true, AFTER_DRAIN = false, RESCALE = false;
    bf16_t* O; const float* RS;
    __device__ __forceinline__ void operator()(const f32x4 (&acc)[2][2][4][2], const Unit& u, int wr, int wc, int fr, int fq) const {
        { int t2_ = (wr * 4 + wc) * 64 + ::lane_now(); asm volatile("" : "+v"(t2_)); fr = t2_ & 15; fq = (t2_ >> 4) & 3; }
        const int row0 = u.pm * BM + wr * 64 + fr, col0 = u.pn * HALF + wc * 32 + 8 * fq;
#pragma unroll
        for (int ai = 0; ai < 2; ++ai)
#pragma unroll
            for (int m = 0; m < 4; ++m) {
                const int row = row0 + ai * HALF + m * 16;
                const float sc = row_rstd(RS, row);
                bf16_t* rowp = O + (size_t)row * ::FFN_H;
                f32x4 r2[2];
#pragma unroll
                for (int n = 0; n < 2; ++n) {
                    const f32x4 g = acc[ai][0][m][n] * sc, up = acc[ai][1][m][n] * sc;
#pragma unroll
                    for (int i = 0; i < 4; ++i) r2[n][i] = g[i] * __builtin_amdgcn_rcpf(1.0f + __builtin_amdgcn_exp2f(-g[i] * 1.4426950408889634f)) * up[i];
                }
                st_bf8(rowp + col0, r2[0], r2[1]);
            }
    }
};
struct EpiSplitQKV {
    static constexpr bool PERM = true, AFTER_DRAIN = false, RESCALE = false;
    bf16_t* QM; bf16_t* KV; const float* RSQ; const float* RSKV;
    __device__ __forceinline__ void operator()(const f32x4 (&acc)[2][2][4][2], const Unit& u, int wr, int wc, int fr, int fq) const {
        { int t2_ = (wr * 4 + wc) * 64 + ::lane_now(); asm volatile("" : "+v"(t2_)); fr = t2_ & 15; fq = (t2_ >> 4) & 3; }
        const bool isq = u.pn < 2;
        bf16_t* O = isq ? QM : KV; const int ldc = isq ? 512 : 768;
        const int row0 = u.pm * BM + wr * 64 + fr, col0 = (isq ? u.pn : u.pn - 2) * BM + wc * 32 + 8 * fq;
#pragma unroll
        for (int ai = 0; ai < 2; ++ai)
#pragma unroll
            for (int m = 0; m < 4; ++m) {
                const int row = row0 + ai * HALF + m * 16;
                const f32x4 ps = *(const f32x4*)((isq ? RSQ : RSKV) + (size_t)row * 4);
                const float sc = __builtin_amdgcn_rsqf(((ps[0] + ps[1]) + (ps[2] + ps[3])) * (isq ? 1.0f / 256.0f : 1.0f / 128.0f) + 1e-6f);
                bf16_t* rowp = O + (size_t)row * ldc;
#pragma unroll
                for (int bj = 0; bj < 2; ++bj) st_bf8(rowp + col0 + bj * HALF, acc[ai][bj][m][0] * sc, acc[ai][bj][m][1] * sc);
            }
    }
};
struct EpiResidualY {
    static constexpr bool PERM = true, AFTER_DRAIN = false, RESCALE = true;
    const bf16_t* XI; bf16_t* XB; float* RS; const float* SSQ;
    __device__ __forceinline__ static void group_rstd(const float* SSQ, int row, float& ra, float& rb, float& rc) {
        const f32x4* p = (const f32x4*)(SSQ + (size_t)row * 12);
        const f32x4 a = p[0], b = p[1], c = p[2];
        ra = __builtin_amdgcn_rsqf(((a[0] + a[1]) + (a[2] + a[3])) * (1.0f / 512.0f) + 1e-6f);
        rb = __builtin_amdgcn_rsqf(((b[0] + b[1]) + (b[2] + b[3])) * (1.0f / 256.0f) + 1e-6f);
        rc = __builtin_amdgcn_rsqf(((c[0] + c[1]) + (c[2] + c[3])) * (1.0f / 256.0f) + 1e-6f);
    }
    __device__ __forceinline__ void rescale(f32x4 (&acc)[2][2][4][2], const Unit& u, int t, int wr, int wc) const {
        int fr, fq; { int t2_ = (wr * 4 + wc) * 64 + ::lane_now(); asm volatile("" : "+v"(t2_)); fr = t2_ & 15; fq = (t2_ >> 4) & 3; } (void)fq;
        const int row0 = u.pm * BM + wr * 64 + fr;
#pragma unroll
        for (int ai = 0; ai < 2; ++ai)
#pragma unroll
            for (int m = 0; m < 4; ++m) {
                float ra, rb, rc; group_rstd(SSQ, row0 + ai * HALF + m * 16, ra, rb, rc);
                const float f = (t == 8) ? ra * __builtin_amdgcn_rcpf(rb) : rb * __builtin_amdgcn_rcpf(rc);
#pragma unroll
                for (int bj = 0; bj < 2; ++bj)
#pragma unroll
                    for (int n = 0; n < 2; ++n) acc[ai][bj][m][n] = acc[ai][bj][m][n] * f;
            }
    }
    __device__ __forceinline__ void operator()(const f32x4 (&acc)[2][2][4][2], const Unit& u, int wr, int wc, int fr, int fq) const {
        { int t2_ = (wr * 4 + wc) * 64 + ::lane_now(); asm volatile("" : "+v"(t2_)); fr = t2_ & 15; fq = (t2_ >> 4) & 3; }
        const int row0 = u.pm * BM + wr * 64 + fr, col0 = u.pn * BM + wc * 32 + 8 * fq;
#pragma unroll
        for (int ai = 0; ai < 2; ++ai)
#pragma unroll
            for (int m = 0; m < 4; ++m) {
                const int row = row0 + ai * HALF + m * 16;
                const size_t ro = (size_t)row * ::DMODEL;
                float ra, rb, rc; group_rstd(SSQ, row, ra, rb, rc); (void)ra; (void)rb;
                float ss = 0.f;
#pragma unroll
                for (int bj = 0; bj < 2; ++bj) {
                    const int c = col0 + bj * HALF;
                    const u32x4 xo = *(const u32x4*)(XI + ro + c);
                    const f32x4 x0 = (f32x4){::bflo(xo.x), ::bfhi(xo.x), ::bflo(xo.y), ::bfhi(xo.y)} + acc[ai][bj][m][0] * rc;
                    const f32x4 x1 = (f32x4){::bflo(xo.z), ::bfhi(xo.z), ::bflo(xo.w), ::bfhi(xo.w)} + acc[ai][bj][m][1] * rc;
                    st_bf8(XB + ro + c, x0, x1);
                    ss += ((x0[0] * x0[0] + x0[1] * x0[1]) + (x0[2] * x0[2] + x0[3] * x0[3])) + ((x1[0] * x1[0] + x1[1] * x1[1]) + (x1[2] * x1[2] + x1[3] * x1[3]));
                }
                { const int ln_ = fq * 16 + fr; ss += ::lane_xor(ss, ln_, 16); ss += ::lane_xor(ss, ln_, 32); }
                if (fq == 0) RS[(size_t)row * 16 + u.pn * 4 + wc] = ss;
            }
    }
};
struct EpiWin {
    static constexpr bool PERM = true, AFTER_DRAIN = false, RESCALE = false;
    bf16_t* O; const float* RS; float* RSQ; float* RSKV; bf16_t* KPE; float* LF; const float* rope; const float* fb;
    __device__ __forceinline__ void operator()(const f32x4 (&acc)[2][2][4][2], const Unit& u, int wr, int wc, int fr, int fq) const {
        { int t2_ = (wr * 4 + wc) * 64 + ::lane_now(); asm volatile("" : "+v"(t2_)); fr = t2_ & 15; fq = (t2_ >> 4) & 3; }
        const int row0 = u.pm * BM + wr * 64 + fr, col0 = u.pn * BM + wc * 32 + 8 * fq, ln_ = fq * 16 + fr;
#pragma unroll
        for (int ai = 0; ai < 2; ++ai)
#pragma unroll
            for (int m = 0; m < 4; ++m) {
                const int row = row0 + ai * HALF + m * 16;
                const float sc = row_rstd(RS, row);
                bf16_t* rowp = O + (size_t)row * ::PROJ_W;
                f32x4 v[2][2];
#pragma unroll
                for (int bj = 0; bj < 2; ++bj)
#pragma unroll
                    for (int n = 0; n < 2; ++n) v[bj][n] = acc[ai][bj][m][n] * sc;
#pragma unroll
                for (int bj = 0; bj < 2; ++bj) st_bf8(rowp + col0 + bj * HALF, v[bj][0], v[bj][1]);
                if (u.pn < 2) {
                    float s0 = 0.f, s1 = 0.f;
#pragma unroll
                    for (int n = 0; n < 2; ++n)
#pragma unroll
                        for (int i = 0; i < 4; ++i) { s0 += v[0][n][i] * v[0][n][i]; s1 += v[1][n][i] * v[1][n][i]; }
                    float ss = (u.pn == 0) ? s0 + s1 : s0;
                    ss += ::lane_xor(ss, ln_, 16); ss += ::lane_xor(ss, ln_, 32);
                    if (fq == 0) { if (u.pn == 0) RSQ[(size_t)row * 4 + wc] = ss; else RSKV[(size_t)row * 4 + wc] = ss; }
                    if (u.pn == 1 && wc == 0) {
                        const int pos = row & (::SEQ - 1), jb = 8 * (fq & 1);
                        const f32x4* rp = (const f32x4*)(rope + ((size_t)pos * 16 + jb) * 2);
                        f32x4 o2[2];
#pragma unroll
                        for (int n = 0; n < 2; ++n) { const f32x4 csA = rp[2 * n], csB = rp[2 * n + 1];
                            const float co[4] = {csA[0], csA[2], csB[0], csB[2]}, si[4] = {csA[1], csA[3], csB[1], csB[3]};
#pragma unroll
                            for (int i = 0; i < 4; ++i) { const float mine = v[1][n][i], oth = ::lane_xor(mine, ln_, 32);
                                o2[n][i] = (fq < 2) ? mine * co[i] - oth * si[i] : oth * si[i] + mine * co[i]; } }
                        st_bf8(KPE + (size_t)row * 32 + 8 * fq, o2[0], o2[1]);
                    }
                    if (u.pn == 1 && wc == 1 && fq == 0) {
                        f32x4 lf;
#pragma unroll
                        for (int i = 0; i < 4; ++i) { const float z = v[1][0][i] + fb[i]; lf[i] = -__builtin_amdgcn_logf(1.0f + __builtin_amdgcn_exp2f(-1.4426950408889634f * z)); }
                        *(f32x4*)(LF + (size_t)row * 4) = lf;
                    }
                }
            }
    }
};
template <class Epi, class Sched, bool ALIGN_EPI = false, bool SP2 = false>
__device__ __forceinline__ void gemm_phase(PG8_LAS unsigned char* lds, const Gemm g, const Sched& S, const Epi& E, int wv) {
    int tid_l = ::tid_from(wv); asm volatile("" : "+v"(tid_l));
    const int tid = tid_l, wid = wv, lane = tid & 63, wr = wid >> 2, wc = wid & 3, fr = lane & 15, fq = lane >> 4;
    const int K = g.K, nt = K / BK, lda = g.lda ? g.lda : K;
    unsigned voffA[2], voffB[2];
#pragma unroll
    for (int i = 0; i < 2; ++i) { int R, C; stage_rc(tid * 16 + i * 8192, R, C); const int Rb = Epi::PERM ? ((R & ~31) + perm32(R & 31)) : R;
        voffA[i] = (unsigned)(R * lda + C) * 2u; voffB[i] = (unsigned)(Rb * K + C) * 2u; }
    const size_t kstep = (size_t)(BK * 2);
    const size_t hstep = (size_t)HALF * K * 2;
    const size_t tstep = 2 * hstep;
    const size_t hstepA = (size_t)HALF * lda * 2, tstepA = 2 * hstepA;
    const unsigned ldsw = (unsigned)wid * 1024u;
    const int aoff = lds_byte(wr * 64 + fr, fq * 8), boff = lds_byte(wc * 32 + fr, fq * 8);
#define PG8_SA(b, h) (((b) * 2 + (h)) * HTB)
#define PG8_SB(b, h) ((4 + (b) * 2 + (h)) * HTB)
#define PG8_STAGE(bufoff, gbase, voff) do { _Pragma("unroll") for (int _i = 0; _i < 2; ++_i) \
        __builtin_amdgcn_global_load_lds((const unsigned*)((const char*)(gbase) + (voff)[_i]), (PG8_LAS unsigned*)(lds + (bufoff) + ldsw + _i * 8192), 16, 0, 0); } while (0)
#define PG8_LDA(dst, b, h) do { _Pragma("unroll") for (int m = 0; m < 4; ++m) _Pragma("unroll") for (int k = 0; k < 2; ++k) dst[m][k] = *(const PG8_LAS bf16x8*)(lds + PG8_SA(b, h) + aoff + m * 2048 + k * 1024); } while (0)
#define PG8_LDB(dst, b, h) do { _Pragma("unroll") for (int n = 0; n < 2; ++n) _Pragma("unroll") for (int k = 0; k < 2; ++k) dst[n][k] = *(const PG8_LAS bf16x8*)(lds + PG8_SB(b, h) + boff + n * 2048 + k * 1024); } while (0)
#define PG8_MMA(ai, bj, At, Bt) do { __builtin_amdgcn_s_setprio(1); _Pragma("unroll") for (int m = 0; m < 4; ++m) _Pragma("unroll") for (int n = 0; n < 2; ++n) _Pragma("unroll") for (int k = 0; k < 2; ++k) \
        acc[ai][bj][m][n] = __builtin_amdgcn_mfma_f32_16x16x32_bf16(Bt[n][k], At[m][k], acc[ai][bj][m][n], 0, 0, 0); __builtin_amdgcn_s_setprio(0); } while (0)
#define PG8_WAIT_V(n) asm volatile("s_waitcnt vmcnt(" #n ")" ::: "memory")
#define PG8_WAIT_L(n) asm volatile("s_waitcnt lgkmcnt(" #n ")" ::: "memory")
#define PG8_BAR __builtin_amdgcn_s_barrier()
#define PG8_SCHED __builtin_amdgcn_sched_barrier(0)
    Unit cur, nxt; int ui = 0;
    if (!S.next(0, cur)) return;
    f32x4 acc[2][2][4][2];
#pragma unroll
    for (int a = 0; a < 2; ++a)
#pragma unroll
        for (int b = 0; b < 2; ++b)
#pragma unroll
            for (int m = 0; m < 4; ++m)
#pragma unroll
                for (int n = 0; n < 2; ++n) acc[a][b][m][n] = (f32x4){0.f, 0.f, 0.f, 0.f};
    bf16x8 At[4][2], B0[2][2], B1[2][2];
    int ck0, cnt; S.krange(cur, nt, ck0, cnt);
    const char* cA = (const char*)g.A + (size_t)cur.pm * tstepA + (size_t)ck0 * kstep; const char* cB = (const char*)g.Bt + (size_t)cur.pn * tstep + (size_t)ck0 * kstep;
    S.a_ready(cur);
    if constexpr (SP2) {
        PG8_STAGE(PG8_SB(0, 0), cB, voffB); PG8_STAGE(PG8_SB(0, 1), cB + hstep, voffB); PG8_STAGE(PG8_SA(0, 0), cA, voffA); PG8_STAGE(PG8_SA(0, 1), cA + hstepA, voffA);
        if (wr == 1) PG8_BAR;
        PG8_WAIT_V(2); PG8_BAR;
        PG8_STAGE(PG8_SB(1, 0), cB + kstep, voffB); PG8_STAGE(PG8_SA(1, 0), cA + kstep, voffA); PG8_STAGE(PG8_SB(1, 1), cB + hstep + kstep, voffB);
        PG8_WAIT_V(6); PG8_BAR;
    } else {
        PG8_STAGE(PG8_SB(0, 0), cB, voffB); PG8_STAGE(PG8_SA(0, 0), cA, voffA); PG8_STAGE(PG8_SB(0, 1), cB + hstep, voffB); PG8_STAGE(PG8_SA(0, 1), cA + hstepA, voffA);
        if (wr == 1) PG8_BAR;
        PG8_WAIT_V(4); PG8_BAR;
        PG8_STAGE(PG8_SB(1, 0), cB + kstep, voffB); PG8_STAGE(PG8_SA(1, 0), cA + kstep, voffA); PG8_STAGE(PG8_SB(1, 1), cB + hstep + kstep, voffB);
        PG8_WAIT_V(6); PG8_BAR;
    }
    for (;;) {
        const bool has_next = S.next(ui + 1, nxt);
        int nk0 = 0, nnt = cnt; if (has_next) S.krange(nxt, nt, nk0, nnt);
        const char* nA = has_next ? (const char*)g.A + (size_t)nxt.pm * tstepA + (size_t)nk0 * kstep : cA; const char* nB = has_next ? (const char*)g.Bt + (size_t)nxt.pn * tstep + (size_t)nk0 * kstep : cB;
        for (int t = 0; t < cnt; t += 2) {
            if constexpr (Epi::RESCALE) { if (t == 8 || t == 12) E.rescale(acc, cur, t, wr, wc); }
            const bool last = (t == cnt - 2);
            const char* a1 = cA + (size_t)(t + 1) * kstep;
            const char* a2 = last ? nA : cA + (size_t)(t + 2) * kstep; const char* b2 = last ? nB : cB + (size_t)(t + 2) * kstep;
            const char* a3 = a2 + kstep; const char* b3 = b2 + kstep;
            if (last && has_next) S.a_ready(nxt);
            if constexpr (SP2) {
            PG8_LDB(B0, 0, 0); PG8_LDB(B1, 0, 1); PG8_SCHED; PG8_LDA(At, 0, 0); PG8_STAGE(PG8_SA(1, 1), a1 + hstepA, voffA);
            PG8_WAIT_V(8); PG8_WAIT_L(0); PG8_BAR; PG8_MMA(0, 0, At, B0); PG8_MMA(0, 1, At, B1); PG8_BAR; PG8_SCHED;
            PG8_LDA(At, 0, 1); PG8_STAGE(PG8_SB(0, 0), b2, voffB); PG8_STAGE(PG8_SB(0, 1), b2 + hstep, voffB); PG8_STAGE(PG8_SA(0, 0), a2, voffA);
            PG8_WAIT_V(8); PG8_WAIT_L(0); PG8_BAR; PG8_MMA(1, 0, At, B0); PG8_MMA(1, 1, At, B1); PG8_BAR; PG8_SCHED;
            PG8_LDB(B0, 1, 0); PG8_LDB(B1, 1, 1); PG8_SCHED; PG8_LDA(At, 1, 0); PG8_STAGE(PG8_SA(0, 1), a2 + hstepA, voffA);
            PG8_WAIT_V(8); PG8_WAIT_L(0); PG8_BAR; PG8_MMA(0, 0, At, B0); PG8_MMA(0, 1, At, B1); PG8_BAR; PG8_SCHED;
            PG8_LDA(At, 1, 1); PG8_STAGE(PG8_SB(1, 0), b3, voffB); PG8_STAGE(PG8_SB(1, 1), b3 + hstep, voffB); PG8_STAGE(PG8_SA(1, 0), a3, voffA);
            PG8_WAIT_V(8); PG8_WAIT_L(0); PG8_BAR; PG8_MMA(1, 0, At, B0); PG8_MMA(1, 1, At, B1); PG8_BAR; PG8_SCHED;
            } else {
            PG8_LDB(B0, 0, 0); PG8_SCHED; PG8_LDA(At, 0, 0); PG8_STAGE(PG8_SA(1, 1), a1 + hstepA, voffA);
            PG8_WAIT_L(8); PG8_BAR; PG8_WAIT_L(0); PG8_MMA(0, 0, At, B0); PG8_BAR; PG8_SCHED;
            PG8_LDB(B1, 0, 1); PG8_STAGE(PG8_SB(0, 0), b2, voffB);
            PG8_BAR; PG8_WAIT_L(0); PG8_MMA(0, 1, At, B1); PG8_BAR;
            PG8_LDA(At, 0, 1); PG8_STAGE(PG8_SA(0, 0), a2, voffA);
            PG8_BAR; PG8_WAIT_L(0); PG8_MMA(1, 0, At, B0); PG8_BAR; PG8_SCHED;
            PG8_STAGE(PG8_SB(0, 1), b2 + hstep, voffB);
            PG8_WAIT_V(6); PG8_BAR; PG8_MMA(1, 1, At, B1); PG8_BAR;
            PG8_LDB(B0, 1, 0); PG8_SCHED; PG8_LDA(At, 1, 0); PG8_STAGE(PG8_SA(0, 1), a2 + hstepA, voffA);
            PG8_WAIT_L(8); PG8_BAR; PG8_WAIT_L(0); PG8_MMA(0, 0, At, B0); PG8_BAR; PG8_SCHED;
            PG8_LDB(B1, 1, 1); PG8_STAGE(PG8_SB(1, 0), b3, voffB);
            PG8_BAR; PG8_WAIT_L(0); PG8_MMA(0, 1, At, B1); PG8_BAR;
            PG8_LDA(At, 1, 1); PG8_STAGE(PG8_SA(1, 0), a3, voffA);
            PG8_BAR; PG8_WAIT_L(0); PG8_MMA(1, 0, At, B0); PG8_BAR; PG8_SCHED;
            PG8_STAGE(PG8_SB(1, 1), b3 + hstep, voffB);
            PG8_WAIT_V(6); PG8_BAR; PG8_MMA(1, 1, At, B1); PG8_BAR;
            }
        }
        if constexpr (ALIGN_EPI) { if (wr == 0) PG8_BAR; }
        if constexpr (!Epi::AFTER_DRAIN) { E(acc, cur, wr, wc, fr, fq); S.done(cur); }
        if (!has_next) break;
#pragma unroll
        for (int a = 0; a < 2; ++a)
#pragma unroll
            for (int b = 0; b < 2; ++b)
#pragma unroll
                for (int m = 0; m < 4; ++m)
#pragma unroll
                    for (int n = 0; n < 2; ++n) acc[a][b][m][n] = (f32x4){0.f, 0.f, 0.f, 0.f};
        cur = nxt; cA = nA; cB = nB; cnt = nnt; ++ui;
        if constexpr (ALIGN_EPI) { if (wr == 1) PG8_BAR; }
    }
    PG8_WAIT_V(0);
    if constexpr (!ALIGN_EPI) { if (wr == 0) PG8_BAR; }
    PG8_BAR;
    if constexpr (Epi::AFTER_DRAIN) { E.fused(acc, cur, wr, wc, fr, fq, lds, wid, lane); S.done(cur); }
#undef PG8_SA
#undef PG8_SB
#undef PG8_STAGE
#undef PG8_LDA
#undef PG8_LDB
#undef PG8_MMA
#undef PG8_WAIT_V
#undef PG8_WAIT_L
#undef PG8_BAR
#undef PG8_SCHED
}
}
constexpr size_t MiB = 1u << 20;
constexpr size_t WS_W = 0, W_LAYER = 28 * MiB;
constexpr size_t WO_IN = 0, WO_UQ = 4 * MiB, WO_UKV = 4 * MiB + 512 * 1024, WO_O = 5 * MiB, WO_CQ = 7 * MiB, WO_CKV = 8 * MiB, WO_CO = 10 * MiB, WO_GU = 11 * MiB, WO_DOWN = 22 * MiB;
constexpr size_t WS_XB = 56 * MiB;
constexpr size_t WS_RS = 120 * MiB;
constexpr size_t WS_KPE = 122 * MiB;
constexpr size_t WS_LC = 124 * MiB;
constexpr size_t WS_CUM = 124 * MiB + 512 * 1024;
constexpr size_t WS_TOT = 125 * MiB;
constexpr size_t WS_ROPE = 125 * MiB + 512 * 1024;
constexpr size_t WS_MEMN = 127 * MiB;
constexpr size_t WS_KVMEM = 129 * MiB;
constexpr size_t WS_PROJ = 134 * MiB;
constexpr size_t WS_CQN = 262 * MiB;
constexpr size_t WS_CKVN = 278 * MiB;
constexpr size_t WS_QM = 294 * MiB;
constexpr size_t WS_HID = 134 * MiB;
constexpr size_t WS_KV = 326 * MiB;
constexpr size_t WS_Y = 374 * MiB;
constexpr size_t WS_SSQ = 438 * MiB;
constexpr size_t WS_RSQ = 440 * MiB;
constexpr size_t WS_RSKV = 440 * MiB + 512 * 1024;
constexpr size_t WS_BAR = 441 * MiB;
constexpr size_t WS_XB2 = 442 * MiB;
constexpr size_t WS_END = 506 * MiB;

constexpr int LDS_BYTES = 131072 + 4096;

struct Args { const float* in[21]; float* out; unsigned char* ws; int ph_lo, ph_hi; };
typedef const __attribute__((address_space(4))) Args* KArgs;

__device__ __forceinline__ int conv_map(int type, int n, float& sc) {
    sc = 1.0f;
    switch (type) {
    case 0:
        if (n < 416) return n;
        if (n < 420) return 1184 + (n - 416);
        if (n < 512) return -1;
        if (n < 1280) { if (n < 768) sc = SC_64; return 416 + (n - 512); }
        if (n < 1536) sc = SC_64;
        return 1188 + (n - 1280);
    case 1: sc = SC_MLA; return n < 384 ? n : -1;
    case 2: if (n < 256) return (n >> 6) * 192 + (n & 63); else { const int mm = n - 256; return (mm >> 7) * 192 + 64 + (mm & 127); }
    case 4: sc = SC_CROSS; return n;
    case 7: { const int t = n >> 8, c = n & 255; return c < 128 ? 128 * t + c : FFN_H + 128 * t + (c - 128); }
    default: return n;
    }
}
__device__ __forceinline__ void conv_tile(const float* src, const float* gain, bf16_t* dst, int K, int Nsrc, int Nd, int Kd, int type, int tile, LAS float* scr, int wv, int koff = 0) {
    int tid_l = tid_from(wv); asm volatile("" : "+v"(tid_l));
    const int tid = tid_l, ntn = Nd >> 8, kb = tile / ntn, nb = tile - kb * ntn, k0 = kb * 64, n0 = nb * 256;
    { const int nn = tid & 255, kh = tid >> 8; float sc; const int sn = conv_map(type, n0 + nn, sc);
      const float* sp = src + (size_t)(k0 + kh - koff) * Nsrc + (sn >= 0 ? sn : 0);
#pragma unroll 8
      for (int i = 0; i < 32; ++i) { const int kk = kh + 2 * i, k = k0 + kk; float v = 0.f;
          if (sn >= 0 && k >= koff && k - koff < K) { v = __builtin_nontemporal_load(sp + (size_t)(2 * i) * Nsrc) * sc; if (gain) v *= gain[k - koff]; }
          scr[nn * 65 + kk] = v; } }
    __syncthreads();
#pragma unroll
    for (int j = 0; j < 4; ++j) { const int idx = tid + 512 * j, nn = idx >> 3, kq = (idx & 7) * 8; const LAS float* s = scr + nn * 65 + kq;
      u32x4 o; o.x = pk2(s[0], s[1]); o.y = pk2(s[2], s[3]); o.z = pk2(s[4], s[5]); o.w = pk2(s[6], s[7]);
      *(u32x4*)(dst + (size_t)(n0 + nn) * Kd + k0 + kq) = o; }
    __syncthreads();
}
__device__ __forceinline__ void phase_prologue(KArgs a, LAS unsigned char* lds, int wv, int part) {
    LAS float* scr = (LAS float*)lds;
    unsigned char* ws = a->ws;
    int tid_l = tid_from(wv); asm volatile("" : "+v"(tid_l));
    const int tid = tid_l, lane = tid & 63, wave = tid >> 6;
    constexpr int NT_L = 128 + 12 + 18 + 64 + 32 + 64 + 32 + 352 + 176;
    const int g_lo = part == 0 ? 0 : 128, g_hi = part == 0 ? 128 : NLAYER * NT_L;
    for (int g = g_lo + blockIdx.x; g < g_hi; g += gridDim.x) {
        const int l = g / NT_L; int r = g - l * NT_L;
        bf16_t* wb = (bf16_t*)(ws + WS_W + (size_t)l * W_LAYER);
        if (r < 128) { conv_tile(a->in[3] + (size_t)l * 1024 * IN_W, a->in[2] + l * 1024, (bf16_t*)((unsigned char*)wb + WO_IN), 1024, IN_W, 2048, 1024, 0, r, scr, wv); continue; } r -= 128;
        if (r < 12) { conv_tile(a->in[5] + (size_t)l * 256 * 384, a->in[4] + l * 256, (bf16_t*)((unsigned char*)wb + WO_UQ), 256, 384, 512, 384, 1, r, scr, wv); continue; } r -= 12;
        if (r < 18) { conv_tile(a->in[7] + (size_t)l * 128 * 768, a->in[6] + l * 128, (bf16_t*)((unsigned char*)wb + WO_UQ) + (size_t)512 * 384, 128, 768, 768, 384, 2, r, scr, wv, 256); continue; } r -= 18;
        if (r < 64) { conv_tile(a->in[11] + (size_t)l * 1024 * 1024, a->in[10] + l * 1024, (bf16_t*)((unsigned char*)wb + WO_O), 1024, 1024, 1024, 1024, 3, r, scr, wv); continue; } r -= 64;
        if (r < 32) { conv_tile(a->in[14] + (size_t)l * 1024 * 512, a->in[12] + l * 1024, (bf16_t*)((unsigned char*)wb + WO_CQ), 1024, 512, 512, 1024, 4, r, scr, wv); continue; } r -= 32;
        if (r < 64) { conv_tile(a->in[15] + (size_t)l * 1024 * 1024, a->in[13] + l * 1024, (bf16_t*)((unsigned char*)wb + WO_CKV), 1024, 1024, 1024, 1024, 5, r, scr, wv); continue; } r -= 64;
        if (r < 32) { conv_tile(a->in[16] + (size_t)l * 512 * 1024, nullptr, (bf16_t*)((unsigned char*)wb + WO_CO), 512, 1024, 1024, 512, 6, r, scr, wv); continue; } r -= 32;
        if (r < 352) { conv_tile(a->in[18] + (size_t)l * 1024 * 2 * FFN_H, a->in[17] + l * 1024, (bf16_t*)((unsigned char*)wb + WO_GU), 1024, 2 * FFN_H, 2 * FFN_H, 1024, 7, r, scr, wv); continue; } r -= 352;
        conv_tile(a->in[19] + (size_t)l * FFN_H * 1024, nullptr, (bf16_t*)((unsigned char*)wb + WO_DOWN), FFN_H, 1024, 1024, FFN_H, 8, r, scr, wv);
    }
    if (part != 0) return;
    const int gw = blockIdx.x * NWAVES + wave, ngw = gridDim.x * NWAVES;
    bf16_t* XB = (bf16_t*)(ws + WS_XB); float* RS = (float*)(ws + WS_RS); bf16_t* MEMN = (bf16_t*)(ws + WS_MEMN);
    for (int row = gw; row < T_TOK + NBATCH * MEMLEN; row += ngw) {
        const bool ismem = row >= T_TOK; const int rr = ismem ? row - T_TOK : row;
        const f32x4* xr = (const f32x4*)((ismem ? a->in[1] : a->in[0]) + (size_t)rr * DMODEL) + lane;
        f32x4 v[4]; float s = 0.f;
#pragma unroll
        for (int j = 0; j < 4; ++j) { v[j] = __builtin_nontemporal_load(xr + 64 * j); s += (v[j][0] * v[j][0] + v[j][1] * v[j][1]) + (v[j][2] * v[j][2] + v[j][3] * v[j][3]); }
        s = wave_sum(s, lane);
        float sc = 1.0f;
        if (ismem) sc = __builtin_amdgcn_rsqf(s * (1.0f / 1024.0f) + EPS);
        else if (lane < 16) RS[(size_t)rr * 16 + lane] = lane == 0 ? s : 0.f;
        u32x2* o8 = (u32x2*)((ismem ? MEMN : XB) + (size_t)rr * DMODEL) + lane;
#pragma unroll
        for (int j = 0; j < 4; ++j) { u32x2 w; w.x = pk2(v[j][0] * sc, v[j][1] * sc); w.y = pk2(v[j][2] * sc, v[j][3] * sc); o8[64 * j] = w; }
    }
    float* rope = (float*)(ws + WS_ROPE);
    for (int i = blockIdx.x * NTHREADS + tid; i < SEQ * 16; i += gridDim.x * NTHREADS) {
        const int pos = i >> 4, j = i & 15;
        const float inv = powf(10000.0f, -(float)(2 * j) / 32.0f), ang = (float)pos * inv;
        rope[2 * i] = cosf(ang); rope[2 * i + 1] = sinf(ang);
    }
}

__device__ __forceinline__ void phase_cum(KArgs a, LAS unsigned char* lds, int wv) {
    unsigned char* ws = a->ws;
    const float* LF = (const float*)(ws + WS_LC); float* CUM = (float*)(ws + WS_CUM);
    LAS float* sc = (LAS float*)lds;
    LAS float* lc = (LAS float*)(lds + 2048);
    int tid_l = tid_from(wv); asm volatile("" : "+v"(tid_l));
    const int tid = tid_l, lane = tid & 63, wave = tid >> 6;
    const int gsz = (int)gridDim.x, half = gsz >= 256 ? gsz / 2 : 0;
    if ((int)blockIdx.x < half) return;
    for (int c = (int)blockIdx.x - half; c < T_TOK / 64; c += gsz - half) {
        const int b = c >> 7, ci = c & 127, n0 = ci * 64;
        { const f32x4* base = (const f32x4*)(LF + (size_t)b * SEQ * 4);
          f32x4 acc = (f32x4){0.f, 0.f, 0.f, 0.f};
          for (int t = tid; t < n0; t += NTHREADS) acc += base[t];
#pragma unroll
          for (int k = 0; k < 4; ++k) acc[k] = wave_sum(acc[k], lane);
          if (lane == 0) *(LAS f32x4*)(sc + wave * 4) = acc;
          if (tid < 256) lc[tid] = LF[((size_t)c * 64) * 4 + tid]; }
        __syncthreads();
        float v = 0.f;
        if (tid < 256) {
            v = lc[tid];
#pragma unroll
            for (int d = 4; d < 64; d <<= 1) { const float t = __int_as_float(__builtin_amdgcn_ds_bpermute(((lane - d) & 63) << 2, __float_as_int(v))); if (lane >= d) v += t; }
            if (lane >= 60) sc[32 + wave * 4 + (tid & 3)] = v;
        }
        __syncthreads();
        if (tid < 256) {
            const int h = tid & 3, i = tid >> 2; float p = v;
#pragma unroll
            for (int w = 0; w < NWAVES; ++w) p += sc[w * 4 + h];
            for (int w = 0; w < wave; ++w) p += sc[32 + w * 4 + h];
            CUM[(size_t)(c * 64 + i) * 4 + h] = p;
        }
        __syncthreads();
    }
}

__device__ __forceinline__ f32x16 mfma32(bf16x8 a, bf16x8 b, f32x16 c) { return __builtin_amdgcn_mfma_f32_32x32x16_bf16(a, b, c, 0, 0, 0); }
typedef short v4i16_t __attribute__((ext_vector_type(4)));
__device__ __forceinline__ float max3f(float a, float b, float c) { float r; asm("v_max3_f32 %0, %1, %2, %3" : "=v"(r) : "v"(a), "v"(b), "v"(c)); return r; }
__device__ __forceinline__ s16x4 vtr(const LAS unsigned char* p) { return __builtin_bit_cast(s16x4, __builtin_amdgcn_ds_read_tr16_b64_v4i16((LAS v4i16_t*)p)); }

struct AttnT {
    const bf16_t* Q; int qpitch, qcol;
    const bf16_t* K; int kpitch, kcol;
    const bf16_t* K2;
    const bf16_t* V; int vpitch, vcol;
    bf16_t* O; int opitch, ocol;
    const float* cum;
    const float* relb;
    const float* rope;
    float* ssq; int slot0;
};
template <int DQK, int DV, int MODE>
__device__ __forceinline__ void attn_unit(LAS unsigned char* lds, const AttnT& A, int b, int h, int qb, int wv) {
    constexpr int KB = DQK * 128, VB = DV * 128, KVB = KB + VB;
    constexpr int KPT = (8 * DQK + 511) / 512, VPT = (8 * DV + 511) / 512, ND = DQK / 16, NV = DV / 32;
    int tid_l = tid_from(wv); asm volatile("" : "+v"(tid_l));
    const int tid = tid_l, lane = tid & 63, r32 = lane & 31, hi = lane >> 5;
    const int wid = wv;
    LAS float* xtra = (LAS float*)(lds + 2 * KVB);
    const int q0 = qb * 256;
    const size_t qrow = (size_t)b * SEQ + q0 + wid * 32 + r32;
    const size_t krow0 = (MODE == 3) ? (size_t)b * MEMLEN : (size_t)b * SEQ;
    int kt_lo = 0, kt_hi = 4 * qb + 4;
    if (MODE == 2) kt_lo = (4 * qb - 8) > 0 ? (4 * qb - 8) : 0;
    if (MODE == 3) kt_hi = 4;
    const int wchunk = 4 * qb + (wid >> 1);
    int w_lo = 0, w_hi = wchunk;
    if (MODE == 2) w_lo = (wchunk - 8) > 0 ? (wchunk - 8) : 0;
    if (MODE == 3) w_hi = 3;
    bf16x8 qr[ND];
    { const bf16_t* qp = A.Q + qrow * A.qpitch + A.qcol + h * DQK + hi * 8;
#pragma unroll
      for (int d0 = 0; d0 < ND; ++d0) qr[d0] = *(const bf16x8*)(qp + d0 * 16); }
    if (MODE == 0) {
        const f32x4* rp = (const f32x4*)(A.rope + ((size_t)(q0 + wid * 32 + r32) * 16 + 8 * hi) * 2);
        bf16x8 a1 = qr[ND - 2], a2 = qr[ND - 1];
#pragma unroll
        for (int jj = 0; jj < 4; ++jj) { const f32x4 cs = rp[jj];
            const float x1a = bf2f((bf16_t)a1[2 * jj]), x2a = bf2f((bf16_t)a2[2 * jj]), x1b = bf2f((bf16_t)a1[2 * jj + 1]), x2b = bf2f((bf16_t)a2[2 * jj + 1]);
            const unsigned w1 = pk2(x1a * cs[0] - x2a * cs[1], x1b * cs[2] - x2b * cs[3]), w2 = pk2(x1a * cs[1] + x2a * cs[0], x1b * cs[3] + x2b * cs[2]);
            a1[2 * jj] = (short)(w1 & 0xffffu); a1[2 * jj + 1] = (short)(w1 >> 16); a2[2 * jj] = (short)(w2 & 0xffffu); a2[2 * jj + 1] = (short)(w2 >> 16); }
        qr[ND - 2] = a1; qr[ND - 1] = a2;
    }
    if (MODE == 2) { if (tid < 192) xtra[tid] = A.relb[h * 192 + tid] * LOG2E; }
    f32x16 o[NV];
#pragma unroll
    for (int d = 0; d < NV; ++d)
#pragma unroll
        for (int r = 0; r < 16; ++r) o[d][r] = 0.f;
    float mrun = 0.f, lrun = 0.f; bool first = true;
    u32x4 kreg[KPT], vreg[VPT]; float ckreg = 0.f;
    constexpr bool DEEP = (MODE != 3);
    u32x4 kreg2[KPT], vreg2[VPT]; float ckreg2 = 0.f;
#define GLOAD(kt, KR, VR, CR) do { const size_t rb_ = krow0 + (size_t)(kt) * 64; \
    _Pragma("unroll") for (int i_ = 0; i_ < KPT; ++i_) { const int e_ = tid + 512 * i_; if (e_ < 8 * DQK) { const int key_ = e_ & 63, c8_ = e_ >> 6; \
        const bf16_t* p_; if (MODE == 0 && c8_ >= 8) p_ = A.K2 + (rb_ + key_) * 32 + (c8_ - 8) * 8; else p_ = A.K + (rb_ + key_) * A.kpitch + A.kcol + h * (MODE == 0 ? 64 : DQK) + c8_ * 8; \
        KR[i_] = *(const u32x4*)p_; } } \
    _Pragma("unroll") for (int i_ = 0; i_ < VPT; ++i_) { const int e_ = tid + 512 * i_; const int part_ = e_ & 3, key_ = (e_ >> 2) & 63, d0_ = e_ >> 8; \
        VR[i_] = *(const u32x4*)(A.V + (rb_ + key_) * A.vpitch + A.vcol + h * DV + d0_ * 32 + part_ * 8); } \
    if (MODE == 1) { if (tid < 64) CR = A.cum[(rb_ + tid) * 4 + h]; } } while (0)
#define LWRITE(buf) do { LAS unsigned char* kb_ = lds + (buf) * KVB; \
    _Pragma("unroll") for (int i_ = 0; i_ < KPT; ++i_) { const int e_ = tid + 512 * i_; if (e_ < 8 * DQK) *(LAS u32x4*)(kb_ + e_ * 16) = kreg[i_]; } \
    _Pragma("unroll") for (int i_ = 0; i_ < VPT; ++i_) { const int e_ = tid + 512 * i_; *(LAS u32x4*)(kb_ + KB + e_ * 16) = vreg[i_]; } \
    if (MODE == 1) { if (tid < 64) xtra[(buf) * 64 + tid] = ckreg; } } while (0)
    const int nsteps = kt_hi - kt_lo;
#define KT(i_) ((MODE == 1) ? (kt_hi - 1 - (i_)) : (kt_lo + (i_)))
    GLOAD(KT(0), kreg, vreg, ckreg); LWRITE(0);
    if (DEEP) { if (1 < nsteps) GLOAD(KT(1), kreg, vreg, ckreg); }
    __syncthreads();
    bool hot = (MODE != 1);
#pragma unroll 1
    for (int it = 0; it < nsteps; ++it) {
        const int kt = KT(it);
        const int cur = it & 1;
        const bool more = it + 1 < nsteps;
        if (DEEP) { if (it + 2 < nsteps) GLOAD(KT(it + 2), kreg2, vreg2, ckreg2); } else { if (more) GLOAD(KT(it + 1), kreg, vreg, ckreg); }
        if (kt >= w_lo && kt <= w_hi) {
            const LAS unsigned char* Kb = lds + cur * KVB; const LAS unsigned char* Vb = Kb + KB;
            constexpr int NDA = ND > 6 ? ND / 2 : ND;
            bf16x8 kf0[NDA], kf1[NDA];
#pragma unroll
            for (int d0 = 0; d0 < NDA; ++d0) {
                kf0[d0] = *(const LAS bf16x8*)(Kb + (2 * d0 + hi) * 1024 + r32 * 16);
                kf1[d0] = *(const LAS bf16x8*)(Kb + (2 * d0 + hi) * 1024 + 512 + r32 * 16);
            }
            f32x4 ck0[4], ck1[4];
            if (MODE == 1) { const LAS float* ck = xtra + cur * 64;
#pragma unroll
                for (int g = 0; g < 4; ++g) { ck0[g] = *(const LAS f32x4*)(ck + 8 * g + 4 * hi); ck1[g] = *(const LAS f32x4*)(ck + 32 + 8 * g + 4 * hi); } }
            __builtin_amdgcn_sched_barrier(0);
            f32x16 p0, p1;
            { const float nm = -mrun;
#pragma unroll
            for (int r = 0; r < 16; ++r) { p0[r] = nm; p1[r] = nm; } }
#pragma unroll
            for (int d0 = 0; d0 < NDA; ++d0) { p0 = mfma32(kf0[d0], qr[d0], p0); p1 = mfma32(kf1[d0], qr[d0], p1); }
            __builtin_amdgcn_sched_barrier(0);
            if (NDA < ND) {
#pragma unroll
                for (int d0 = 0; d0 < ND - NDA; ++d0) {
                    kf0[d0] = *(const LAS bf16x8*)(Kb + (2 * (d0 + NDA) + hi) * 1024 + r32 * 16);
                    kf1[d0] = *(const LAS bf16x8*)(Kb + (2 * (d0 + NDA) + hi) * 1024 + 512 + r32 * 16);
                }
                __builtin_amdgcn_sched_barrier(0);
#pragma unroll
                for (int d0 = 0; d0 < ND - NDA; ++d0) { p0 = mfma32(kf0[d0], qr[d0 + NDA], p0); p1 = mfma32(kf1[d0], qr[d0 + NDA], p1); }
                __builtin_amdgcn_sched_barrier(0);
            }
            asm volatile("s_nop 15\n\ts_nop 7" : "+v"(p0), "+v"(p1));
            const LAS unsigned char* vbase = Vb + (4 * hi + ((lane & 15) >> 2)) * 64 + ((lane >> 4) & 1) * 32 + (lane & 3) * 8;
            constexpr int KSA = NV > 2 ? 1 : 4;
            s16x4 vlo[4][NV], vh4[4][NV];
            if (hot) {
#pragma unroll
                for (int ks = 0; ks < KSA; ++ks)
#pragma unroll
                    for (int d = 0; d < NV; ++d) { vlo[ks][d] = vtr(vbase + d * 4096 + ks * 1024); vh4[ks][d] = vtr(vbase + d * 4096 + ks * 1024 + 512); }
            }
            __builtin_amdgcn_sched_barrier(0);
            if (MODE == 1) {
#pragma unroll
                for (int g = 0; g < 4; ++g)
#pragma unroll
                    for (int i = 0; i < 4; ++i) { p0[4 * g + i] -= ck0[g][i]; p1[4 * g + i] -= ck1[g][i]; }
                if (kt * 64 + 63 > q0 + wid * 32) {
                    const int qrel = q0 + wid * 32 + r32 - kt * 64;
#pragma unroll
                    for (int r = 0; r < 16; ++r) { const int kk = (r & 3) + 8 * (r >> 2) + 4 * hi; if (kk > qrel) p0[r] = -INFINITY; if (kk + 32 > qrel) p1[r] = -INFINITY; }
                }
            }
            if (MODE == 2) {
                if (wchunk - kt >= 3) { const float cb = xtra[191];
#pragma unroll
                    for (int r = 0; r < 16; ++r) { p0[r] += cb; p1[r] += cb; } }
                else { const int qrel = q0 + wid * 32 + r32 - kt * 64 + 63;
#pragma unroll
                    for (int r = 0; r < 16; ++r) { const int kk = (r & 3) + 8 * (r >> 2) + 4 * hi;
                        int i0 = qrel - kk, i1 = qrel - kk - 32; i0 = i0 < 0 ? 0 : (i0 > 191 ? 191 : i0); i1 = i1 < 0 ? 0 : (i1 > 191 ? 191 : i1);
                        p0[r] += xtra[i0]; p1[r] += xtra[i1]; } }
            }
            float mx = max3f(p0[0], p0[1], p1[0]), mx2 = max3f(p0[2], p0[3], p1[1]);
            mx = max3f(mx, p1[2], p1[3]);
#pragma unroll
            for (int r = 4; r < 16; r += 4) { mx = max3f(mx, p0[r], p0[r + 1]); mx2 = max3f(mx2, p0[r + 2], p0[r + 3]); mx = max3f(mx, p1[r], p1[r + 1]); mx2 = max3f(mx2, p1[r + 2], p1[r + 3]); }
            mx = max3f(mx, mx2, mx2);
            mx = max3f(mx, mx, lane_xor(mx, lane, 32));
            const bool dead = (MODE == 1) && !first && __all(mx < -160.0f);
            if (!dead) {
            if (MODE == 1 && !hot) {
#pragma unroll
                for (int ks = 0; ks < KSA; ++ks)
#pragma unroll
                    for (int d = 0; d < NV; ++d) { vlo[ks][d] = vtr(vbase + d * 4096 + ks * 1024); vh4[ks][d] = vtr(vbase + d * 4096 + ks * 1024 + 512); }
                hot = true;
            }
            if (first || __any(mx > 8.0f)) {
                const float dl = first ? mx : fmaxf(mx, 0.f);
                mrun += dl;
#pragma unroll
                for (int r = 0; r < 16; ++r) { p0[r] -= dl; p1[r] -= dl; }
                if (!first) { const float f = __builtin_amdgcn_exp2f(-dl); lrun *= f;
#pragma unroll
                    for (int d = 0; d < NV; ++d)
#pragma unroll
                        for (int r = 0; r < 16; ++r) o[d][r] *= f; }
                first = false;
            }
            float ls = 0.f;
#pragma unroll
            for (int r = 0; r < 16; ++r) { p0[r] = __builtin_amdgcn_exp2f(p0[r]); p1[r] = __builtin_amdgcn_exp2f(p1[r]); ls += p0[r] + p1[r]; }
            lrun += ls;
            u32x4 pw[4];
            pw[0] = (u32x4){pk2(p0[0], p0[1]), pk2(p0[2], p0[3]), pk2(p0[4], p0[5]), pk2(p0[6], p0[7])};
            pw[1] = (u32x4){pk2(p0[8], p0[9]), pk2(p0[10], p0[11]), pk2(p0[12], p0[13]), pk2(p0[14], p0[15])};
            pw[2] = (u32x4){pk2(p1[0], p1[1]), pk2(p1[2], p1[3]), pk2(p1[4], p1[5]), pk2(p1[6], p1[7])};
            pw[3] = (u32x4){pk2(p1[8], p1[9]), pk2(p1[10], p1[11]), pk2(p1[12], p1[13]), pk2(p1[14], p1[15])};
            __builtin_amdgcn_sched_barrier(0);
#pragma unroll
            for (int ks = 0; ks < 4; ++ks) {
                if (KSA < 4 && ks + 1 < 4) {
#pragma unroll
                    for (int d = 0; d < NV; ++d) { vlo[ks + 1][d] = vtr(vbase + d * 4096 + (ks + 1) * 1024); vh4[ks + 1][d] = vtr(vbase + d * 4096 + (ks + 1) * 1024 + 512); }
                    __builtin_amdgcn_sched_barrier(0);
                }
                const bf16x8 pf = __builtin_bit_cast(bf16x8, pw[ks]);
#pragma unroll
                for (int d = 0; d < NV; ++d) {
                    const s16x4 lo = vlo[ks][d], h4 = vh4[ks][d];
                    const bf16x8 vf = (bf16x8){lo[0], lo[1], lo[2], lo[3], h4[0], h4[1], h4[2], h4[3]};
                    o[d] = mfma32(vf, pf, o[d]);
                }
                if (KSA < 4) __builtin_amdgcn_sched_barrier(0);
            }
            } else { hot = false; }
        }
        if (more) LWRITE(cur ^ 1);
        __syncthreads();
        if (DEEP) {
#pragma unroll
            for (int i_ = 0; i_ < KPT; ++i_) kreg[i_] = kreg2[i_];
#pragma unroll
            for (int i_ = 0; i_ < VPT; ++i_) vreg[i_] = vreg2[i_];
            ckreg = ckreg2;
        }
    }
#undef GLOAD
#undef LWRITE
#undef KT
    lrun += lane_xor(lrun, lane, 32);
    const float rl = 1.0f / lrun;
    {
        constexpr int NCH16 = DV / 8, RB = DV * 2;
        LAS unsigned char* stg = lds + 65536 + wid * (32 * RB);
#pragma unroll
        for (int d = 0; d < NV; ++d)
#pragma unroll
            for (int g = 0; g < 4; ++g) { u32x2 w; w.x = pk2(o[d][4 * g] * rl, o[d][4 * g + 1] * rl); w.y = pk2(o[d][4 * g + 2] * rl, o[d][4 * g + 3] * rl);
                const int pi = 8 * d + 2 * g + hi, ch = pi >> 1, sub = pi & 1;
                *(LAS u32x2*)(stg + r32 * RB + ((ch ^ (r32 & (NCH16 - 1))) * 16) + sub * 8) = w; }
        bf16_t* ob = A.O + ((size_t)b * SEQ + q0 + wid * 32) * A.opitch + A.ocol + h * DV;
#pragma unroll
        for (int i = 0; i < (32 * NCH16) / 64; ++i) { const int row = i * (64 / NCH16) + lane / NCH16, ch = lane % NCH16;
            const u32x4 v = *(const LAS u32x4*)(stg + row * RB + ((ch ^ (row & (NCH16 - 1))) * 16));
            *(u32x4*)(ob + (size_t)row * A.opitch + ch * 8) = v; }
    }
    if (MODE != 3) {
        float sq = 0.f;
#pragma unroll
        for (int d = 0; d < NV; ++d)
#pragma unroll
            for (int r = 0; r < 16; ++r) { const float v = o[d][r] * rl; sq += v * v; }
        sq += lane_xor(sq, lane, 32);
        if (hi == 0) A.ssq[qrow * 12 + A.slot0 + h] = sq;
    }
}

__device__ __forceinline__ void phase_final(KArgs a, int wv) {
    const float* g = a->in[20];
    const bf16_t* XB = (const bf16_t*)(a->ws + (((3 * NLAYER) & 1) ? WS_XB2 : WS_XB));
    int tid_l = tid_from(wv); asm volatile("" : "+v"(tid_l));
    const int tid = tid_l, lane = tid & 63, wave = tid >> 6;
    for (int row = blockIdx.x * NWAVES + wave; row < T_TOK; row += gridDim.x * NWAVES) {
        const u32x2* xr = (const u32x2*)(XB + (size_t)row * DMODEL) + lane;
        f32x4 v[4]; float s = 0.f;
#pragma unroll
        for (int j = 0; j < 4; ++j) { const u32x2 w = xr[64 * j]; v[j] = (f32x4){bflo(w.x), bfhi(w.x), bflo(w.y), bfhi(w.y)}; s += (v[j][0] * v[j][0] + v[j][1] * v[j][1]) + (v[j][2] * v[j][2] + v[j][3] * v[j][3]); }
        const float rs = __builtin_amdgcn_rsqf(wave_sum(s, lane) * (1.0f / 1024.0f) + EPS);
        f32x4* orow = (f32x4*)(a->out + (size_t)row * DMODEL) + lane;
#pragma unroll
        for (int j = 0; j < 4; ++j) { const f32x4 gg = ((const f32x4*)g)[64 * j + lane]; orow[64 * j] = v[j] * rs * gg; }
    }
}

constexpr int PH_PER_LAYER = 9, N_PHASES = 1 + NLAYER * PH_PER_LAYER + 1;
__global__ void __launch_bounds__(NTHREADS, 2) fwd_kernel(Args args) {
    extern __shared__ __attribute__((aligned(16))) unsigned char lds_raw[];
    LAS unsigned char* lds = (LAS unsigned char*)lds_raw;
    const int lo = args.ph_lo, hi = args.ph_hi;
#define WSP(off) (wsl + (off))
#define LAUNDER_WS() KArgs ap = (KArgs)__builtin_amdgcn_kernarg_segment_ptr(); asm volatile("" : "+s"(ap)); unsigned char* wsl = ap->ws; \
    bf16_t* XB = (bf16_t*)WSP(WS_XB); bf16_t* XB2 = (bf16_t*)WSP(WS_XB2); (void)XB2; float* RS = (float*)WSP(WS_RS); bf16_t* PROJ = (bf16_t*)WSP(WS_PROJ); bf16_t* CQN = (bf16_t*)WSP(WS_CQN); bf16_t* CKVN = (bf16_t*)WSP(WS_CKVN); \
    bf16_t* QM = (bf16_t*)WSP(WS_QM); bf16_t* KV = (bf16_t*)WSP(WS_KV); bf16_t* Y = (bf16_t*)WSP(WS_Y); bf16_t* HID = (bf16_t*)WSP(WS_HID); \
    bf16_t* KPE = (bf16_t*)WSP(WS_KPE); bf16_t* MEMN = (bf16_t*)WSP(WS_MEMN); bf16_t* QC = QM; bf16_t* OC = KV; \
    const float* CUM = (const float*)WSP(WS_CUM); const float* rope = (const float*)WSP(WS_ROPE); float* SSQ = (float*)WSP(WS_SSQ); (void)SSQ; float* RSQ = (float*)WSP(WS_RSQ); float* RSKV = (float*)WSP(WS_RSKV); float* LF = (float*)WSP(WS_LC); (void)RSQ; (void)RSKV; (void)LF; \
    unsigned char* wl = wsl + WS_W + (size_t)l * W_LAYER; bf16_t* KVMEM = (bf16_t*)WSP(WS_KVMEM) + (size_t)l * 1024 * 1024; \
    (void)XB; (void)RS; (void)PROJ; (void)CQN; (void)CKVN; (void)QM; (void)KV; (void)Y; (void)HID; (void)KPE; (void)MEMN; (void)QC; (void)OC; (void)CUM; (void)rope; (void)wl; (void)KVMEM
    const int G = gridDim.x, bx = blockIdx.x;
    const int vcu = (G % 8 == 0) ? (bx % 8) * (G / 8) + bx / 8 : bx;
    volatile LAS unsigned* bst = (volatile LAS unsigned*)(lds + 131072 + 1024);
    const int wv = __builtin_amdgcn_readfirstlane((int)threadIdx.x >> 6);
    if (threadIdx.x < 4) bst[threadIdx.x] = 0u;
    __syncthreads();
    XcdBarrier gbar; gbar.bar = (unsigned*)(args.ws + WS_BAR); gbar.x = 0; gbar.st = bst; gbar.wv = wv;
    if (hi - lo > 1) gbar = xcd_barrier_post((unsigned*)(args.ws + WS_BAR), bst, wv);
    if (lo > 100000) cg::this_grid().sync();
    for (int p = lo; p < hi; ++p) {
        if (p == 0) { KArgs ap = (KArgs)__builtin_amdgcn_kernarg_segment_ptr(); asm volatile("" : "+s"(ap)); phase_prologue(ap, lds, wv, 0); }
        else if (p == N_PHASES - 1) { KArgs ap = (KArgs)__builtin_amdgcn_kernarg_segment_ptr(); asm volatile("" : "+s"(ap)); phase_final(ap, wv); }
        else {
        const int l = (p - 1) / PH_PER_LAYER, kph = (p - 1) - l * PH_PER_LAYER;
        LAUNDER_WS();
        switch (kph) {
        case 0: {
            pg8::Gemm g{((3 * l) & 1) ? XB2 : XB, (const bf16_t*)(wl + WO_IN), T_TOK, PROJ_W, 1024}; pg8::StaticOrder S; S.init(T_TOK, PROJ_W, G, bx);
            pg8::EpiWin E{PROJ, RS, RSQ, RSKV, KPE, LF, rope, ap->in[8] + l * 4};
            pg8::gemm_phase<pg8::EpiWin, pg8::StaticOrder, true, true>(lds, g, S, E, wv);
            if (l == 0) phase_prologue(ap, lds, wv, 1);
        }
        break;
        case 1: {
            { pg8::Gemm g{PROJ, (const bf16_t*)(wl + WO_UQ), T_TOK, 1280, 384, PROJ_W}; pg8::QkvOrder S; S.init(T_TOK, 1280, G, bx);
              pg8::EpiSplitQKV E{QM, KV, RSQ, RSKV};
              pg8::gemm_phase<pg8::EpiSplitQKV, pg8::QkvOrder, true, true>(lds, g, S, E, wv); }
            { pg8::Gemm g{MEMN, (const bf16_t*)(wl + WO_CKV), 1024, 1024, 1024}; pg8::StaticOrder S; S.init(1024, 1024, G, (bx + G - (128 % G)) % G);
              pg8::EpiScaleBf16<false> E{KVMEM, 1024, nullptr};
              pg8::gemm_phase<pg8::EpiScaleBf16<false>, pg8::StaticOrder, true, true>(lds, g, S, E, wv); }
            phase_cum(ap, lds, wv);
        }
        break;
        case 2: {
            { AttnT A{QM, 512, 0, KV, 768, 0, KPE, KV, 768, 256, Y, 1024, 0, nullptr, nullptr, rope, SSQ, 0};
              for (int u = vcu; u < 256; u += G) { const int bh = u >> 4, s = u & 15;
                  for (int hf = 0; hf < 2; ++hf) attn_unit<96, 128, 0>(lds, A, bh >> 2, bh & 3, hf ? s : 31 - s, wv); } }
            { AttnT A{PROJ, PROJ_W, 512, PROJ, PROJ_W, 768, nullptr, PROJ, PROJ_W, 1024, Y, 1024, 512, CUM, nullptr, nullptr, SSQ, 4};
              for (int u = vcu; u < 256; u += G) { const int bh = u >> 4, s = u & 15;
                  for (int hf = 0; hf < 2; ++hf) attn_unit<64, 64, 1>(lds, A, bh >> 2, bh & 3, hf ? s : 31 - s, wv); } }
            { AttnT A{PROJ, PROJ_W, 1280, PROJ, PROJ_W, 1536, nullptr, PROJ, PROJ_W, 1792, Y, 1024, 768, nullptr, ap->in[9] + l * 4 * 192, nullptr, SSQ, 8};
              for (int u = vcu; u < 512; u += G) { const int bh = (u >> 4) & 15, qb = (u & 15) + 16 * (u >> 8); attn_unit<64, 64, 2>(lds, A, bh >> 2, bh & 3, qb, wv); } }
        }
        break;
        case 3: {
            pg8::Gemm g{Y, (const bf16_t*)(wl + WO_O), T_TOK, 1024, 1024}; pg8::StaticOrder S; S.init(T_TOK, 1024, G, bx);
            pg8::EpiResidualY E{((3 * l) & 1) ? XB2 : XB, ((3 * l + 1) & 1) ? XB2 : XB, RS, SSQ};
            pg8::gemm_phase<pg8::EpiResidualY, pg8::StaticOrder, true, true>(lds, g, S, E, wv);
        }
        break;
        case 4: {
            pg8::Gemm g{((3 * l + 1) & 1) ? XB2 : XB, (const bf16_t*)(wl + WO_CQ), T_TOK, 512, 1024}; pg8::StaticOrder S; S.init(T_TOK, 512, G, bx);
            pg8::EpiScaleBf16<true> E{QC, 512, RS};
            pg8::gemm_phase<pg8::EpiScaleBf16<true>, pg8::StaticOrder, true, true>(lds, g, S, E, wv);
        }
        break;
        case 5: {
            AttnT A{QC, 512, 0, KVMEM, 1024, 0, nullptr, KVMEM, 1024, 512, OC, 512, 0, nullptr, nullptr, nullptr, nullptr, 0};
            for (int u = vcu; u < 512; u += G) { const int bh = (u >> 4) & 15, qb = (u & 15) + 16 * (u >> 8); attn_unit<128, 128, 3>(lds, A, bh >> 2, bh & 3, qb, wv); }
        }
        break;
        case 6: {
            pg8::Gemm g{OC, (const bf16_t*)(wl + WO_CO), T_TOK, 1024, 512}; pg8::StaticOrder S; S.init(T_TOK, 1024, G, bx);
            pg8::EpiResidual E{((3 * l + 1) & 1) ? XB2 : XB, ((3 * l + 2) & 1) ? XB2 : XB, RS, true};
            pg8::gemm_phase<pg8::EpiResidual, pg8::StaticOrder, true, true>(lds, g, S, E, wv);
        }
        break;
        case 7: {
            pg8::Gemm g{((3 * l + 2) & 1) ? XB2 : XB, (const bf16_t*)(wl + WO_GU), T_TOK, 2 * FFN_H, 1024}; pg8::StaticOrder S; S.init(T_TOK, 2 * FFN_H, G, bx);
            pg8::EpiSwiGLU E{HID, RS};
            pg8::gemm_phase<pg8::EpiSwiGLU, pg8::StaticOrder, true, true>(lds, g, S, E, wv);
        }
        break;
        case 8: {
            pg8::Gemm g{HID, (const bf16_t*)(wl + WO_DOWN), T_TOK, 1024, FFN_H}; pg8::StaticOrder S; S.init(T_TOK, 1024, G, bx);
            pg8::EpiResidual E{((3 * l + 2) & 1) ? XB2 : XB, ((3 * l + 3) & 1) ? XB2 : XB, RS, l + 1 < NLAYER};
            pg8::gemm_phase<pg8::EpiResidual, pg8::StaticOrder, true, true>(lds, g, S, E, wv);
        }
        break;

        default: break;
        }
        }
        if (p + 1 < hi) xcd_barrier(gbar);
    }
}

extern "C" void kernel_launch(void* const* d_in, const int* in_sizes, int n_in, void* d_out, int out_size, void* d_ws, size_t ws_size, hipStream_t stream) {
    static int grid = 0;
    if (grid == 0) {
        if (n_in != 21 || out_size != T_TOK * DMODEL || ws_size < WS_END) { fprintf(stderr, "kernel_launch: unexpected shapes (n_in %d, out %d, ws %zu)\n", n_in, out_size, ws_size); grid = -1; return; }
        int dev = 0, cus = 0, per_cu = 0;
        (void)hipGetDevice(&dev); (void)hipDeviceGetAttribute(&cus, hipDeviceAttributeMultiprocessorCount, dev);
        if (hipFuncSetAttribute((const void*)fwd_kernel, hipFuncAttributeMaxDynamicSharedMemorySize, LDS_BYTES) != hipSuccess) { fprintf(stderr, "kernel_launch: hipFuncSetAttribute failed\n"); grid = -1; return; }
        if (hipOccupancyMaxActiveBlocksPerMultiprocessor(&per_cu, (const void*)fwd_kernel, NTHREADS, LDS_BYTES) != hipSuccess || per_cu < 1) { fprintf(stderr, "kernel_launch: occupancy query gave %d\n", per_cu); per_cu = 1; }
        (void)hipGetLastError();
        grid = cus * 1;
        if (grid <= 0) grid = 256;
    }
    if (grid < 0) return;
    if (hipMemsetAsync((char*)d_ws + WS_BAR, 0, XCD_BAR_WORDS * 4, stream) != hipSuccess) { fprintf(stderr, "kernel_launch: memset failed\n"); return; }
    Args a{};
    for (int i = 0; i < 21; ++i) a.in[i] = (const float*)d_in[i];
    a.out = (float*)d_out; a.ws = (unsigned char*)d_ws;
#if MK_MULTI
    for (int p = 0; p < N_PHASES; ++p) { a.ph_lo = p; a.ph_hi = p + 1; hipLaunchKernelGGL(fwd_kernel, dim3(grid), dim3(NTHREADS), LDS_BYTES, stream, a); }
#else
    a.ph_lo = 0; a.ph_hi = N_PHASES;
    void* kargs[] = {&a};
    hipError_t e = hipLaunchCooperativeKernel((const void*)fwd_kernel, dim3(grid), dim3(NTHREADS), kargs, LDS_BYTES, stream);
    if (e != hipSuccess) fprintf(stderr, "kernel_launch: cooperative launch failed: %s (grid %d)\n", hipGetErrorString(e), grid);
#endif
}
```

```cpp
#include <hip/hip_runtime.h>
#include <hip/hip_cooperative_groups.h>
#include <cstdio>
#include <cstdint>
namespace cg = cooperative_groups;

#ifndef MK_MULTI
#define MK_MULTI 0
#endif

constexpr int NWAVES = 8, NTHREADS = 512;
constexpr int T_TOK = 32768, SEQ = 8192, NBATCH = 4, DMODEL = 1024, NLAYER = 2, MEMLEN = 256;
constexpr int IN_W = 1956, PROJ_W = 2048, FFN_H = 2816;
constexpr float EPS = 1e-6f, LOG2E = 1.4426950408889634f;
constexpr float SC_MLA = 0.10206207261596575f * 1.4426950408889634f;
constexpr float SC_64 = 0.125f * 1.4426950408889634f;
constexpr float SC_CROSS = 0.08838834764831845f * 1.4426950408889634f;

#define LAS __attribute__((address_space(3)))
typedef unsigned short bf16_t;
typedef float f32x4 __attribute__((ext_vector_type(4)));
typedef float f32x16 __attribute__((ext_vector_type(16)));
typedef short bf16x8 __attribute__((ext_vector_type(8)));
typedef short s16x4 __attribute__((ext_vector_type(4)));
typedef unsigned u32x4 __attribute__((ext_vector_type(4)));
typedef unsigned u32x2 __attribute__((ext_vector_type(2)));
typedef float f32x2_t __attribute__((ext_vector_type(2)));
typedef __bf16 bf16x2_t __attribute__((ext_vector_type(2)));

__device__ __forceinline__ unsigned pk2(float lo, float hi) { f32x2_t v = {lo, hi}; bf16x2_t b = __builtin_convertvector(v, bf16x2_t); return __builtin_bit_cast(unsigned, b); }
__device__ __forceinline__ float bflo(unsigned u) { return __uint_as_float(u << 16); }
__device__ __forceinline__ float bfhi(unsigned u) { return __uint_as_float(u & 0xffff0000u); }
__device__ __forceinline__ float bf2f(bf16_t h) { return __uint_as_float(((unsigned)h) << 16); }
__device__ __forceinline__ float lane_xor(float v, int lane, int m) { return __int_as_float(__builtin_amdgcn_ds_bpermute((lane ^ m) << 2, __float_as_int(v))); }
__device__ __forceinline__ float wave_sum(float v, int lane) {
#pragma unroll
    for (int o = 1; o < 64; o <<= 1) v += lane_xor(v, lane, o);
    return v;
}
__device__ __forceinline__ int lane_now() { int l; asm volatile("v_mbcnt_lo_u32_b32 %0, -1, 0\n\tv_mbcnt_hi_u32_b32 %0, -1, %0" : "=&v"(l)); return l; }
__device__ __forceinline__ int tid_from(int wv) { return wv * 64 + lane_now(); }

#define XB_TMO      128
#define XB_XCNT(j)  (256  + 64 * (j))
#define XB_XSUB(j)  (1280 + 64 * (j))
#define XB_XGEN(j)  (2304 + 64 * (j))
#define XB_TOP      3328
#define XB_TOPGEN   3392
#define XCD_BAR_WORDS 3456
#define XB_SPIN_CAP (1u << 18)


__device__ __forceinline__ unsigned xb_ld(unsigned* p)              { return __hip_atomic_load(p, __ATOMIC_RELAXED, __HIP_MEMORY_SCOPE_AGENT); }
__device__ __forceinline__ unsigned xb_add(unsigned* p, unsigned v) { return __hip_atomic_fetch_add(p, v, __ATOMIC_RELAXED, __HIP_MEMORY_SCOPE_AGENT); }
__device__ __forceinline__ unsigned xb_xcc_id() { return (unsigned)__builtin_amdgcn_s_getreg((3 << 11) | 20) & 0xFu; }
#define XB_SPIN(cond, bar) do { unsigned _sp = 0; while (cond) { __builtin_amdgcn_s_sleep(1); \
    if ((++_sp & 255u) == 0u) { if (xb_ld(&(bar)[XB_TMO])) break; if (_sp > XB_SPIN_CAP) { atomicAdd(&(bar)[XB_TMO], 1u); break; } } } } while (0)

struct XcdBarrier {
    unsigned* bar; unsigned x;
    volatile LAS unsigned* st; int wv;
};

__device__ __forceinline__ XcdBarrier xcd_barrier_post(unsigned* bar, volatile LAS unsigned* st, int wv) {
    XcdBarrier b; b.bar = bar; b.x = xb_xcc_id(); b.st = st; b.wv = wv;
    if (tid_from(wv) == 0) (void)xb_add(&bar[XB_XCNT(b.x)], 1u);
    return b;
}
__device__ __forceinline__ void xcd_barrier_complete(unsigned* bar, unsigned x, unsigned& nloc, unsigned& nx) {
    const unsigned G = gridDim.x * gridDim.y * gridDim.z;
    unsigned sum, cnt, mine, sp = 0u;
    for (;;) {
        sum = 0u; cnt = 0u; mine = 0u;
#pragma unroll
        for (unsigned j = 0; j < 16; ++j) { const unsigned c = xb_ld(&bar[XB_XCNT(j)]); sum += c; cnt += (c > 0u) ? 1u : 0u; mine = (j == x) ? c : mine; }
        if (sum == G) break;
        __builtin_amdgcn_s_sleep(1);
        if ((++sp & 255u) == 0u) { if (xb_ld(&bar[XB_TMO])) break; if (sp > XB_SPIN_CAP) { atomicAdd(&bar[XB_TMO], 1u); break; } }
    }
    nloc = mine > 0u ? mine : 1u; nx = cnt > 0u ? cnt : 1u;
}

__device__ __forceinline__ void xcd_barrier(const XcdBarrier& b) {
    asm volatile("s_waitcnt vmcnt(0)" ::: "memory");
    __syncthreads();
    if (tid_from(b.wv) == 0) {
        unsigned* bar = b.bar;
        __builtin_amdgcn_s_waitcnt(0);
        unsigned nloc = b.st[0], nx = b.st[1];
        if (nloc == 0u) { xcd_barrier_complete(bar, b.x, nloc, nx); b.st[0] = nloc; b.st[1] = nx; }
        const unsigned old = xb_add(&bar[XB_XSUB(b.x)], 1u);
        const unsigned gen = old / nloc;
        if (old + 1u == (gen + 1u) * nloc) {
            __builtin_amdgcn_fence(__ATOMIC_RELEASE, "agent");
            asm volatile("s_waitcnt vmcnt(0)" ::: "memory");
            const unsigned og = xb_add(&bar[XB_TOP], 1u);
            const unsigned tg = og / nx;
            if (og + 1u == (tg + 1u) * nx) xb_add(&bar[XB_TOPGEN], 1u);
            else XB_SPIN(xb_ld(&bar[XB_TOPGEN]) == tg, bar);
            __builtin_amdgcn_fence(__ATOMIC_ACQUIRE, "agent");
            xb_add(&bar[XB_XGEN(b.x)], 1u);
            asm volatile("s_waitcnt vmcnt(0)" ::: "memory");
        } else {
            XB_SPIN(xb_ld(&bar[XB_XGEN(b.x)]) == gen, bar);
            __builtin_amdgcn_fence(__ATOMIC_ACQUIRE, "agent");
            asm volatile("s_waitcnt vmcnt(0)" ::: "memory");
        }
    }
    __syncthreads();
}

namespace pg8 {
#define PG8_LAS __attribute__((address_space(3)))
typedef unsigned short bf16_t;
typedef short bf16x8 __attribute__((ext_vector_type(8)));
typedef float f32x4 __attribute__((ext_vector_type(4)));
typedef unsigned u32x4 __attribute__((ext_vector_type(4)));
constexpr int BM = 256, BK = 64, HALF = 128, HTB = HALF * BK * 2  , STAGE_BYTES = 8 * HTB, NXCD = 8, WGM = 8;

__host__ __device__ __forceinline__ int lds_byte(int r, int c) { const int st = (r >> 4) * 2 + (c >> 5), rr = r & 15, cc = c & 31, ob = rr * 64 + cc * 2; return st * 1024 + (ob ^ (((ob >> 9) & 1) << 5)); }
__host__ __device__ __forceinline__ void stage_rc(int b, int& R, int& C) { const int st = b / 1024, sb = b % 1024, swz = sb ^ (((sb >> 9) & 1) << 5); R = (st >> 1) * 16 + swz / 64; C = (st & 1) * 32 + (swz % 64) / 2; }
__host__ __device__ __forceinline__ int perm32(int rho) { const int n = rho >> 4, i = rho & 15; return 8 * (i >> 2) + 4 * n + (i & 3); }

struct Unit { int pm, pn; };
struct Gemm { const bf16_t* A; const bf16_t* Bt; int M, N, K; int lda; };

struct StaticOrder {
    int nM, nN, nwg, G, c;
    __host__ __device__ void init(int M, int N, int G_, int c_) { nM = M / BM; nN = N / BM; nwg = nM * nN; G = G_; c = c_; }
    __host__ __device__ bool next(int i, Unit& u) const {
        const long L = (long)i * G + c; if (L >= nwg) return false;
        int wgid = (int)L; { const int q = nwg / NXCD, r = nwg % NXCD, xcd = wgid % NXCD, off = wgid / NXCD; wgid = (xcd < r ? xcd * (q + 1) : r * (q + 1) + (xcd - r) * q) + off; }
        const int nig = WGM * nN, gid = wgid / nig, fm = gid * WGM, gsz = (nM - fm) < WGM ? (nM - fm) : WGM;
        u.pm = fm + ((wgid % nig) % gsz); u.pn = (wgid % nig) / gsz; return true;
    }
    __device__ __forceinline__ void a_ready(const Unit&) const {}
    __device__ __forceinline__ void done(const Unit&) const {}
    __device__ __forceinline__ void krange(const Unit&, int nt, int& kt0, int& nkt) const { kt0 = 0; nkt = nt; }
};
struct QkvOrder : StaticOrder {
    __device__ __forceinline__ void krange(const Unit& u, int, int& kt0, int& nkt) const { if (u.pn < 2) { kt0 = 0; nkt = 4; } else { kt0 = 4; nkt = 2; } }
};

__device__ __forceinline__ float row_rstd(const float* RS, int row) {
    const f32x4* p = (const f32x4*)(RS + (size_t)row * 16);
    const f32x4 a = p[0], b = p[1], c = p[2], d = p[3];
    const float s = ((a[0] + a[1]) + (a[2] + a[3])) + ((b[0] + b[1]) + (b[2] + b[3])) + ((c[0] + c[1]) + (c[2] + c[3])) + ((d[0] + d[1]) + (d[2] + d[3]));
    return __builtin_amdgcn_rsqf(s * (1.0f / 1024.0f) + 1e-6f);
}
__device__ __forceinline__ void st_bf8(bf16_t* p, f32x4 a, f32x4 c) { u32x4 w; w.x = ::pk2(a[0], a[1]); w.y = ::pk2(a[2], a[3]); w.z = ::pk2(c[0], c[1]); w.w = ::pk2(c[2], c[3]); *(u32x4*)p = w; }
__device__ __forceinline__ void st_bf4(bf16_t* p, f32x4 v) { u32x2 w; w.x = ::pk2(v[0], v[1]); w.y = ::pk2(v[2], v[3]); *(u32x2*)p = w; }

template <bool HAS_RS> struct EpiScaleBf16 {
    static constexpr bool PERM = true, AFTER_DRAIN = false, RESCALE = false;
    bf16_t* O; int ldc; const float* RS;
    __device__ __forceinline__ void operator()(const f32x4 (&acc)[2][2][4][2], const Unit& u, int wr, int wc, int fr, int fq) const {
        { int t2_ = (wr * 4 + wc) * 64 + ::lane_now(); asm volatile("" : "+v"(t2_)); fr = t2_ & 15; fq = (t2_ >> 4) & 3; }
        const int row0 = u.pm * BM + wr * 64 + fr, col0 = u.pn * BM + wc * 32 + 8 * fq;
#pragma unroll
        for (int ai = 0; ai < 2; ++ai)
#pragma unroll
            for (int m = 0; m < 4; ++m) {
                const int row = row0 + ai * HALF + m * 16;
                const float sc = HAS_RS ? row_rstd(RS, row) : 1.0f;
                bf16_t* rowp = O + (size_t)row * ldc;
#pragma unroll
                for (int bj = 0; bj < 2; ++bj) st_bf8(rowp + col0 + bj * HALF, acc[ai][bj][m][0] * sc, acc[ai][bj][m][1] * sc);
            }
    }
};
struct EpiQRope {
    static constexpr bool PERM = false, AFTER_DRAIN = false, RESCALE = false;
    bf16_t* O; int ldc; const float* rope;
    __device__ __forceinline__ void operator()(const f32x4 (&acc)[2][2][4][2], const Unit& u, int wr, int wc, int fr, int fq) const {
        { int t2_ = (wr * 4 + wc) * 64 + ::lane_now(); asm volatile("" : "+v"(t2_)); fr = t2_ & 15; fq = (t2_ >> 4) & 3; }
        const int row0 = u.pm * BM + wr * 64 + fr, col0 = u.pn * BM + wc * 32 + 4 * fq;
#pragma unroll
        for (int ai = 0; ai < 2; ++ai)
#pragma unroll
            for (int m = 0; m < 4; ++m) {
                const int row = row0 + ai * HALF + m * 16, pos = row & (::SEQ - 1);
                bf16_t* rowp = O + (size_t)row * ldc;
#pragma unroll
                for (int bj = 0; bj < 2; ++bj) {
                    const int c = col0 + bj * HALF;
                    if (c >= 384) continue;
                    f32x4 v0 = acc[ai][bj][m][0], v1 = acc[ai][bj][m][1];
                    if (((c >> 5) % 3) == 2) {
                        const f32x4* rp = (const f32x4*)(rope + ((size_t)pos * 16 + 4 * fq) * 2);
                        const f32x4 cs0 = rp[0], cs1 = rp[1];
                        const float co[4] = {cs0[0], cs0[2], cs1[0], cs1[2]}, si[4] = {cs0[1], cs0[3], cs1[1], cs1[3]};
                        f32x4 a, b;
#pragma unroll
                        for (int i = 0; i < 4; ++i) { a[i] = v0[i] * co[i] - v1[i] * si[i]; b[i] = v0[i] * si[i] + v1[i] * co[i]; }
                        v0 = a; v1 = b;
                    }
                    st_bf4(rowp + c, v0); st_bf4(rowp + c + 16, v1);
                }
            }
    }
};
struct EpiResidual {
    static constexpr bool PERM = true, AFTER_DRAIN = false, RESCALE = false;
    const bf16_t* XI; bf16_t* XB; float* RS; bool stats;
    __device__ __forceinline__ void operator()(const f32x4 (&acc)[2][2][4][2], const Unit& u, int wr, int wc, int fr, int fq) const {
        { int t2_ = (wr * 4 + wc) * 64 + ::lane_now(); asm volatile("" : "+v"(t2_)); fr = t2_ & 15; fq = (t2_ >> 4) & 3; }
        const int row0 = u.pm * BM + wr * 64 + fr, col0 = u.pn * BM + wc * 32 + 8 * fq;
#pragma unroll
        for (int ai = 0; ai < 2; ++ai)
#pragma unroll
            for (int m = 0; m < 4; ++m) {
                const int row = row0 + ai * HALF + m * 16;
                const size_t ro = (size_t)row * ::DMODEL;
                float ss = 0.f;
#pragma unroll
                for (int bj = 0; bj < 2; ++bj) {
                    const int c = col0 + bj * HALF;
                    const u32x4 xo = *(const u32x4*)(XI + ro + c);
                    const f32x4 x0 = (f32x4){::bflo(xo.x), ::bfhi(xo.x), ::bflo(xo.y), ::bfhi(xo.y)} + acc[ai][bj][m][0];
                    const f32x4 x1 = (f32x4){::bflo(xo.z), ::bfhi(xo.z), ::bflo(xo.w), ::bfhi(xo.w)} + acc[ai][bj][m][1];
                    st_bf8(XB + ro + c, x0, x1);
                    ss += ((x0[0] * x0[0] + x0[1] * x0[1]) + (x0[2] * x0[2] + x0[3] * x0[3])) + ((x1[0] * x1[0] + x1[1] * x1[1]) + (x1[2] * x1[2] + x1[3] * x1[3]));
                }
                { const int ln_ = fq * 16 + fr; ss += ::lane_xor(ss, ln_, 16); ss += ::lane_xor(ss, ln_, 32); }
                if (stats && fq == 0) RS[(size_t)row * 16 + u.pn * 4 + wc] = ss;
            }
    }
};
struct EpiSwiGLU {
    static constexpr bool PERM = true, AFTER_DRAIN = false, RESCALE = false;
    bf16_t* O; const float* RS;
    __device__ __forceinline__ void operator()(const f32x4 (&acc)[2][2][4][2], const Unit& u, int wr, int wc, int fr, int fq) const {
        { int t2_ = (wr * 4 + wc) * 64 + ::lane_now(); asm volatile("" : "+v"(t2_)); fr = t2_ & 15; fq = (t2_ >> 4) & 3; }
        const int row0 = u.pm * BM + wr * 64 + fr, col0 = u.pn * HALF + wc * 32 + 8 * fq;
#pragma unroll
        for (int ai = 0; ai < 2; ++ai)
#pragma unroll
            for (int m = 0; m < 4; ++m) {
                const int row = row0 + ai * HALF + m * 16;
                const float sc = row_rstd(RS, row);
                bf16_t* rowp = O + (size_t)row * ::FFN_H;
                f32x4 r2[2];
#pragma unroll
                for (int n = 0; n < 2; ++n) {
                    const f32x4 g = acc[ai][0][m][n] * sc, up = acc[ai][1][m][n] * sc;
#pragma unroll
                    for (int i = 0; i < 4; ++i) r2[n][i] = g[i] * __builtin_amdgcn_rcpf(1.0f + __builtin_amdgcn_exp2f(-g[i] * 1.4426950408889634f)) * up[i];
                }
                st_bf8(rowp + col0, r2[0], r2[1]);
            }
    }
};
struct EpiSplitQKV {
    static constexpr bool PERM = true, AFTER_DRAIN = false, RESCALE = false;
    bf16_t* QM; bf16_t* KV; const float* RSQ; const float* RSKV;
    __device__ __forceinline__ void operator()(const f32x4 (&acc)[2][2][4][2], const Unit& u, int wr, int wc, int fr, int fq) const {
        { int t2_ = (wr * 4 + wc) * 64 + ::lane_now(); asm volatile("" : "+v"(t2_)); fr = t2_ & 15; fq = (t2_ >> 4) & 3; }
        const bool isq = u.pn < 2;
        bf16_t* O = isq ? QM : KV; const int ldc = isq ? 512 : 768;
        const int row0 = u.pm * BM + wr * 64 + fr, col0 = (isq ? u.pn : u.pn - 2) * BM + wc * 32 + 8 * fq;
#pragma unroll
        for (int ai = 0; ai < 2; ++ai)
#pragma unroll
            for (int m = 0; m < 4; ++m) {
                const int row = row0 + ai * HALF + m * 16;
                const f32x4 ps = *(const f32x4*)((isq ? RSQ : RSKV) + (size_t)row * 4);
                const float sc = __builtin_amdgcn_rsqf(((ps[0] + ps[1]) + (ps[2] + ps[3])) * (isq ? 1.0f / 256.0f : 1.0f / 128.0f) + 1e-6f);
                bf16_t* rowp = O + (size_t)row * ldc;
#pragma unroll
                for (int bj = 0; bj < 2; ++bj) st_bf8(rowp + col0 + bj * HALF, acc[ai][bj][m][0] * sc, acc[ai][bj][m][1] * sc);
            }
    }
};
struct EpiResidualY {
    static constexpr bool PERM = true, AFTER_DRAIN = false, RESCALE = true;
    const bf16_t* XI; bf16_t* XB; float* RS; const float* SSQ;
    __device__ __forceinline__ static void group_rstd(const float* SSQ, int row, float& ra, float& rb, float& rc) {
        const f32x4* p = (const f32x4*)(SSQ + (size_t)row * 12);
        const f32x4 a = p[0], b = p[1], c = p[2];
        ra = __builtin_amdgcn_rsqf(((a[0] + a[1]) + (a[2] + a[3])) * (1.0f / 512.0f) + 1e-6f);
        rb = __builtin_amdgcn_rsqf(((b[0] + b[1]) + (b[2] + b[3])) * (1.0f / 256.0f) + 1e-6f);
        rc = __builtin_amdgcn_rsqf(((c[0] + c[1]) + (c[2] + c[3])) * (1.0f / 256.0f) + 1e-6f);
    }
    __device__ __forceinline__ void rescale(f32x4 (&acc)[2][2][4][2], const Unit& u, int t, int wr, int wc) const {
        int fr, fq; { int t2_ = (wr * 4 + wc) * 64 + ::lane_now(); asm volatile("" : "+v"(t2_)); fr = t2_ & 15; fq = (t2_ >> 4) & 3; } (void)fq;
        const int row0 = u.pm * BM + wr * 64 + fr;
#pragma unroll
        for (int ai = 0; ai < 2; ++ai)
#pragma unroll
            for (int m = 0; m < 4; ++m) {
                float ra, rb, rc; group_rstd(SSQ, row0 + ai * HALF + m * 16, ra, rb, rc);
                const float f = (t == 8) ? ra * __builtin_amdgcn_rcpf(rb) : rb * __builtin_amdgcn_rcpf(rc);
#pragma unroll
                for (int bj = 0; bj < 2; ++bj)
#pragma unroll
                    for (int n = 0; n < 2; ++n) acc[ai][bj][m][n] = acc[ai][bj][m][n] * f;
            }
    }
    __device__ __forceinline__ void operator()(const f32x4 (&acc)[2][2][4][2], const Unit& u, int wr, int wc, int fr, int fq) const {
        { int t2_ = (wr * 4 + wc) * 64 + ::lane_now(); asm volatile("" : "+v"(t2_)); fr = t2_ & 15; fq = (t2_ >> 4) & 3; }
        const int row0 = u.pm * BM + wr * 64 + fr, col0 = u.pn * BM + wc * 32 + 8 * fq;
#pragma unroll
        for (int ai = 0; ai < 2; ++ai)
#pragma unroll
            for (int m = 0; m < 4; ++m) {
                const int row = row0 + ai * HALF + m * 16;
                const size_t ro = (size_t)row * ::DMODEL;
                float ra, rb, rc; group_rstd(SSQ, row, ra, rb, rc); (void)ra; (void)rb;
                float ss = 0.f;
#pragma unroll
                for (int bj = 0; bj < 2; ++bj) {
                    const int c = col0 + bj * HALF;
                    const u32x4 xo = *(const u32x4*)(XI + ro + c);
                    const f32x4 x0 = (f32x4){::bflo(xo.x), ::bfhi(xo.x), ::bflo(xo.y), ::bfhi(xo.y)} + acc[ai][bj][m][0] * rc;
                    const f32x4 x1 = (f32x4){::bflo(xo.z), ::bfhi(xo.z), ::bflo(xo.w), ::bfhi(xo.w)} + acc[ai][bj][m][1] * rc;
                    st_bf8(XB + ro + c, x0, x1);
                    ss += ((x0[0] * x0[0] + x0[1] * x0[1]) + (x0[2] * x0[2] + x0[3] * x0[3])) + ((x1[0] * x1[0] + x1[1] * x1[1]) + (x1[2] * x1[2] + x1[3] * x1[3]));
                }
                { const int ln_ = fq * 16 + fr; ss += ::lane_xor(ss, ln_, 16); ss += ::lane_xor(ss, ln_, 32); }
                if (fq == 0) RS[(size_t)row * 16 + u.pn * 4 + wc] = ss;
            }
    }
};
struct EpiWin {
    static constexpr bool PERM = true, AFTER_DRAIN = false, RESCALE = false;
    bf16_t* O; const float* RS; float* RSQ; float* RSKV; bf16_t* KPE; float* LF; const float* rope; const float* fb;
    __device__ __forceinline__ void operator()(const f32x4 (&acc)[2][2][4][2], const Unit& u, int wr, int wc, int fr, int fq) const {
        { int t2_ = (wr * 4 + wc) * 64 + ::lane_now(); asm volatile("" : "+v"(t2_)); fr = t2_ & 15; fq = (t2_ >> 4) & 3; }
        const int row0 = u.pm * BM + wr * 64 + fr, col0 = u.pn * BM + wc * 32 + 8 * fq, ln_ = fq * 16 + fr;
#pragma unroll
        for (int ai = 0; ai < 2; ++ai)
#pragma unroll
            for (int m = 0; m < 4; ++m) {
                const int row = row0 + ai * HALF + m * 16;
                const float sc = row_rstd(RS, row);
                bf16_t* rowp = O + (size_t)row * ::PROJ_W;
                f32x4 v[2][2];
#pragma unroll
                for (int bj = 0; bj < 2; ++bj)
#pragma unroll
                    for (int n = 0; n < 2; ++n) v[bj][n] = acc[ai][bj][m][n] * sc;
#pragma unroll
                for (int bj = 0; bj < 2; ++bj) st_bf8(rowp + col0 + bj * HALF, v[bj][0], v[bj][1]);
                if (u.pn < 2) {
                    float s0 = 0.f, s1 = 0.f;
#pragma unroll
                    for (int n = 0; n < 2; ++n)
#pragma unroll
                        for (int i = 0; i < 4; ++i) { s0 += v[0][n][i] * v[0][n][i]; s1 += v[1][n][i] * v[1][n][i]; }
                    float ss = (u.pn == 0) ? s0 + s1 : s0;
                    ss += ::lane_xor(ss, ln_, 16); ss += ::lane_xor(ss, ln_, 32);
                    if (fq == 0) { if (u.pn == 0) RSQ[(size_t)row * 4 + wc] = ss; else RSKV[(size_t)row * 4 + wc] = ss; }
                    if (u.pn == 1 && wc == 0) {
                        const int pos = row & (::SEQ - 1), jb = 8 * (fq & 1);
                        const f32x4* rp = (const f32x4*)(rope + ((size_t)pos * 16 + jb) * 2);
                        f32x4 o2[2];
#pragma unroll
                        for (int n = 0; n < 2; ++n) { const f32x4 csA = rp[2 * n], csB = rp[2 * n + 1];
                            const float co[4] = {csA[0], csA[2], csB[0], csB[2]}, si[4] = {csA[1], csA[3], csB[1], csB[3]};
#pragma unroll
                            for (int i = 0; i < 4; ++i) { const float mine = v[1][n][i], oth = ::lane_xor(mine, ln_, 32);
                                o2[n][i] = (fq < 2) ? mine * co[i] - oth * si[i] : oth * si[i] + mine * co[i]; } }
                        st_bf8(KPE + (size_t)row * 32 + 8 * fq, o2[0], o2[1]);
                    }
                    if (u.pn == 1 && wc == 1 && fq == 0) {
                        f32x4 lf;
#pragma unroll
                        for (int i = 0; i < 4; ++i) { const float z = v[1][0][i] + fb[i]; lf[i] = -__builtin_amdgcn_logf(1.0f + __builtin_amdgcn_exp2f(-1.4426950408889634f * z)); }
                        *(f32x4*)(LF + (size_t)row * 4) = lf;
                    }
                }
            }
    }
};
template <class Epi, class Sched, bool ALIGN_EPI = false, bool SP2 = false>
__device__ __forceinline__ void gemm_phase(PG8_LAS unsigned char* lds, const Gemm g, const Sched& S, const Epi& E, int wv) {
    int tid_l = ::tid_from(wv); asm volatile("" : "+v"(tid_l));
    const int tid = tid_l, wid = wv, lane = tid & 63, wr = wid >> 2, wc = wid & 3, fr = lane & 15, fq = lane >> 4;
    const int K = g.K, nt = K / BK, lda = g.lda ? g.lda : K;
    unsigned voffA[2], voffB[2];
#pragma unroll
    for (int i = 0; i < 2; ++i) { int R, C; stage_rc(tid * 16 + i * 8192, R, C); const int Rb = Epi::PERM ? ((R & ~31) + perm32(R & 31)) : R;
        voffA[i] = (unsigned)(R * lda + C) * 2u; voffB[i] = (unsigned)(Rb * K + C) * 2u; }
    const size_t kstep = (size_t)(BK * 2);
    const size_t hstep = (size_t)HALF * K * 2;
    const size_t tstep = 2 * hstep;
    const size_t hstepA = (size_t)HALF * lda * 2, tstepA = 2 * hstepA;
    const unsigned ldsw = (unsigned)wid * 1024u;
    const int aoff = lds_byte(wr * 64 + fr, fq * 8), boff = lds_byte(wc * 32 + fr, fq * 8);
#define PG8_SA(b, h) (((b) * 2 + (h)) * HTB)
#define PG8_SB(b, h) ((4 + (b) * 2 + (h)) * HTB)
#define PG8_STAGE(bufoff, gbase, voff) do { _Pragma("unroll") for (int _i = 0; _i < 2; ++_i) \
        __builtin_amdgcn_global_load_lds((const unsigned*)((const char*)(gbase) + (voff)[_i]), (PG8_LAS unsigned*)(lds + (bufoff) + ldsw + _i * 8192), 16, 0, 0); } while (0)
#define PG8_LDA(dst, b, h) do { _Pragma("unroll") for (int m = 0; m < 4; ++m) _Pragma("unroll") for (int k = 0; k < 2; ++k) dst[m][k] = *(const PG8_LAS bf16x8*)(lds + PG8_SA(b, h) + aoff + m * 2048 + k * 1024); } while (0)
#define PG8_LDB(dst, b, h) do { _Pragma("unroll") for (int n = 0; n < 2; ++n) _Pragma("unroll") for (int k = 0; k < 2; ++k) dst[n][k] = *(const PG8_LAS bf16x8*)(lds + PG8_SB(b, h) + boff + n * 2048 + k * 1024); } while (0)
#define PG8_MMA(ai, bj, At, Bt) do { __builtin_amdgcn_s_setprio(1); _Pragma("unroll") for (int m = 0; m < 4; ++m) _Pragma("unroll") for (int n = 0; n < 2; ++n) _Pragma("unroll") for (int k = 0; k < 2; ++k) \
        acc[ai][bj][m][n] = __builtin_amdgcn_mfma_f32_16x16x32_bf16(Bt[n][k], At[m][k], acc[ai][bj][m][n], 0, 0, 0); __builtin_amdgcn_s_setprio(0); } while (0)
#define PG8_WAIT_V(n) asm volatile("s_waitcnt vmcnt(" #n ")" ::: "memory")
#define PG8_WAIT_L(n) asm volatile("s_waitcnt lgkmcnt(" #n ")" ::: "memory")
#define PG8_BAR __builtin_amdgcn_s_barrier()
#define PG8_SCHED __builtin_amdgcn_sched_barrier(0)
    Unit cur, nxt; int ui = 0;
    if (!S.next(0, cur)) return;
    f32x4 acc[2][2][4][2];
#pragma unroll
    for (int a = 0; a < 2; ++a)
#pragma unroll
        for (int b = 0; b < 2; ++b)
#pragma unroll
            for (int m = 0; m < 4; ++m)
#pragma unroll
                for (int n = 0; n < 2; ++n) acc[a][b][m][n] = (f32x4){0.f, 0.f, 0.f, 0.f};
    bf16x8 At[4][2], B0[2][2], B1[2][2];
    int ck0, cnt; S.krange(cur, nt, ck0, cnt);
    const char* cA = (const char*)g.A + (size_t)cur.pm * tstepA + (size_t)ck0 * kstep; const char* cB = (const char*)g.Bt + (size_t)cur.pn * tstep + (size_t)ck0 * kstep;
    S.a_ready(cur);
    if constexpr (SP2) {
        PG8_STAGE(PG8_SB(0, 0), cB, voffB); PG8_STAGE(PG8_SB(0, 1), cB + hstep, voffB); PG8_STAGE(PG8_SA(0, 0), cA, voffA); PG8_STAGE(PG8_SA(0, 1), cA + hstepA, voffA);
        if (wr == 1) PG8_BAR;
        PG8_WAIT_V(2); PG8_BAR;
        PG8_STAGE(PG8_SB(1, 0), cB + kstep, voffB); PG8_STAGE(PG8_SA(1, 0), cA + kstep, voffA); PG8_STAGE(PG8_SB(1, 1), cB + hstep + kstep, voffB);
        PG8_WAIT_V(6); PG8_BAR;
    } else {
        PG8_STAGE(PG8_SB(0, 0), cB, voffB); PG8_STAGE(PG8_SA(0, 0), cA, voffA); PG8_STAGE(PG8_SB(0, 1), cB + hstep, voffB); PG8_STAGE(PG8_SA(0, 1), cA + hstepA, voffA);
        if (wr == 1) PG8_BAR;
        PG8_WAIT_V(4); PG8_BAR;
        PG8_STAGE(PG8_SB(1, 0), cB + kstep, voffB); PG8_STAGE(PG8_SA(1, 0), cA + kstep, voffA); PG8_STAGE(PG8_SB(1, 1), cB + hstep + kstep, voffB);
        PG8_WAIT_V(6); PG8_BAR;
    }
    for (;;) {
        const bool has_next = S.next(ui + 1, nxt);
        int nk0 = 0, nnt = cnt; if (has_next) S.krange(nxt, nt, nk0, nnt);
        const char* nA = has_next ? (const char*)g.A + (size_t)nxt.pm * tstepA + (size_t)nk0 * kstep : cA; const char* nB = has_next ? (const char*)g.Bt + (size_t)nxt.pn * tstep + (size_t)nk0 * kstep : cB;
        for (int t = 0; t < cnt; t += 2) {
            if constexpr (Epi::RESCALE) { if (t == 8 || t == 12) E.rescale(acc, cur, t, wr, wc); }
            const bool last = (t == cnt - 2);
            const char* a1 = cA + (size_t)(t + 1) * kstep;
            const char* a2 = last ? nA : cA + (size_t)(t + 2) * kstep; const char* b2 = last ? nB : cB + (size_t)(t + 2) * kstep;
            const char* a3 = a2 + kstep; const char* b3 = b2 + kstep;
            if (last && has_next) S.a_ready(nxt);
            if constexpr (SP2) {
            PG8_LDB(B0, 0, 0); PG8_LDB(B1, 0, 1); PG8_SCHED; PG8_LDA(At, 0, 0); PG8_STAGE(PG8_SA(1, 1), a1 + hstepA, voffA);
            PG8_WAIT_V(8); PG8_WAIT_L(0); PG8_BAR; PG8_MMA(0, 0, At, B0); PG8_MMA(0, 1, At, B1); PG8_BAR; PG8_SCHED;
            PG8_LDA(At, 0, 1); PG8_STAGE(PG8_SB(0, 0), b2, voffB); PG8_STAGE(PG8_SB(0, 1), b2 + hstep, voffB); PG8_STAGE(PG8_SA(0, 0), a2, voffA);
            PG8_WAIT_V(8); PG8_WAIT_L(0); PG8_BAR; PG8_MMA(1, 0, At, B0); PG8_MMA(1, 1, At, B1); PG8_BAR; PG8_SCHED;
            PG8_LDB(B0, 1, 0); PG8_LDB(B1, 1, 1); PG8_SCHED; PG8_LDA(At, 1, 0); PG8_STAGE(PG8_SA(0, 1), a2 + hstepA, voffA);
            PG8_WAIT_V(8); PG8_WAIT_L(0); PG8_BAR; PG8_MMA(0, 0, At, B0); PG8_MMA(0, 1, At, B1); PG8_BAR; PG8_SCHED;
            PG8_LDA(At, 1, 1); PG8_STAGE(PG8_SB(1, 0), b3, voffB); PG8_STAGE(PG8_SB(1, 1), b3 + hstep, voffB); PG8_STAGE(PG8_SA(1, 0), a3, voffA);
            PG8_WAIT_V(8); PG8_WAIT_L(0); PG8_BAR; PG8_MMA(1, 0, At, B0); PG8_MMA(1, 1, At, B1); PG8_BAR; PG8_SCHED;
            } else {
            PG8_LDB(B0, 0, 0); PG8_SCHED; PG8_LDA(At, 0, 0); PG8_STAGE(PG8_SA(1, 1), a1 + hstepA, voffA);
            PG8_WAIT_L(8); PG8_BAR; PG8_WAIT_L(0); PG8_MMA(0, 0, At, B0); PG8_BAR; PG8_SCHED;
            PG8_LDB(B1, 0, 1); PG8_STAGE(PG8_SB(0, 0), b2, voffB);
            PG8_BAR; PG8_WAIT_L(0); PG8_MMA(0, 1, At, B1); PG8_BAR;
            PG8_LDA(At, 0, 1); PG8_STAGE(PG8_SA(0, 0), a2, voffA);
            PG8_BAR; PG8_WAIT_L(0); PG8_MMA(1, 0, At, B0); PG8_BAR; PG8_SCHED;
            PG8_STAGE(PG8_SB(0, 1), b2 + hstep, voffB);
            PG8_WAIT_V(6); PG8_BAR; PG8_MMA(1, 1, At, B1); PG8_BAR;
            PG8_LDB(B0, 1, 0); PG8_SCHED; PG8_LDA(At, 1, 0); PG8_STAGE(PG8_SA(0, 1), a2 + hstepA, voffA);
            PG8_WAIT_L(8); PG8_BAR; PG8_WAIT_L(0); PG8_MMA(0, 0, At, B0); PG8_BAR; PG8_SCHED;
            PG8_LDB(B1, 1, 1); PG8_STAGE(PG8_SB(1, 0), b3, voffB);
            PG8_BAR; PG8_WAIT_L(0); PG8_MMA(0, 1, At, B1); PG8_BAR;
            PG8_LDA(At, 1, 1); PG8_STAGE(PG8_SA(1, 0), a3, voffA);
            PG8_BAR; PG8_WAIT_L(0); PG8_MMA(1, 0, At, B0); PG8_BAR; PG8_SCHED;
            PG8_STAGE(PG8_SB(1, 1), b3 + hstep, voffB);
            PG8_WAIT_V(6); PG8_BAR; PG8_MMA(1, 1, At, B1); PG8_BAR;
            }
        }
        if constexpr (ALIGN_EPI) { if (wr == 0) PG8_BAR; }
        if constexpr (!Epi::AFTER_DRAIN) { E(acc, cur, wr, wc, fr, fq); S.done(cur); }
        if (!has_next) break;
#pragma unroll
        for (int a = 0; a < 2; ++a)
#pragma unroll
            for (int b = 0; b < 2; ++b)
#pragma unroll
                for (int m = 0; m < 4; ++m)
#pragma unroll
                    for (int n = 0; n < 2; ++n) acc[a][b][m][n] = (f32x4){0.f, 0.f, 0.f, 0.f};
        cur = nxt; cA = nA; cB = nB; cnt = nnt; ++ui;
        if constexpr (ALIGN_EPI) { if (wr == 1) PG8_BAR; }
    }
    PG8_WAIT_V(0);
    if constexpr (!ALIGN_EPI) { if (wr == 0) PG8_BAR; }
    PG8_BAR;
    if constexpr (Epi::AFTER_DRAIN) { E.fused(acc, cur, wr, wc, fr, fq, lds, wid, lane); S.done(cur); }
#undef PG8_SA
#undef PG8_SB
#undef PG8_STAGE
#undef PG8_LDA
#undef PG8_LDB
#undef PG8_MMA
#undef PG8_WAIT_V
#undef PG8_WAIT_L
#undef PG8_BAR
#undef PG8_SCHED
}
}
constexpr size_t MiB = 1u << 20;
constexpr size_t WS_W = 0, W_LAYER = 28 * MiB;
constexpr size_t WO_IN = 0, WO_UQ = 4 * MiB, WO_UKV = 4 * MiB + 512 * 1024, WO_O = 5 * MiB, WO_CQ = 7 * MiB, WO_CKV = 8 * MiB, WO_CO = 10 * MiB, WO_GU = 11 * MiB, WO_DOWN = 22 * MiB;
constexpr size_t WS_XB = 56 * MiB;
constexpr size_t WS_RS = 120 * MiB;
constexpr size_t WS_KPE = 122 * MiB;
constexpr size_t WS_LC = 124 * MiB;
constexpr size_t WS_CUM = 124 * MiB + 512 * 1024;
constexpr size_t WS_TOT = 125 * MiB;
constexpr size_t WS_ROPE = 125 * MiB + 512 * 1024;
constexpr size_t WS_MEMN = 127 * MiB;
constexpr size_t WS_KVMEM = 129 * MiB;
constexpr size_t WS_PROJ = 134 * MiB;
constexpr size_t WS_CQN = 262 * MiB;
constexpr size_t WS_CKVN = 278 * MiB;
constexpr size_t WS_QM = 294 * MiB;
constexpr size_t WS_HID = 134 * MiB;
constexpr size_t WS_KV = 326 * MiB;
constexpr size_t WS_Y = 374 * MiB;
constexpr size_t WS_SSQ = 438 * MiB;
constexpr size_t WS_RSQ = 440 * MiB;
constexpr size_t WS_RSKV = 440 * MiB + 512 * 1024;
constexpr size_t WS_BAR = 441 * MiB;
constexpr size_t WS_XB2 = 442 * MiB;
constexpr size_t WS_END = 506 * MiB;

constexpr int LDS_BYTES = 131072 + 4096;

struct Args { const float* in[21]; float* out; unsigned char* ws; int ph_lo, ph_hi; };
typedef const __attribute__((address_space(4))) Args* KArgs;

__device__ __forceinline__ int conv_map(int type, int n, float& sc) {
    sc = 1.0f;
    switch (type) {
    case 0:
        if (n < 416) return n;
        if (n < 420) return 1184 + (n - 416);
        if (n < 512) return -1;
        if (n < 1280) { if (n < 768) sc = SC_64; return 416 + (n - 512); }
        if (n < 1536) sc = SC_64;
        return 1188 + (n - 1280);
    case 1: sc = SC_MLA; return n < 384 ? n : -1;
    case 2: if (n < 256) return (n >> 6) * 192 + (n & 63); else { const int mm = n - 256; return (mm >> 7) * 192 + 64 + (mm & 127); }
    case 4: sc = SC_CROSS; return n;
    case 7: { const int t = n >> 8, c = n & 255; return c < 128 ? 128 * t + c : FFN_H + 128 * t + (c - 128); }
    default: return n;
    }
}
__device__ __forceinline__ void conv_tile(const float* src, const float* gain, bf16_t* dst, int K, int Nsrc, int Nd, int Kd, int type, int tile, LAS float* scr, int wv, int koff = 0) {
    int tid_l = tid_from(wv); asm volatile("" : "+v"(tid_l));
    const int tid = tid_l, ntn = Nd >> 8, kb = tile / ntn, nb = tile - kb * ntn, k0 = kb * 64, n0 = nb * 256;
    { const int nn = tid & 255, kh = tid >> 8; float sc; const int sn = conv_map(type, n0 + nn, sc);
      const float* sp = src + (size_t)(k0 + kh - koff) * Nsrc + (sn >= 0 ? sn : 0);
#pragma unroll 8
      for (int i = 0; i < 32; ++i) { const int kk = kh + 2 * i, k = k0 + kk; float v = 0.f;
          if (sn >= 0 && k >= koff && k - koff < K) { v = __builtin_nontemporal_load(sp + (size_t)(2 * i) * Nsrc) * sc; if (gain) v *= gain[k - koff]; }
          scr[nn * 65 + kk] = v; } }
    __syncthreads();
#pragma unroll
    for (int j = 0; j < 4; ++j) { const int idx = tid + 512 * j, nn = idx >> 3, kq = (idx & 7) * 8; const LAS float* s = scr + nn * 65 + kq;
      u32x4 o; o.x = pk2(s[0], s[1]); o.y = pk2(s[2], s[3]); o.z = pk2(s[4], s[5]); o.w = pk2(s[6], s[7]);
      *(u32x4*)(dst + (size_t)(n0 + nn) * Kd + k0 + kq) = o; }
    __syncthreads();
}
__device__ __forceinline__ void phase_prologue(KArgs a, LAS unsigned char* lds, int wv, int part) {
    LAS float* scr = (LAS float*)lds;
    unsigned char* ws = a->ws;
    int tid_l = tid_from(wv); asm volatile("" : "+v"(tid_l));
    const int tid = tid_l, lane = tid & 63, wave = tid >> 6;
    constexpr int NT_L = 128 + 12 + 18 + 64 + 32 + 64 + 32 + 352 + 176;
    const int g_lo = part == 0 ? 0 : 128, g_hi = part == 0 ? 128 : NLAYER * NT_L;
    for (int g = g_lo + blockIdx.x; g < g_hi; g += gridDim.x) {
        const int l = g / NT_L; int r = g - l * NT_L;
        bf16_t* wb = (bf16_t*)(ws + WS_W + (size_t)l * W_LAYER);
        if (r < 128) { conv_tile(a->in[3] + (size_t)l * 1024 * IN_W, a->in[2] + l * 1024, (bf16_t*)((unsigned char*)wb + WO_IN), 1024, IN_W, 2048, 1024, 0, r, scr, wv); continue; } r -= 128;
        if (r < 12) { conv_tile(a->in[5] + (size_t)l * 256 * 384, a->in[4] + l * 256, (bf16_t*)((unsigned char*)wb + WO_UQ), 256, 384, 512, 384, 1, r, scr, wv); continue; } r -= 12;
        if (r < 18) { conv_tile(a->in[7] + (size_t)l * 128 * 768, a->in[6] + l * 128, (bf16_t*)((unsigned char*)wb + WO_UQ) + (size_t)512 * 384, 128, 768, 768, 384, 2, r, scr, wv, 256); continue; } r -= 18;
        if (r < 64) { conv_tile(a->in[11] + (size_t)l * 1024 * 1024, a->in[10] + l * 1024, (bf16_t*)((unsigned char*)wb + WO_O), 1024, 1024, 1024, 1024, 3, r, scr, wv); continue; } r -= 64;
        if (r < 32) { conv_tile(a->in[14] + (size_t)l * 1024 * 512, a->in[12] + l * 1024, (bf16_t*)((unsigned char*)wb + WO_CQ), 1024, 512, 512, 1024, 4, r, scr, wv); continue; } r -= 32;
        if (r < 64) { conv_tile(a->in[15] + (size_t)l * 1024 * 1024, a->in[13] + l * 1024, (bf16_t*)((unsigned char*)wb + WO_CKV), 1024, 1024, 1024, 1024, 5, r, scr, wv); continue; } r -= 64;
        if (r < 32) { conv_tile(a->in[16] + (size_t)l * 512 * 1024, nullptr, (bf16_t*)((unsigned char*)wb + WO_CO), 512, 1024, 1024, 512, 6, r, scr, wv); continue; } r -= 32;
        if (r < 352) { conv_tile(a->in[18] + (size_t)l * 1024 * 2 * FFN_H, a->in[17] + l * 1024, (bf16_t*)((unsigned char*)wb + WO_GU), 1024, 2 * FFN_H, 2 * FFN_H, 1024, 7, r, scr, wv); continue; } r -= 352;
        conv_tile(a->in[19] + (size_t)l * FFN_H * 1024, nullptr, (bf16_t*)((unsigned char*)wb + WO_DOWN), FFN_H, 1024, 1024, FFN_H, 8, r, scr, wv);
    }
    if (part != 0) return;
    const int gw = blockIdx.x * NWAVES + wave, ngw = gridDim.x * NWAVES;
    bf16_t* XB = (bf16_t*)(ws + WS_XB); float* RS = (float*)(ws + WS_RS); bf16_t* MEMN = (bf16_t*)(ws + WS_MEMN);
    for (int row = gw; row < T_TOK + NBATCH * MEMLEN; row += ngw) {
        const bool ismem = row >= T_TOK; const int rr = ismem ? row - T_TOK : row;
        const f32x4* xr = (const f32x4*)((ismem ? a->in[1] : a->in[0]) + (size_t)rr * DMODEL) + lane;
        f32x4 v[4]; float s = 0.f;
#pragma unroll
        for (int j = 0; j < 4; ++j) { v[j] = __builtin_nontemporal_load(xr + 64 * j); s += (v[j][0] * v[j][0] + v[j][1] * v[j][1]) + (v[j][2] * v[j][2] + v[j][3] * v[j][3]); }
        s = wave_sum(s, lane);
        float sc = 1.0f;
        if (ismem) sc = __builtin_amdgcn_rsqf(s * (1.0f / 1024.0f) + EPS);
        else if (lane < 16) RS[(size_t)rr * 16 + lane] = lane == 0 ? s : 0.f;
        u32x2* o8 = (u32x2*)((ismem ? MEMN : XB) + (size_t)rr * DMODEL) + lane;
#pragma unroll
        for (int j = 0; j < 4; ++j) { u32x2 w; w.x = pk2(v[j][0] * sc, v[j][1] * sc); w.y = pk2(v[j][2] * sc, v[j][3] * sc); o8[64 * j] = w; }
    }
    float* rope = (float*)(ws + WS_ROPE);
    for (int i = blockIdx.x * NTHREADS + tid; i < SEQ * 16; i += gridDim.x * NTHREADS) {
        const int pos = i >> 4, j = i & 15;
        const float inv = __builtin_amdgcn_exp2f(-(float)j * (13.287712379549449f / 16.0f)), ang = (float)pos * inv;
        const double rev = (double)ang * 0.15915494309189535; const float frv = (float)(rev - floor(rev));
        rope[2 * i] = __builtin_amdgcn_cosf(frv); rope[2 * i + 1] = __builtin_amdgcn_sinf(frv);
    }
}

__device__ __forceinline__ void phase_cum(KArgs a, LAS unsigned char* lds, int wv) {
    unsigned char* ws = a->ws;
    const float* LF = (const float*)(ws + WS_LC); float* CUM = (float*)(ws + WS_CUM);
    LAS float* sc = (LAS float*)lds;
    LAS float* lc = (LAS float*)(lds + 2048);
    int tid_l = tid_from(wv); asm volatile("" : "+v"(tid_l));
    const int tid = tid_l, lane = tid & 63, wave = tid >> 6;
    const int gsz = (int)gridDim.x, half = gsz >= 256 ? gsz / 2 : 0;
    if ((int)blockIdx.x < half) return;
    for (int c = (int)blockIdx.x - half; c < T_TOK / 64; c += gsz - half) {
        const int b = c >> 7, ci = c & 127, n0 = ci * 64;
        { const f32x4* base = (const f32x4*)(LF + (size_t)b * SEQ * 4);
          f32x4 acc = (f32x4){0.f, 0.f, 0.f, 0.f};
          for (int t = tid; t < n0; t += NTHREADS) acc += base[t];
#pragma unroll
          for (int k = 0; k < 4; ++k) acc[k] = wave_sum(acc[k], lane);
          if (lane == 0) *(LAS f32x4*)(sc + wave * 4) = acc;
          if (tid < 256) lc[tid] = LF[((size_t)c * 64) * 4 + tid]; }
        __syncthreads();
        float v = 0.f;
        if (tid < 256) {
            v = lc[tid];
#pragma unroll
            for (int d = 4; d < 64; d <<= 1) { const float t = __int_as_float(__builtin_amdgcn_ds_bpermute(((lane - d) & 63) << 2, __float_as_int(v))); if (lane >= d) v += t; }
            if (lane >= 60) sc[32 + wave * 4 + (tid & 3)] = v;
        }
        __syncthreads();
        if (tid < 256) {
            const int h = tid & 3, i = tid >> 2; float p = v;
#pragma unroll
            for (int w = 0; w < NWAVES; ++w) p += sc[w * 4 + h];
            for (int w = 0; w < wave; ++w) p += sc[32 + w * 4 + h];
            CUM[(size_t)(c * 64 + i) * 4 + h] = p;
        }
        __syncthreads();
    }
}

__device__ __forceinline__ f32x16 mfma32(bf16x8 a, bf16x8 b, f32x16 c) { return __builtin_amdgcn_mfma_f32_32x32x16_bf16(a, b, c, 0, 0, 0); }
typedef short v4i16_t __attribute__((ext_vector_type(4)));
__device__ __forceinline__ float max3f(float a, float b, float c) { float r; asm("v_max3_f32 %0, %1, %2, %3" : "=v"(r) : "v"(a), "v"(b), "v"(c)); return r; }
__device__ __forceinline__ s16x4 vtr(const LAS unsigned char* p) { return __builtin_bit_cast(s16x4, __builtin_amdgcn_ds_read_tr16_b64_v4i16((LAS v4i16_t*)p)); }

struct AttnT {
    const bf16_t* Q; int qpitch, qcol;
    const bf16_t* K; int kpitch, kcol;
    const bf16_t* K2;
    const bf16_t* V; int vpitch, vcol;
    bf16_t* O; int opitch, ocol;
    const float* cum;
    const float* relb;
    const float* rope;
    float* ssq; int slot0;
};
template <int DQK, int DV, int MODE>
__device__ __forceinline__ void attn_unit(LAS unsigned char* lds, const AttnT& A, int b, int h, int qb, int wv) {
    constexpr int KB = DQK * 128, VB = DV * 128, KVB = KB + VB;
    constexpr int KPT = (8 * DQK + 511) / 512, VPT = (8 * DV + 511) / 512, ND = DQK / 16, NV = DV / 32;
    int tid_l = tid_from(wv); asm volatile("" : "+v"(tid_l));
    const int tid = tid_l, lane = tid & 63, r32 = lane & 31, hi = lane >> 5;
    const int wid = wv;
    LAS float* xtra = (LAS float*)(lds + 2 * KVB);
    const int q0 = qb * 256;
    const size_t qrow = (size_t)b * SEQ + q0 + wid * 32 + r32;
    const size_t krow0 = (MODE == 3) ? (size_t)b * MEMLEN : (size_t)b * SEQ;
    int kt_lo = 0, kt_hi = 4 * qb + 4;
    if (MODE == 2) kt_lo = (4 * qb - 8) > 0 ? (4 * qb - 8) : 0;
    if (MODE == 3) kt_hi = 4;
    const int wchunk = 4 * qb + (wid >> 1);
    int w_lo = 0, w_hi = wchunk;
    if (MODE == 2) w_lo = (wchunk - 8) > 0 ? (wchunk - 8) : 0;
    if (MODE == 3) w_hi = 3;
    bf16x8 qr[ND];
    { const bf16_t* qp = A.Q + qrow * A.qpitch + A.qcol + h * DQK + hi * 8;
#pragma unroll
      for (int d0 = 0; d0 < ND; ++d0) qr[d0] = *(const bf16x8*)(qp + d0 * 16); }
    if (MODE == 0) {
        const f32x4* rp = (const f32x4*)(A.rope + ((size_t)(q0 + wid * 32 + r32) * 16 + 8 * hi) * 2);
        bf16x8 a1 = qr[ND - 2], a2 = qr[ND - 1];
#pragma unroll
        for (int jj = 0; jj < 4; ++jj) { const f32x4 cs = rp[jj];
            const float x1a = bf2f((bf16_t)a1[2 * jj]), x2a = bf2f((bf16_t)a2[2 * jj]), x1b = bf2f((bf16_t)a1[2 * jj + 1]), x2b = bf2f((bf16_t)a2[2 * jj + 1]);
            const unsigned w1 = pk2(x1a * cs[0] - x2a * cs[1], x1b * cs[2] - x2b * cs[3]), w2 = pk2(x1a * cs[1] + x2a * cs[0], x1b * cs[3] + x2b * cs[2]);
            a1[2 * jj] = (short)(w1 & 0xffffu); a1[2 * jj + 1] = (short)(w1 >> 16); a2[2 * jj] = (short)(w2 & 0xffffu); a2[2 * jj + 1] = (short)(w2 >> 16); }
        qr[ND - 2] = a1; qr[ND - 1] = a2;
    }
    if (MODE == 2) { if (tid < 192) xtra[tid] = A.relb[h * 192 + tid] * LOG2E; }
    f32x16 o[NV];
#pragma unroll
    for (int d = 0; d < NV; ++d)
#pragma unroll
        for (int r = 0; r < 16; ++r) o[d][r] = 0.f;
    float mrun = 0.f, lrun = 0.f; bool first = true;
    u32x4 kreg[KPT], vreg[VPT]; float ckreg = 0.f;
    constexpr bool DEEP = (MODE != 3);
    u32x4 kreg2[KPT], vreg2[VPT]; float ckreg2 = 0.f;
#define GLOAD(kt, KR, VR, CR) do { const size_t rb_ = krow0 + (size_t)(kt) * 64; \
    _Pragma("unroll") for (int i_ = 0; i_ < KPT; ++i_) { const int e_ = tid + 512 * i_; if (e_ < 8 * DQK) { const int key_ = e_ & 63, c8_ = e_ >> 6; \
        const bf16_t* p_; if (MODE == 0 && c8_ >= 8) p_ = A.K2 + (rb_ + key_) * 32 + (c8_ - 8) * 8; else p_ = A.K + (rb_ + key_) * A.kpitch + A.kcol + h * (MODE == 0 ? 64 : DQK) + c8_ * 8; \
        KR[i_] = *(const u32x4*)p_; } } \
    _Pragma("unroll") for (int i_ = 0; i_ < VPT; ++i_) { const int e_ = tid + 512 * i_; const int part_ = e_ & 3, key_ = (e_ >> 2) & 63, d0_ = e_ >> 8; \
        VR[i_] = *(const u32x4*)(A.V + (rb_ + key_) * A.vpitch + A.vcol + h * DV + d0_ * 32 + part_ * 8); } \
    if (MODE == 1) { if (tid < 64) CR = A.cum[(rb_ + tid) * 4 + h]; } } while (0)
#define LWRITE(buf) do { LAS unsigned char* kb_ = lds + (buf) * KVB; \
    _Pragma("unroll") for (int i_ = 0; i_ < KPT; ++i_) { const int e_ = tid + 512 * i_; if (e_ < 8 * DQK) *(LAS u32x4*)(kb_ + e_ * 16) = kreg[i_]; } \
    _Pragma("unroll") for (int i_ = 0; i_ < VPT; ++i_) { const int e_ = tid + 512 * i_; *(LAS u32x4*)(kb_ + KB + e_ * 16) = vreg[i_]; } \
    if (MODE == 1) { if (tid < 64) xtra[(buf) * 64 + tid] = ckreg; } } while (0)
    const int nsteps = kt_hi - kt_lo;
#define KT(i_) ((MODE == 1) ? (kt_hi - 1 - (i_)) : (kt_lo + (i_)))
    GLOAD(KT(0), kreg, vreg, ckreg); LWRITE(0);
    if (DEEP) { if (1 < nsteps) GLOAD(KT(1), kreg, vreg, ckreg); }
    __syncthreads();
    bool hot = (MODE != 1);
#pragma unroll 1
    for (int it = 0; it < nsteps; ++it) {
        const int kt = KT(it);
        const int cur = it & 1;
        const bool more = it + 1 < nsteps;
        if (DEEP) { if (it + 2 < nsteps) GLOAD(KT(it + 2), kreg2, vreg2, ckreg2); } else { if (more) GLOAD(KT(it + 1), kreg, vreg, ckreg); }
        if (kt >= w_lo && kt <= w_hi) {
            const LAS unsigned char* Kb = lds + cur * KVB; const LAS unsigned char* Vb = Kb + KB;
            constexpr int NDA = ND > 6 ? ND / 2 : ND;
            bf16x8 kf0[NDA], kf1[NDA];
#pragma unroll
            for (int d0 = 0; d0 < NDA; ++d0) {
                kf0[d0] = *(const LAS bf16x8*)(Kb + (2 * d0 + hi) * 1024 + r32 * 16);
                kf1[d0] = *(const LAS bf16x8*)(Kb + (2 * d0 + hi) * 1024 + 512 + r32 * 16);
            }
            f32x4 ck0[4], ck1[4];
            if (MODE == 1) { const LAS float* ck = xtra + cur * 64;
#pragma unroll
                for (int g = 0; g < 4; ++g) { ck0[g] = *(const LAS f32x4*)(ck + 8 * g + 4 * hi); ck1[g] = *(const LAS f32x4*)(ck + 32 + 8 * g + 4 * hi); } }
            __builtin_amdgcn_sched_barrier(0);
            f32x16 p0, p1;
            { const float nm = -mrun;
#pragma unroll
            for (int r = 0; r < 16; ++r) { p0[r] = nm; p1[r] = nm; } }
#pragma unroll
            for (int d0 = 0; d0 < NDA; ++d0) { p0 = mfma32(kf0[d0], qr[d0], p0); p1 = mfma32(kf1[d0], qr[d0], p1); }
            __builtin_amdgcn_sched_barrier(0);
            if (NDA < ND) {
#pragma unroll
                for (int d0 = 0; d0 < ND - NDA; ++d0) {
                    kf0[d0] = *(const LAS bf16x8*)(Kb + (2 * (d0 + NDA) + hi) * 1024 + r32 * 16);
                    kf1[d0] = *(const LAS bf16x8*)(Kb + (2 * (d0 + NDA) + hi) * 1024 + 512 + r32 * 16);
                }
                __builtin_amdgcn_sched_barrier(0);
#pragma unroll
                for (int d0 = 0; d0 < ND - NDA; ++d0) { p0 = mfma32(kf0[d0], qr[d0 + NDA], p0); p1 = mfma32(kf1[d0], qr[d0 + NDA], p1); }
                __builtin_amdgcn_sched_barrier(0);
            }
            asm volatile("s_nop 15\n\ts_nop 7" : "+v"(p0), "+v"(p1));
            const LAS unsigned char* vbase = Vb + (4 * hi + ((lane & 15) >> 2)) * 64 + ((lane >> 4) & 1) * 32 + (lane & 3) * 8;
            constexpr int KSA = NV > 2 ? 1 : 4;
            s16x4 vlo[4][NV], vh4[4][NV];
            if (hot) {
#pragma unroll
                for (int ks = 0; ks < KSA; ++ks)
#pragma unroll
                    for (int d = 0; d < NV; ++d) { vlo[ks][d] = vtr(vbase + d * 4096 + ks * 1024); vh4[ks][d] = vtr(vbase + d * 4096 + ks * 1024 + 512); }
            }
            __builtin_amdgcn_sched_barrier(0);
            if (MODE == 1) {
#pragma unroll
                for (int g = 0; g < 4; ++g)
#pragma unroll
                    for (int i = 0; i < 4; ++i) { p0[4 * g + i] -= ck0[g][i]; p1[4 * g + i] -= ck1[g][i]; }
                if (kt * 64 + 63 > q0 + wid * 32) {
                    const int qrel = q0 + wid * 32 + r32 - kt * 64;
#pragma unroll
                    for (int r = 0; r < 16; ++r) { const int kk = (r & 3) + 8 * (r >> 2) + 4 * hi; if (kk > qrel) p0[r] = -INFINITY; if (kk + 32 > qrel) p1[r] = -INFINITY; }
                }
            }
            if (MODE == 2) {
                if (wchunk - kt >= 3) { const float cb = xtra[191];
#pragma unroll
                    for (int r = 0; r < 16; ++r) { p0[r] += cb; p1[r] += cb; } }
                else { const int qrel = q0 + wid * 32 + r32 - kt * 64 + 63;
#pragma unroll
                    for (int r = 0; r < 16; ++r) { const int kk = (r & 3) + 8 * (r >> 2) + 4 * hi;
                        int i0 = qrel - kk, i1 = qrel - kk - 32; i0 = i0 < 0 ? 0 : (i0 > 191 ? 191 : i0); i1 = i1 < 0 ? 0 : (i1 > 191 ? 191 : i1);
                        p0[r] += xtra[i0]; p1[r] += xtra[i1]; } }
            }
            float mx = max3f(p0[0], p0[1], p1[0]), mx2 = max3f(p0[2], p0[3], p1[1]);
            mx = max3f(mx, p1[2], p1[3]);
#pragma unroll
            for (int r = 4; r < 16; r += 4) { mx = max3f(mx, p0[r], p0[r + 1]); mx2 = max3f(mx2, p0[r + 2], p0[r + 3]); mx = max3f(mx, p1[r], p1[r + 1]); mx2 = max3f(mx2, p1[r + 2], p1[r + 3]); }
            mx = max3f(mx, mx2, mx2);
            mx = max3f(mx, mx, lane_xor(mx, lane, 32));
            const bool dead = (MODE == 1) && !first && __all(mx < -160.0f);
            if (!dead) {
            if (MODE == 1 && !hot) {
#pragma unroll
                for (int ks = 0; ks < KSA; ++ks)
#pragma unroll
                    for (int d = 0; d < NV; ++d) { vlo[ks][d] = vtr(vbase + d * 4096 + ks * 1024); vh4[ks][d] = vtr(vbase + d * 4096 + ks * 1024 + 512); }
                hot = true;
            }
            if (first || __any(mx > 8.0f)) {
                const float dl = first ? mx : fmaxf(mx, 0.f);
                mrun += dl;
#pragma unroll
                for (int r = 0; r < 16; ++r) { p0[r] -= dl; p1[r] -= dl; }
                if (!first) { const float f = __builtin_amdgcn_exp2f(-dl); lrun *= f;
#pragma unroll
                    for (int d = 0; d < NV; ++d)
#pragma unroll
                        for (int r = 0; r < 16; ++r) o[d][r] *= f; }
                first = false;
            }
            float ls = 0.f;
#pragma unroll
            for (int r = 0; r < 16; ++r) { p0[r] = __builtin_amdgcn_exp2f(p0[r]); p1[r] = __builtin_amdgcn_exp2f(p1[r]); ls += p0[r] + p1[r]; }
            lrun += ls;
            u32x4 pw[4];
            pw[0] = (u32x4){pk2(p0[0], p0[1]), pk2(p0[2], p0[3]), pk2(p0[4], p0[5]), pk2(p0[6], p0[7])};
            pw[1] = (u32x4){pk2(p0[8], p0[9]), pk2(p0[10], p0[11]), pk2(p0[12], p0[13]), pk2(p0[14], p0[15])};
            pw[2] = (u32x4){pk2(p1[0], p1[1]), pk2(p1[2], p1[3]), pk2(p1[4], p1[5]), pk2(p1[6], p1[7])};
            pw[3] = (u32x4){pk2(p1[8], p1[9]), pk2(p1[10], p1[11]), pk2(p1[12], p1[13]), pk2(p1[14], p1[15])};
            __builtin_amdgcn_sched_barrier(0);
#pragma unroll
            for (int ks = 0; ks < 4; ++ks) {
                if (KSA < 4 && ks + 1 < 4) {
#pragma unroll
                    for (int d = 0; d < NV; ++d) { vlo[ks + 1][d] = vtr(vbase + d * 4096 + (ks + 1) * 1024); vh4[ks + 1][d] = vtr(vbase + d * 4096 + (ks + 1) * 1024 + 512); }
                    __builtin_amdgcn_sched_barrier(0);
                }
                const bf16x8 pf = __builtin_bit_cast(bf16x8, pw[ks]);
#pragma unroll
                for (int d = 0; d < NV; ++d) {
                    const s16x4 lo = vlo[ks][d], h4 = vh4[ks][d];
                    const bf16x8 vf = (bf16x8){lo[0], lo[1], lo[2], lo[3], h4[0], h4[1], h4[2], h4[3]};
                    o[d] = mfma32(vf, pf, o[d]);
                }
                if (KSA < 4) __builtin_amdgcn_sched_barrier(0);
            }
            } else { hot = false; }
        }
        if (more) LWRITE(cur ^ 1);
        __syncthreads();
        if (DEEP) {
#pragma unroll
            for (int i_ = 0; i_ < KPT; ++i_) kreg[i_] = kreg2[i_];
#pragma unroll
            for (int i_ = 0; i_ < VPT; ++i_) vreg[i_] = vreg2[i_];
            ckreg = ckreg2;
        }
    }
#undef GLOAD
#undef LWRITE
#undef KT
    lrun += lane_xor(lrun, lane, 32);
    const float rl = 1.0f / lrun;
    {
        constexpr int NCH16 = DV / 8, RB = DV * 2;
        LAS unsigned char* stg = lds + 65536 + wid * (32 * RB);
#pragma unroll
        for (int d = 0; d < NV; ++d)
#pragma unroll
            for (int g = 0; g < 4; ++g) { u32x2 w; w.x = pk2(o[d][4 * g] * rl, o[d][4 * g + 1] * rl); w.y = pk2(o[d][4 * g + 2] * rl, o[d][4 * g + 3] * rl);
                const int pi = 8 * d + 2 * g + hi, ch = pi >> 1, sub = pi & 1;
                *(LAS u32x2*)(stg + r32 * RB + ((ch ^ (r32 & (NCH16 - 1))) * 16) + sub * 8) = w; }
        bf16_t* ob = A.O + ((size_t)b * SEQ + q0 + wid * 32) * A.opitch + A.ocol + h * DV;
#pragma unroll
        for (int i = 0; i < (32 * NCH16) / 64; ++i) { const int row = i * (64 / NCH16) + lane / NCH16, ch = lane % NCH16;
            const u32x4 v = *(const LAS u32x4*)(stg + row * RB + ((ch ^ (row & (NCH16 - 1))) * 16));
            *(u32x4*)(ob + (size_t)row * A.opitch + ch * 8) = v; }
    }
    if (MODE != 3) {
        float sq = 0.f;
#pragma unroll
        for (int d = 0; d < NV; ++d)
#pragma unroll
            for (int r = 0; r < 16; ++r) { const float v = o[d][r] * rl; sq += v * v; }
        sq += lane_xor(sq, lane, 32);
        if (hi == 0) A.ssq[qrow * 12 + A.slot0 + h] = sq;
    }
}

__device__ __forceinline__ void phase_final(KArgs a, int wv) {
    const float* g = a->in[20];
    const bf16_t* XB = (const bf16_t*)(a->ws + (((3 * NLAYER) & 1) ? WS_XB2 : WS_XB));
    int tid_l = tid_from(wv); asm volatile("" : "+v"(tid_l));
    const int tid = tid_l, lane = tid & 63, wave = tid >> 6;
    for (int row = blockIdx.x * NWAVES + wave; row < T_TOK; row += gridDim.x * NWAVES) {
        const u32x2* xr = (const u32x2*)(XB + (size_t)row * DMODEL) + lane;
        f32x4 v[4]; float s = 0.f;
#pragma unroll
        for (int j = 0; j < 4; ++j) { const u32x2 w = xr[64 * j]; v[j] = (f32x4){bflo(w.x), bfhi(w.x), bflo(w.y), bfhi(w.y)}; s += (v[j][0] * v[j][0] + v[j][1] * v[j][1]) + (v[j][2] * v[j][2] + v[j][3] * v[j][3]); }
        const float rs = __builtin_amdgcn_rsqf(wave_sum(s, lane) * (1.0f / 1024.0f) + EPS);
        f32x4* orow = (f32x4*)(a->out + (size_t)row * DMODEL) + lane;
#pragma unroll
        for (int j = 0; j < 4; ++j) { const f32x4 gg = ((const f32x4*)g)[64 * j + lane]; orow[64 * j] = v[j] * rs * gg; }
    }
}

constexpr int PH_PER_LAYER = 9, N_PHASES = 1 + NLAYER * PH_PER_LAYER + 1;
__global__ void __launch_bounds__(NTHREADS, 2) fwd_kernel(Args args) {
    extern __shared__ __attribute__((aligned(16))) unsigned char lds_raw[];
    LAS unsigned char* lds = (LAS unsigned char*)lds_raw;
    const int lo = args.ph_lo, hi = args.ph_hi;
#define WSP(off) (wsl + (off))
#define LAUNDER_WS() KArgs ap = (KArgs)__builtin_amdgcn_kernarg_segment_ptr(); asm volatile("" : "+s"(ap)); unsigned char* wsl = ap->ws; \
    bf16_t* XB = (bf16_t*)WSP(WS_XB); bf16_t* XB2 = (bf16_t*)WSP(WS_XB2); (void)XB2; float* RS = (float*)WSP(WS_RS); bf16_t* PROJ = (bf16_t*)WSP(WS_PROJ); bf16_t* CQN = (bf16_t*)WSP(WS_CQN); bf16_t* CKVN = (bf16_t*)WSP(WS_CKVN); \
    bf16_t* QM = (bf16_t*)WSP(WS_QM); bf16_t* KV = (bf16_t*)WSP(WS_KV); bf16_t* Y = (bf16_t*)WSP(WS_Y); bf16_t* HID = (bf16_t*)WSP(WS_HID); \
    bf16_t* KPE = (bf16_t*)WSP(WS_KPE); bf16_t* MEMN = (bf16_t*)WSP(WS_MEMN); bf16_t* QC = QM; bf16_t* OC = KV; \
    const float* CUM = (const float*)WSP(WS_CUM); const float* rope = (const float*)WSP(WS_ROPE); float* SSQ = (float*)WSP(WS_SSQ); (void)SSQ; float* RSQ = (float*)WSP(WS_RSQ); float* RSKV = (float*)WSP(WS_RSKV); float* LF = (float*)WSP(WS_LC); (void)RSQ; (void)RSKV; (void)LF; \
    unsigned char* wl = wsl + WS_W + (size_t)l * W_LAYER; bf16_t* KVMEM = (bf16_t*)WSP(WS_KVMEM) + (size_t)l * 1024 * 1024; \
    (void)XB; (void)RS; (void)PROJ; (void)CQN; (void)CKVN; (void)QM; (void)KV; (void)Y; (void)HID; (void)KPE; (void)MEMN; (void)QC; (void)OC; (void)CUM; (void)rope; (void)wl; (void)KVMEM
    const int G = gridDim.x, bx = blockIdx.x;
    const int vcu = (G % 8 == 0) ? (bx % 8) * (G / 8) + bx / 8 : bx;
    volatile LAS unsigned* bst = (volatile LAS unsigned*)(lds + 131072 + 1024);
    const int wv = __builtin_amdgcn_readfirstlane((int)threadIdx.x >> 6);
    if (threadIdx.x < 4) bst[threadIdx.x] = 0u;
    __syncthreads();
    XcdBarrier gbar; gbar.bar = (unsigned*)(args.ws + WS_BAR); gbar.x = 0; gbar.st = bst; gbar.wv = wv;
    if (hi - lo > 1) gbar = xcd_barrier_post((unsigned*)(args.ws + WS_BAR), bst, wv);
    if (lo > 100000) cg::this_grid().sync();
    for (int p = lo; p < hi; ++p) {
        if (p == 0) { KArgs ap = (KArgs)__builtin_amdgcn_kernarg_segment_ptr(); asm volatile("" : "+s"(ap)); phase_prologue(ap, lds, wv, 0); }
        else if (p == N_PHASES - 1) { KArgs ap = (KArgs)__builtin_amdgcn_kernarg_segment_ptr(); asm volatile("" : "+s"(ap)); phase_final(ap, wv); }
        else {
        const int l = (p - 1) / PH_PER_LAYER, kph = (p - 1) - l * PH_PER_LAYER;
        LAUNDER_WS();
        switch (kph) {
        case 0: {
            pg8::Gemm g{((3 * l) & 1) ? XB2 : XB, (const bf16_t*)(wl + WO_IN), T_TOK, PROJ_W, 1024}; pg8::StaticOrder S; S.init(T_TOK, PROJ_W, G, bx);
            pg8::EpiWin E{PROJ, RS, RSQ, RSKV, KPE, LF, rope, ap->in[8] + l * 4};
            pg8::gemm_phase<pg8::EpiWin, pg8::StaticOrder, true, true>(lds, g, S, E, wv);
            if (l == 0) phase_prologue(ap, lds, wv, 1);
        }
        break;
        case 1: {
            { pg8::Gemm g{PROJ, (const bf16_t*)(wl + WO_UQ), T_TOK, 1280, 384, PROJ_W}; pg8::QkvOrder S; S.init(T_TOK, 1280, G, bx);
              pg8::EpiSplitQKV E{QM, KV, RSQ, RSKV};
              pg8::gemm_phase<pg8::EpiSplitQKV, pg8::QkvOrder, true, true>(lds, g, S, E, wv); }
            { pg8::Gemm g{MEMN, (const bf16_t*)(wl + WO_CKV), 1024, 1024, 1024}; pg8::StaticOrder S; S.init(1024, 1024, G, (bx + G - (128 % G)) % G);
              pg8::EpiScaleBf16<false> E{KVMEM, 1024, nullptr};
              pg8::gemm_phase<pg8::EpiScaleBf16<false>, pg8::StaticOrder, true, true>(lds, g, S, E, wv); }
            phase_cum(ap, lds, wv);
        }
        break;
        case 2: {
            { AttnT A{QM, 512, 0, KV, 768, 0, KPE, KV, 768, 256, Y, 1024, 0, nullptr, nullptr, rope, SSQ, 0};
              for (int u = vcu; u < 256; u += G) { const int bh = u >> 4, s = u & 15;
                  for (int hf = 0; hf < 2; ++hf) attn_unit<96, 128, 0>(lds, A, bh >> 2, bh & 3, hf ? s : 31 - s, wv); } }
            { AttnT A{PROJ, PROJ_W, 512, PROJ, PROJ_W, 768, nullptr, PROJ, PROJ_W, 1024, Y, 1024, 512, CUM, nullptr, nullptr, SSQ, 4};
              for (int u = vcu; u < 256; u += G) { const int bh = u >> 4, s = u & 15;
                  for (int hf = 0; hf < 2; ++hf) attn_unit<64, 64, 1>(lds, A, bh >> 2, bh & 3, hf ? s : 31 - s, wv); } }
            { AttnT A{PROJ, PROJ_W, 1280, PROJ, PROJ_W, 1536, nullptr, PROJ, PROJ_W, 1792, Y, 1024, 768, nullptr, ap->in[9] + l * 4 * 192, nullptr, SSQ, 8};
              for (int u = vcu; u < 512; u += G) { const int bh = (u >> 4) & 15, qb = (u & 15) + 16 * (u >> 8); attn_unit<64, 64, 2>(lds, A, bh >> 2, bh & 3, qb, wv); } }
        }
        break;
        case 3: {
            pg8::Gemm g{Y, (const bf16_t*)(wl + WO_O), T_TOK, 1024, 1024}; pg8::StaticOrder S; S.init(T_TOK, 1024, G, bx);
            pg8::EpiResidualY E{((3 * l) & 1) ? XB2 : XB, ((3 * l + 1) & 1) ? XB2 : XB, RS, SSQ};
            pg8::gemm_phase<pg8::EpiResidualY, pg8::StaticOrder, true, true>(lds, g, S, E, wv);
        }
        break;
        case 4: {
            pg8::Gemm g{((3 * l + 1) & 1) ? XB2 : XB, (const bf16_t*)(wl + WO_CQ), T_TOK, 512, 1024}; pg8::StaticOrder S; S.init(T_TOK, 512, G, bx);
            pg8::EpiScaleBf16<true> E{QC, 512, RS};
            pg8::gemm_phase<pg8::EpiScaleBf16<true>, pg8::StaticOrder, true, true>(lds, g, S, E, wv);
        }
        break;
        case 5: {
            AttnT A{QC, 512, 0, KVMEM, 1024, 0, nullptr, KVMEM, 1024, 512, OC, 512, 0, nullptr, nullptr, nullptr, nullptr, 0};
            for (int u = vcu; u < 512; u += G) { const int bh = (u >> 4) & 15, qb = (u & 15) + 16 * (u >> 8); attn_unit<128, 128, 3>(lds, A, bh >> 2, bh & 3, qb, wv); }
        }
        break;
        case 6: {
            pg8::Gemm g{OC, (const bf16_t*)(wl + WO_CO), T_TOK, 1024, 512}; pg8::StaticOrder S; S.init(T_TOK, 1024, G, bx);
            pg8::EpiResidual E{((3 * l + 1) & 1) ? XB2 : XB, ((3 * l + 2) & 1) ? XB2 : XB, RS, true};
            pg8::gemm_phase<pg8::EpiResidual, pg8::StaticOrder, true, true>(lds, g, S, E, wv);
        }
        break;
        case 7: {
            pg8::Gemm g{((3 * l + 2) & 1) ? XB2 : XB, (const bf16_t*)(wl + WO_GU), T_TOK, 2 * FFN_H, 1024}; pg8::StaticOrder S; S.init(T_TOK, 2 * FFN_H, G, bx);
            pg8::EpiSwiGLU E{HID, RS};
            pg8::gemm_phase<pg8::EpiSwiGLU, pg8::StaticOrder, true, true>(lds, g, S, E, wv);
        }
        break;
        case 8: {
            pg8::Gemm g{HID, (const bf16_t*)(wl + WO_DOWN), T_TOK, 1024, FFN_H}; pg8::StaticOrder S; S.init(T_TOK, 1024, G, bx);
            pg8::EpiResidual E{((3 * l + 2) & 1) ? XB2 : XB, ((3 * l + 3) & 1) ? XB2 : XB, RS, l + 1 < NLAYER};
            pg8::gemm_phase<pg8::EpiResidual, pg8::StaticOrder, true, true>(lds, g, S, E, wv);
        }
        break;

        default: break;
        }
        }
        if (p + 1 < hi) xcd_barrier(gbar);
    }
}

extern "C" void kernel_launch(void* const* d_in, const int* in_sizes, int n_in, void* d_out, int out_size, void* d_ws, size_t ws_size, hipStream_t stream) {
    static int grid = 0;
    if (grid == 0) {
        if (n_in != 21 || out_size != T_TOK * DMODEL || ws_size < WS_END) { fprintf(stderr, "kernel_launch: unexpected shapes (n_in %d, out %d, ws %zu)\n", n_in, out_size, ws_size); grid = -1; return; }
        int dev = 0, cus = 0, per_cu = 0;
        (void)hipGetDevice(&dev); (void)hipDeviceGetAttribute(&cus, hipDeviceAttributeMultiprocessorCount, dev);
        if (hipFuncSetAttribute((const void*)fwd_kernel, hipFuncAttributeMaxDynamicSharedMemorySize, LDS_BYTES) != hipSuccess) { fprintf(stderr, "kernel_launch: hipFuncSetAttribute failed\n"); grid = -1; return; }
        if (hipOccupancyMaxActiveBlocksPerMultiprocessor(&per_cu, (const void*)fwd_kernel, NTHREADS, LDS_BYTES) != hipSuccess || per_cu < 1) { fprintf(stderr, "kernel_launch: occupancy query gave %d\n", per_cu); per_cu = 1; }
        (void)hipGetLastError();
        grid = cus * 1;
        if (grid <= 0) grid = 256;
    }
    if (grid < 0) return;
    if (hipMemsetAsync((char*)d_ws + WS_BAR, 0, XCD_BAR_WORDS * 4, stream) != hipSuccess) { fprintf(stderr, "kernel_launch: memset failed\n"); return; }
    Args a{};
    for (int i = 0; i < 21; ++i) a.in[i] = (const float*)d_in[i];
    a.out = (float*)d_out; a.ws = (unsigned char*)d_ws;
#if MK_MULTI
    for (int p = 0; p < N_PHASES; ++p) { a.ph_lo = p; a.ph_hi = p + 1; hipLaunchKernelGGL(fwd_kernel, dim3(grid), dim3(NTHREADS), LDS_BYTES, stream, a); }
#else
    a.ph_lo = 0; a.ph_hi = N_PHASES;
    void* kargs[] = {&a};
    hipError_t e = hipLaunchCooperativeKernel((const void*)fwd_kernel, dim3(grid), dim3(NTHREADS), kargs, LDS_BYTES, stream);
    if (e != hipSuccess) fprintf(stderr, "kernel_launch: cooperative launch failed: %s (grid %d)\n", hipGetErrorString(e), grid);
#endif
}
```
